# Optimizing an MI355X kernel written in HIP

```python
import jax, jax.numpy as jnp
from jax import lax
import numpy as np

D_MODEL = 1024
BATCH = 2
SEQ = 8192
DEPTH = 1

N_MEM = 256
BRANCH_WIDTH = D_MODEL
N_BRANCH = 3
EPS = 1e-6
CONV_WIDTH = 4
LRU_WIDTH = BRANCH_WIDTH
LRU_BLOCKS = 4
LRU_BLOCK = LRU_WIDTH // LRU_BLOCKS
LRU_C = 8.0
MLSTM_WIDTH = BRANCH_WIDTH
MLSTM_HEADS = 4
MLSTM_HEAD_DIM = MLSTM_WIDTH // MLSTM_HEADS
MLSTM_CHUNK = 128
XATTN_WIDTH = BRANCH_WIDTH
XATTN_HEADS = 4
XATTN_HEAD_DIM = XATTN_WIDTH // XATTN_HEADS
IN_SPLITS = (LRU_WIDTH, LRU_WIDTH, MLSTM_WIDTH, MLSTM_WIDTH, XATTN_WIDTH, XATTN_WIDTH, N_BRANCH * D_MODEL)
IN_TOTAL = sum(IN_SPLITS)

kernel_name = "hybrid_rglru_mlstm_memxattn_gated"


def rms_norm(x, g):
    xf = x.astype(jnp.float32)
    y = xf * lax.rsqrt(jnp.mean(xf * xf, axis=-1, keepdims=True) + EPS) * g.astype(jnp.float32)
    return y.astype(x.dtype)


def causal_conv(u, w, b):
    K = w.shape[0]
    S = u.shape[1]
    up = jnp.pad(u, ((0, 0), (K - 1, 0), (0, 0)))
    out = b
    for k in range(K):
        out = out + w[k] * up[:, k:k + S]
    return out


def block_diag(u, w):
    G, I, O = w.shape
    ug = u.reshape(u.shape[:-1] + (G, I))
    return jnp.einsum('bsgi,gio->bsgo', ug, w).reshape(u.shape[:-1] + (G * O,))


def _lin_rec_combine(e1, e2):
    a1, b1 = e1
    a2, b2 = e2
    return a1 * a2, a2 * b1 + b2


def rg_lru(u, w_a, b_a, w_x, b_x, lam):
    uf = u.astype(jnp.float32)
    r = jax.nn.sigmoid(block_diag(u, w_a).astype(jnp.float32) + b_a.astype(jnp.float32))
    i = jax.nn.sigmoid(block_diag(u, w_x).astype(jnp.float32) + b_x.astype(jnp.float32))
    log_a = LRU_C * r * jax.nn.log_sigmoid(lam.astype(jnp.float32))
    a = jnp.exp(log_a)
    mult = jnp.sqrt(-jnp.expm1(2.0 * log_a))
    _, h = lax.associative_scan(_lin_rec_combine, (a, mult * i * uf), axis=1)
    return h.astype(u.dtype)


def mlstm_chunkwise(q, k, v, ig, lf):
    Bsz, S, H, d = q.shape
    L = MLSTM_CHUNK
    nc = S // L

    def chunks(t):
        return jnp.moveaxis(t.reshape((Bsz, nc, L, H) + t.shape[3:]), (1, 3), (0, 2))

    causal = jnp.tril(jnp.ones((L, L), dtype=bool))

    def step(carry, xs):
        C, n, m = carry
        qc, kc, vc, igc, lfc = xs
        b = jnp.cumsum(lfc, axis=-1)
        dmat = b[..., :, None] - b[..., None, :] + igc[..., None, :]
        dmat = jnp.where(causal, dmat, -jnp.inf)
        inter = b + m[..., None]
        m_t = jnp.maximum(inter, jnp.max(dmat, axis=-1))
        s = jnp.einsum('bhtd,bhsd->bhts', qc, kc) * jnp.exp(dmat - m_t[..., None])
        sc = jnp.exp(inter - m_t)
        num = jnp.einsum('bhts,bhsd->bhtd', s, vc) + sc[..., None] * jnp.einsum('bhvk,bhtk->bhtv', C, qc)
        den = jnp.sum(s, axis=-1) + sc * jnp.einsum('bhk,bhtk->bht', n, qc)
        h = num / jnp.maximum(jnp.abs(den), jnp.exp(-m_t))[..., None]
        bL = b[..., -1]
        g = bL[..., None] - b + igc
        m_new = jnp.maximum(bL + m, jnp.max(g, axis=-1))
        wk = jnp.exp(g - m_new[..., None])
        decay = jnp.exp(bL + m - m_new)
        C_new = decay[..., None, None] * C + jnp.einsum('bhs,bhsv,bhsk->bhvk', wk, vc, kc)
        n_new = decay[..., None] * n + jnp.einsum('bhs,bhsk->bhk', wk, kc)
        return (C_new, n_new, m_new), h

    init = (jnp.zeros((Bsz, H, d, d), jnp.float32), jnp.zeros((Bsz, H, d), jnp.float32),
            jnp.zeros((Bsz, H), jnp.float32))
    _, hs = lax.scan(step, init, (chunks(q), chunks(k), chunks(v), chunks(ig), chunks(lf)))
    return jnp.moveaxis(hs, (0, 2), (1, 3)).reshape(Bsz, S, H, d)


def mlstm_branch(xm, z, conv_w, conv_b, w_q, w_k, w_v, w_o, b_o, w_if, b_if, norm_g, skip):
    Bsz, S, W = xm.shape
    H, d = MLSTM_HEADS, MLSTM_HEAD_DIM
    xc = jax.nn.silu(causal_conv(xm, conv_w, conv_b))
    q = block_diag(xc, w_q)
    k = block_diag(xc, w_k)
    v = block_diag(xm, w_v)
    o = jax.nn.sigmoid(block_diag(xm, w_o).astype(jnp.float32) + b_o.astype(jnp.float32))
    gates = (jnp.concatenate([q, k, v], axis=-1) @ w_if).astype(jnp.float32) + b_if.astype(jnp.float32)
    ig = gates[..., :H]
    lf = jax.nn.log_sigmoid(gates[..., H:])
    f32 = jnp.float32
    h = mlstm_chunkwise(q.astype(f32).reshape(Bsz, S, H, d),
                        (k.astype(f32) * (d ** -0.5)).reshape(Bsz, S, H, d),
                        v.astype(f32).reshape(Bsz, S, H, d), ig, lf)
    h = o.reshape(Bsz, S, H, d) * h
    mu = jnp.mean(h, axis=-1, keepdims=True)
    var = jnp.mean(jnp.square(h - mu), axis=-1, keepdims=True)
    hn = ((h - mu) * lax.rsqrt(var + EPS)).reshape(Bsz, S, W) * norm_g.astype(f32)
    out = (hn + skip.astype(f32) * xc.astype(f32)) * jax.nn.silu(z.astype(f32))
    return out.astype(xm.dtype)


def memory_cross_attention(q_in, z, mem_n, w_mem_kv):
    Bsz, S, _ = q_in.shape
    H, d = XATTN_HEADS, XATTN_HEAD_DIM
    kv = mem_n @ w_mem_kv
    k = kv[..., :XATTN_WIDTH].reshape(Bsz, -1, H, d)
    v = kv[..., XATTN_WIDTH:].reshape(Bsz, -1, H, d)
    q = q_in.reshape(Bsz, S, H, d)
    s = jnp.einsum('bshd,bmhd->bhsm', q, k).astype(jnp.float32) * (d ** -0.5)
    p = jax.nn.softmax(s, axis=-1).astype(v.dtype)
    o = jnp.einsum('bhsm,bmhd->bshd', p, v).reshape(Bsz, S, XATTN_WIDTH)
    return o * jax.nn.silu(z)


def setup_inputs(seed: int = 0) -> dict:
    key = jax.random.key(seed)
    ks = iter(jax.random.split(key, 40))
    f32 = jnp.float32
    L, D, H, hd = DEPTH, D_MODEL, MLSTM_HEADS, MLSTM_HEAD_DIM

    def nrm(shape, scale):
        return jax.random.normal(next(ks), shape, f32) * scale

    u = jax.random.uniform(next(ks), (L, LRU_WIDTH), f32, 0.9, 0.999)
    a = u ** (1.0 / LRU_C)
    lru_lambda = jnp.log(a) - jnp.log1p(-a)
    b_if = jnp.concatenate([nrm((L, H), 0.1),
                            jnp.broadcast_to(jnp.linspace(3.0, 6.0, H), (L, H)) + nrm((L, H), 0.1)], axis=-1)
    return {
        "x": nrm((BATCH, SEQ, D), 1.0),
        "mem": nrm((BATCH, N_MEM, D), 1.0),
        "norm_g": 1.0 + nrm((L, D), 0.02),
        "w_in": nrm((L, D, IN_TOTAL), D ** -0.5),
        "b_in": nrm((L, IN_TOTAL), 0.02),
        "lru_conv_w": nrm((L, CONV_WIDTH, LRU_WIDTH), CONV_WIDTH ** -0.5),
        "lru_conv_b": nrm((L, LRU_WIDTH), 0.02),
        "lru_w_a": nrm((L, LRU_BLOCKS, LRU_BLOCK, LRU_BLOCK), LRU_BLOCK ** -0.5),
        "lru_b_a": nrm((L, LRU_WIDTH), 0.02),
        "lru_w_x": nrm((L, LRU_BLOCKS, LRU_BLOCK, LRU_BLOCK), LRU_BLOCK ** -0.5),
        "lru_b_x": nrm((L, LRU_WIDTH), 0.02),
        "lru_lambda": lru_lambda,
        "m_conv_w": nrm((L, CONV_WIDTH, MLSTM_WIDTH), CONV_WIDTH ** -0.5),
        "m_conv_b": nrm((L, MLSTM_WIDTH), 0.02),
        "m_w_q": nrm((L, H, hd, hd), hd ** -0.5),
        "m_w_k": nrm((L, H, hd, hd), hd ** -0.5),
        "m_w_v": nrm((L, H, hd, hd), hd ** -0.5),
        "m_w_o": nrm((L, H, hd, hd), hd ** -0.5),
        "m_b_o": nrm((L, MLSTM_WIDTH), 0.02),
        "m_w_if": nrm((L, 3 * MLSTM_WIDTH, 2 * H), (3 * MLSTM_WIDTH) ** -0.5),
        "m_b_if": b_if,
        "m_norm_g": 1.0 + nrm((L, MLSTM_WIDTH), 0.02),
        "m_skip": 1.0 + nrm((L, MLSTM_WIDTH), 0.02),
        "mem_norm_g": 1.0 + nrm((L, D), 0.02),
        "w_mem_kv": nrm((L, D, 2 * XATTN_WIDTH), D ** -0.5),
        "w_branch": nrm((L, N_BRANCH, BRANCH_WIDTH, D), BRANCH_WIDTH ** -0.5),
        "w_out": nrm((L, D, D), D ** -0.5),
        "final_norm_g": 1.0 + nrm((D,), 0.02),
    }


def reference(x, mem, norm_g, w_in, b_in, lru_conv_w, lru_conv_b, lru_w_a, lru_b_a, lru_w_x, lru_b_x,
              lru_lambda, m_conv_w, m_conv_b, m_w_q, m_w_k, m_w_v, m_w_o, m_b_o, m_w_if, m_b_if,
              m_norm_g, m_skip, mem_norm_g, w_mem_kv, w_branch, w_out, final_norm_g):
    Bsz, S, D = x.shape
    cuts = [int(c) for c in np.cumsum(IN_SPLITS)[:-1]]
    for l in range(DEPTH):
        h = rms_norm(x, norm_g[l])
        proj = h @ w_in[l] + b_in[l]
        lru_x, lru_z, m_x, m_z, xa_q, xa_z, gate_logits = jnp.split(proj, cuts, axis=-1)
        y_a = rg_lru(causal_conv(lru_x, lru_conv_w[l], lru_conv_b[l]),
                     lru_w_a[l], lru_b_a[l], lru_w_x[l], lru_b_x[l], lru_lambda[l]) * jax.nn.silu(lru_z)
        y_b = mlstm_branch(m_x, m_z, m_conv_w[l], m_conv_b[l], m_w_q[l], m_w_k[l], m_w_v[l], m_w_o[l],
                           m_b_o[l], m_w_if[l], m_b_if[l], m_norm_g[l], m_skip[l])
        y_c = memory_cross_attention(xa_q, xa_z, rms_norm(mem, mem_norm_g[l]), w_mem_kv[l])
        ys = jnp.stack([y_a, y_b, y_c], axis=2)
        branch_out = jnp.einsum('bsnw,nwd->bsnd', ys, w_branch[l])
        gates = jax.nn.sigmoid(gate_logits.astype(jnp.float32)).reshape(Bsz, S, N_BRANCH, D).astype(x.dtype)
        merged = jnp.sum(gates * branch_out, axis=2)
        x = x + merged @ w_out[l]
    return rms_norm(x, final_norm_g)
```

```cpp
#include <hip/hip_runtime.h>
#include <hip/hip_cooperative_groups.h>
#include <cstdio>
namespace cg = cooperative_groups;

#define LAS __attribute__((address_space(3)))
typedef unsigned short bf16_t;
typedef short bf16x8 __attribute__((ext_vector_type(8)));
typedef float f32x4 __attribute__((ext_vector_type(4)));
typedef unsigned u32x4 __attribute__((ext_vector_type(4)));
typedef unsigned u32x2 __attribute__((ext_vector_type(2)));

constexpr int T = 16384, DM = 1024, SEQ = 8192;
constexpr size_t SLOT = (size_t)T * DM * 2;

constexpr size_t O_WINT = 0;
constexpr size_t O_WBT = O_WINT + (size_t)9216 * 1024 * 2;
constexpr size_t O_WOUTT = O_WBT + (size_t)3 * 1024 * 1024 * 2;
constexpr size_t O_WKVT = O_WOUTT + (size_t)1024 * 1024 * 2;
constexpr size_t O_WQT = O_WKVT + (size_t)2048 * 1024 * 2;
constexpr size_t O_WKT = O_WQT + 524288;
constexpr size_t O_WVT = O_WKT + 524288;
constexpr size_t O_WOT = O_WVT + 524288;
constexpr size_t O_WLRUT = O_WOT + 524288;
constexpr size_t O_BINR = O_WLRUT + 1048576;
constexpr size_t O_WXC = O_BINR + 36864;
constexpr size_t O_WXM = O_WXC + 32768;
constexpr size_t O_GATES = O_WXM + 32768;
constexpr size_t O_BC = O_GATES + (size_t)T * 16 * 4;
constexpr size_t O_AV = O_BC + (size_t)T * 4 * 4;
constexpr size_t O_MT = O_AV + (size_t)T * 4 * 4;
constexpr size_t O_DENP = O_MT + (size_t)T * 4 * 4;
constexpr size_t O_NKLOC = O_DENP + 1048576;
constexpr size_t O_NPREV = O_NKLOC + 262144;
constexpr size_t O_KMEM = O_NPREV + 262144;
constexpr size_t O_VMEMT = O_KMEM + 1048576;
constexpr size_t O_MEMN = O_VMEMT + 1048576;
constexpr size_t O_HEND = O_MEMN + 1048576;
constexpr size_t O_SLOG = O_HEND + 1048576;
constexpr size_t O_CARRY = O_SLOG + 1048576;
constexpr size_t O_BAR = O_CARRY + 1048576;
constexpr size_t O_CNT = O_BAR + 16384;
constexpr size_t O_XCH = O_CNT + 16384;
constexpr size_t O_WGT = O_XCH + 262144;
constexpr size_t O_SMALL_END = O_WGT + 65536;
constexpr size_t O_SLOTS = (size_t)46 * 1024 * 1024;
static_assert(O_SMALL_END <= O_SLOTS, "small region overflow");
constexpr size_t WS_NEED = O_SLOTS + 6 * SLOT;

struct Params { const float* in[28]; float* out; unsigned char* ws; };

__device__ __forceinline__ unsigned pk2(float lo, float hi) { unsigned r; asm volatile("v_cvt_pk_bf16_f32 %0, %1, %2" : "=v"(r) : "v"(lo), "v"(hi)); return r; }
__device__ __forceinline__ float bf_lo(unsigned w) { return __uint_as_float(w << 16); }
__device__ __forceinline__ float bf_hi(unsigned w) { return __uint_as_float(w & 0xffff0000u); }
__device__ __forceinline__ float bf2f(bf16_t b) { return __uint_as_float(((unsigned)b) << 16); }
__device__ __forceinline__ float sigm(float x) { return 1.0f / (1.0f + __expf(-x)); }
__device__ __forceinline__ float logsigm(float x) { return fminf(x, 0.f) - log1pf(expf(-fabsf(x))); }
__device__ __forceinline__ float wave_sum(float v) {
#pragma unroll
  for (int o = 1; o < 64; o <<= 1) v += __shfl_xor(v, o);
  return v;
}

constexpr int BM = 256, BK = 64, HALF = 128, HTB = HALF * BK * 2, STAGE_BYTES = 8 * HTB;
__device__ __forceinline__ int lds_byte(int r, int c) { const int st = (r >> 4) * 2 + (c >> 5), rr = r & 15, cc = c & 31, ob = rr * 64 + cc * 2; return st * 1024 + (ob ^ (((ob >> 9) & 1) << 5)); }
__device__ __forceinline__ void stage_rc(int b, int& R, int& C) { const int st = b / 1024, sb = b % 1024, swz = sb ^ (((sb >> 9) & 1) << 5); R = (st >> 1) * 16 + swz / 64; C = (st & 1) * 32 + (swz % 64) / 2; }

__device__ __forceinline__ int perm32(int rho) { const int n = rho >> 4, i = rho & 15; return 8 * (i >> 2) + 4 * n + (i & 3); }
struct UnitD { const char* A0; const char* A1; const char* B0; const char* B1; char* out; const float* bias; int ldc, sub, row0, col0, aux0, aux1; };

__device__ __forceinline__ bool static_tile(long L, int nM, int nN, int& pm, int& pn) {
  const int nwg = nM * nN; if (L >= nwg) return false;
  int wgid = (int)L; { const int q = nwg / 8, r = nwg % 8, xcd = wgid % 8, off = wgid / 8; wgid = (xcd < r ? xcd * (q + 1) : r * (q + 1) + (xcd - r) * q) + off; }
  const int nig = 8 * nN, gid = wgid / nig, fm = gid * 8, gsz = (nM - fm) < 8 ? (nM - fm) : 8;
  pm = fm + ((wgid % nig) % gsz); pn = (wgid % nig) / gsz; return true;
}

#define ROWOF(ai, m) (128 * (ai) + 64 * wr + 16 * (m) + fr)
#define COLOF(bj, n) (128 * (bj) + 32 * wc + 8 * fq + 4 * (n))
#define UNR _Pragma("unroll")

template <class Sched, class Epi, bool DRAIN>
__device__ __forceinline__ void gemm_phase(LAS unsigned char* lds, const int lda, const int ldb, const int nt, const int nt0, const Sched& S, const Epi& E) {
  int tid = threadIdx.x; asm volatile("" : "+v"(tid));
  const int wid = __builtin_amdgcn_readfirstlane(tid >> 6), lane = tid & 63, wr = wid >> 2, wc = wid & 3, fr = lane & 15, fq = lane >> 4;
  unsigned voffA, voffB;
  { int R, C; stage_rc(tid * 16, R, C); const int Rb = (R & ~31) + perm32(R & 31); voffA = (unsigned)(R * lda + C) * 2u; voffB = (unsigned)(Rb * ldb + C) * 2u; }
  const size_t qstepA = (size_t)64 * lda * 2, qstepB = (size_t)64 * ldb * 2;
  const size_t kstep = (size_t)(BK * 2);
  const size_t hstepA = (size_t)HALF * lda * 2, hstepB = (size_t)HALF * ldb * 2;
  const unsigned ldsw = (unsigned)wid * 1024u;
  const int aoff = lds_byte(wr * 64 + fr, fq * 8), boff = lds_byte(wc * 32 + fr, fq * 8);
#define G_SA(b, h) (((b) * 2 + (h)) * HTB)
#define G_SB(b, h) ((4 + (b) * 2 + (h)) * HTB)
#define qoffA qstepA
#define qoffB qstepB
#define voffA_ voffA
#define G_STAGE(bufoff, gbase, voff) do { _Pragma("unroll") for (int _i = 0; _i < 2; ++_i) \
    __builtin_amdgcn_global_load_lds((const unsigned*)((const char*)(gbase) + (size_t)_i * q##voff + v##voff), (LAS unsigned*)(lds + (bufoff) + ldsw + _i * 8192), 16, 0, 0); } while (0)
#define G_LDA(dst, b, h) do { _Pragma("unroll") for (int m = 0; m < 4; ++m) _Pragma("unroll") for (int k = 0; k < 2; ++k) dst[m][k] = *(const LAS bf16x8*)(lds + G_SA(b, h) + aoff + m * 2048 + k * 1024); } while (0)
#define G_LDB(dst, b, h) do { _Pragma("unroll") for (int n = 0; n < 2; ++n) _Pragma("unroll") for (int k = 0; k < 2; ++k) dst[n][k] = *(const LAS bf16x8*)(lds + G_SB(b, h) + boff + n * 2048 + k * 1024); } while (0)
#define G_MMA(ai, bj, At, Bt) do { __builtin_amdgcn_s_setprio(1); _Pragma("unroll") for (int m = 0; m < 4; ++m) _Pragma("unroll") for (int n = 0; n < 2; ++n) _Pragma("unroll") for (int k = 0; k < 2; ++k) \
    acc[ai][bj][m][n] = __builtin_amdgcn_mfma_f32_16x16x32_bf16(Bt[n][k], At[m][k], acc[ai][bj][m][n], 0, 0, 0); __builtin_amdgcn_s_setprio(0); } while (0)
#define G_WAIT_V(n) asm volatile("s_waitcnt vmcnt(" #n ")" ::: "memory")
#define G_WAIT_L(n) asm volatile("s_waitcnt lgkmcnt(" #n ")" ::: "memory")
#define G_BAR __builtin_amdgcn_s_barrier()
#define G_SCHED __builtin_amdgcn_sched_barrier(0)
  UnitD cur, nxt; int ui = 0;
  if (!S.next(0, cur)) return;
  f32x4 acc[2][2][4][2];
#pragma unroll
  for (int a = 0; a < 2; ++a)
#pragma unroll
    for (int b = 0; b < 2; ++b)
#pragma unroll
      for (int m = 0; m < 4; ++m)
#pragma unroll
        for (int n = 0; n < 2; ++n) acc[a][b][m][n] = (f32x4){0.f, 0.f, 0.f, 0.f};
  bf16x8 At[4][2], B0[2][2], B1[2][2];
  {
    const char* cA = cur.A0; const char* cB = cur.B0;
    G_STAGE(G_SB(0, 0), cB, offB); G_STAGE(G_SA(0, 0), cA, offA); G_STAGE(G_SB(0, 1), cB + hstepB, offB); G_STAGE(G_SA(0, 1), cA + hstepA, offA);
    if (wr == 1) G_BAR;
    G_WAIT_V(4); G_BAR;
    G_STAGE(G_SB(1, 0), cB + kstep, offB); G_STAGE(G_SA(1, 0), cA + kstep, offA); G_STAGE(G_SB(1, 1), cB + hstepB + kstep, offB);
    G_WAIT_V(6); G_BAR;
  }
  for (;;) {
    const bool has_next = S.next(ui + 1, nxt);
    const char* nA = has_next ? nxt.A0 : cur.A0; const char* nB = has_next ? nxt.B0 : cur.B0;
    for (int t = 0; t < nt; t += 2) {
      const bool last = (t == nt - 2);
      const char* a1 = (t + 1 < nt0) ? cur.A0 + (size_t)(t + 1) * kstep : cur.A1 + (size_t)(t + 1 - nt0) * kstep;
      const char* a2; const char* b2;
      if (last) { a2 = nA; b2 = nB; }
      else if (t + 2 < nt0) { a2 = cur.A0 + (size_t)(t + 2) * kstep; b2 = cur.B0 + (size_t)(t + 2) * kstep; }
      else { a2 = cur.A1 + (size_t)(t + 2 - nt0) * kstep; b2 = cur.B1 + (size_t)(t + 2 - nt0) * kstep; }
      const char* a3 = a2 + kstep; const char* b3 = b2 + kstep;
      G_LDB(B0, 0, 0); G_SCHED; G_LDA(At, 0, 0); G_STAGE(G_SA(1, 1), a1 + hstepA, offA);
      G_WAIT_L(8); G_BAR; G_WAIT_L(0); G_MMA(0, 0, At, B0); G_BAR; G_SCHED;
      G_LDB(B1, 0, 1); G_STAGE(G_SB(0, 0), b2, offB);
      G_BAR; G_WAIT_L(0); G_MMA(0, 1, At, B1); G_BAR;
      G_LDA(At, 0, 1); G_STAGE(G_SA(0, 0), a2, offA);
      G_BAR; G_WAIT_L(0); G_MMA(1, 0, At, B0); G_BAR; G_SCHED;
      G_STAGE(G_SB(0, 1), b2 + hstepB, offB);
      G_WAIT_V(6); G_BAR; G_MMA(1, 1, At, B1); G_BAR;
      G_LDB(B0, 1, 0); G_SCHED; G_LDA(At, 1, 0); G_STAGE(G_SA(0, 1), a2 + hstepA, offA);
      G_WAIT_L(8); G_BAR; G_WAIT_L(0); G_MMA(0, 0, At, B0); G_BAR; G_SCHED;
      G_LDB(B1, 1, 1); G_STAGE(G_SB(1, 0), b3, offB);
      G_BAR; G_WAIT_L(0); G_MMA(0, 1, At, B1); G_BAR;
      G_LDA(At, 1, 1); G_STAGE(G_SA(1, 0), a3, offA);
      G_BAR; G_WAIT_L(0); G_MMA(1, 0, At, B0); G_BAR; G_SCHED;
      G_STAGE(G_SB(1, 1), b3 + hstepB, offB);
      G_WAIT_V(6); G_BAR; G_MMA(1, 1, At, B1); G_BAR;
    }
    if constexpr (!DRAIN) { int fr2 = fr, fq2 = fq; asm volatile("" : "+v"(fr2), "+v"(fq2)); E.run(acc, cur, wr, wc, fr2, fq2); }
    if (!has_next) break;
#pragma unroll
    for (int a = 0; a < 2; ++a)
#pragma unroll
      for (int b = 0; b < 2; ++b)
#pragma unroll
        for (int m = 0; m < 4; ++m)
#pragma unroll
          for (int n = 0; n < 2; ++n) acc[a][b][m][n] = (f32x4){0.f, 0.f, 0.f, 0.f};
    cur = nxt; ++ui;
  }
  G_WAIT_V(0);
  if (wr == 0) G_BAR;
  G_BAR;
  if constexpr (DRAIN) { int fr2 = fr, fq2 = fq; asm volatile("" : "+v"(fr2), "+v"(fq2)); E.run(acc, cur, wr, wc, fr2, fq2); }
#undef G_SA
#undef G_SB
#undef G_STAGE
#undef G_LDA
#undef G_LDB
#undef G_MMA
#undef G_WAIT_V
#undef G_WAIT_L
#undef G_BAR
#undef G_SCHED
}

typedef f32x4 Acc[2][2][4][2];

template <bool MAX>
__device__ __forceinline__ void row_allreduce(float (&v)[2][4], LAS float* P, int wr, int wc, int fr, int fq) {
  UNR for (int ai = 0; ai < 2; ++ai) UNR for (int m = 0; m < 4; ++m) {
    float x = v[ai][m];
    float y = __shfl_xor(x, 16); x = MAX ? fmaxf(x, y) : x + y;
    y = __shfl_xor(x, 32); x = MAX ? fmaxf(x, y) : x + y;
    if (fq == 0) P[ROWOF(ai, m) * 4 + wc] = x;
  }
  __syncthreads();
  UNR for (int ai = 0; ai < 2; ++ai) UNR for (int m = 0; m < 4; ++m) {
    const f32x4 q = *(const LAS f32x4*)(P + ROWOF(ai, m) * 4);
    v[ai][m] = MAX ? fmaxf(fmaxf(q.x, q.y), fmaxf(q.z, q.w)) : (q.x + q.y) + (q.z + q.w);
  }
  __syncthreads();
}

struct EpiBf16 {
  const float* m_Av; const float* m_Mt;
  __device__ __forceinline__ void run(Acc& acc, const UnitD& u, int wr, int wc, int fr, int fq) const {
    bf16_t* base = (bf16_t*)u.out + (size_t)(64 * wr + fr) * u.ldc + 32 * wc + 8 * fq;
    UNR for (int bj = 0; bj < 2; ++bj) {
      f32x4 b0 = u.bias ? *(const f32x4*)(u.bias + COLOF(bj, 0)) : (f32x4){0.f, 0.f, 0.f, 0.f};
      f32x4 b1 = u.bias ? *(const f32x4*)(u.bias + COLOF(bj, 1)) : (f32x4){0.f, 0.f, 0.f, 0.f};
      if (u.sub == 2) { const float me = m_Mt[(size_t)(u.row0 + 255) * 4 + u.aux0];
        UNR for (int j = 0; j < 4; ++j) { b0[j] = __expf(m_Av[(size_t)(u.row0 + COLOF(bj, 0) + j) * 4 + u.aux0] - me); b1[j] = __expf(m_Av[(size_t)(u.row0 + COLOF(bj, 1) + j) * 4 + u.aux0] - me); } }
      UNR for (int ai = 0; ai < 2; ++ai) UNR for (int m = 0; m < 4; ++m) {
        f32x4 v0 = acc[ai][bj][m][0], v1 = acc[ai][bj][m][1];
        if (u.sub == 2) { v0 = v0 * b0; v1 = v1 * b1; } else { v0 = v0 + b0; v1 = v1 + b1; }
        if (u.sub == 1) { v0.x = sigm(v0.x); v0.y = sigm(v0.y); v0.z = sigm(v0.z); v0.w = sigm(v0.w); v1.x = sigm(v1.x); v1.y = sigm(v1.y); v1.z = sigm(v1.z); v1.w = sigm(v1.w); }
        u32x4 w; w.x = pk2(v0.x, v0.y); w.y = pk2(v0.z, v0.w); w.z = pk2(v1.x, v1.y); w.w = pk2(v1.z, v1.w);
        *(u32x4*)(base + (size_t)(128 * ai + 16 * m) * u.ldc + 128 * bj) = w;
      }
      asm volatile("" ::: "memory");
    }
  }
};
struct EpiU1 {
  const float* m_Av; const float* m_Mt; float* m_denp;
  __device__ __forceinline__ void run(Acc& acc, const UnitD& u, int wr, int wc, int fr, int fq) const {
    const int h = u.aux0, unit = u.aux1, tok0 = u.row0;
    float av[2][8];
    UNR for (int bj = 0; bj < 2; ++bj) UNR for (int j = 0; j < 8; ++j) av[bj][j] = m_Av[(size_t)(tok0 + COLOF(bj, 0) + j) * 4 + h];
    float mtv[2][4];
    UNR for (int ai = 0; ai < 2; ++ai) UNR for (int m = 0; m < 4; ++m) mtv[ai][m] = m_Mt[(size_t)(tok0 + ROWOF(ai, m)) * 4 + h];
    UNR for (int ai = 0; ai < 2; ++ai) UNR for (int m = 0; m < 4; ++m) {
      const int r = ROWOF(ai, m);
      const float mt = mtv[ai][m];
      bf16_t* rowp = (bf16_t*)u.out + (size_t)r * u.ldc;
      float rs = 0.f;
      UNR for (int bj = 0; bj < 2; ++bj) {
        float v[8];
        UNR for (int j = 0; j < 8; ++j) { const int c = COLOF(bj, 0) + j; const float w = (c <= r) ? __expf(av[bj][j] - mt) : 0.f; v[j] = acc[ai][bj][m][j >> 2][j & 3] * w; rs += v[j]; }
        u32x4 w2; w2.x = pk2(v[0], v[1]); w2.y = pk2(v[2], v[3]); w2.z = pk2(v[4], v[5]); w2.w = pk2(v[6], v[7]);
        *(u32x4*)(rowp + COLOF(bj, 0)) = w2;
      }
      rs += __shfl_xor(rs, 16); rs += __shfl_xor(rs, 32);
      if (fq == 0) m_denp[((size_t)unit * 256 + r) * 4 + wc] = rs;
      asm volatile("" ::: "memory");
    }
  }
};
struct EpiLru {
  const float* b_a; const float* b_x; const float* lam; const bf16_t* u; bf16_t* loga; bf16_t* bb;
  __device__ __forceinline__ void run(Acc& acc, const UnitD& ud, int wr, int wc, int fr, int fq) const {
    const int chb = ud.col0;
    UNR for (int bj = 0; bj < 2; ++bj) {
      const int ch = chb + 64 * bj + 16 * wc + 4 * fq;
      const f32x4 ba = *(const f32x4*)(b_a + ch), bx = *(const f32x4*)(b_x + ch), l = *(const f32x4*)(lam + ch);
      f32x4 ls;
      UNR for (int j = 0; j < 4; ++j) ls[j] = 8.0f * logsigm(l[j]);
      const size_t o0 = ((size_t)ud.row0 + 64 * wr + fr) * 1024 + ch;
      UNR for (int ai = 0; ai < 2; ++ai) { u32x2 uq[4];
      UNR for (int m = 0; m < 4; ++m) uq[m] = *(const u32x2*)(u + o0 + (size_t)(128 * ai + 16 * m) * 1024);
      UNR for (int m = 0; m < 4; ++m) {
        const size_t o = o0 + (size_t)(128 * ai + 16 * m) * 1024;
        const u32x2 uw = uq[m];
        const float uu[4] = {bf_lo(uw.x), bf_hi(uw.x), bf_lo(uw.y), bf_hi(uw.y)};
        float la[4], bv[4];
        UNR for (int j = 0; j < 4; ++j) {
          const float rg = sigm(acc[ai][bj][m][0][j] + ba[j]);
          const float ig = sigm(acc[ai][bj][m][1][j] + bx[j]);
          la[j] = rg * ls[j];
          const float x2 = 2.0f * la[j];
          const float om = (x2 > -0.02f) ? -(x2 * (1.0f + x2 * (0.5f + x2 * (1.0f / 6.0f)))) : 1.0f - __expf(x2);
          bv[j] = sqrtf(fmaxf(om, 0.f)) * ig * uu[j];
        }
        u32x2 w1; w1.x = pk2(la[0], la[1]); w1.y = pk2(la[2], la[3]);
        u32x2 w2; w2.x = pk2(bv[0], bv[1]); w2.y = pk2(bv[2], bv[3]);
        *(u32x2*)(loga + o) = w1; *(u32x2*)(bb + o) = w2;
      }
      asm volatile("" ::: "memory"); }
    }
  }
};
struct EpiZ {
  __device__ __forceinline__ void run(Acc& acc, const UnitD& u, int wr, int wc, int fr, int fq) const {
    bf16_t* base = (bf16_t*)u.out + (size_t)(64 * wr + fr) * u.ldc + 32 * wc + 8 * fq;
    UNR for (int bj = 0; bj < 2; ++bj) {
      const f32x4 b0 = *(const f32x4*)(u.bias + COLOF(bj, 0)), b1 = *(const f32x4*)(u.bias + COLOF(bj, 1));
      u32x4 o[2][4];
      UNR for (int ai = 0; ai < 2; ++ai) UNR for (int m = 0; m < 4; ++m) o[ai][m] = *(const u32x4*)(base + (size_t)(128 * ai + 16 * m) * u.ldc + 128 * bj);
      UNR for (int ai = 0; ai < 2; ++ai) UNR for (int m = 0; m < 4; ++m) {
        const f32x4 z0 = acc[ai][bj][m][0] + b0, z1 = acc[ai][bj][m][1] + b1; const u32x4 ov = o[ai][m];
        u32x4 w; w.x = pk2(bf_lo(ov.x) * z0.x * sigm(z0.x), bf_hi(ov.x) * z0.y * sigm(z0.y)); w.y = pk2(bf_lo(ov.y) * z0.z * sigm(z0.z), bf_hi(ov.y) * z0.w * sigm(z0.w));
        w.z = pk2(bf_lo(ov.z) * z1.x * sigm(z1.x), bf_hi(ov.z) * z1.y * sigm(z1.y)); w.w = pk2(bf_lo(ov.w) * z1.z * sigm(z1.z), bf_hi(ov.w) * z1.w * sigm(z1.w));
        *(u32x4*)(base + (size_t)(128 * ai + 16 * m) * u.ldc + 128 * bj) = w;
      }
      asm volatile("" ::: "memory");
    }
  }
};
struct EpiMerge {
  bf16_t* gsc; float* macc; bf16_t* merged;
  __device__ __forceinline__ void run(Acc& acc, const UnitD& u, int wr, int wc, int fr, int fq) const {
    const size_t org = (size_t)(u.row0 + 64 * wr + fr) * 1024 + u.col0 + 32 * wc + 8 * fq;
    if ((u.sub & 1) == 0) {
      UNR for (int bj = 0; bj < 2; ++bj) {
        const f32x4 b0 = *(const f32x4*)(u.bias + COLOF(bj, 0)), b1 = *(const f32x4*)(u.bias + COLOF(bj, 1));
        UNR for (int ai = 0; ai < 2; ++ai) UNR for (int m = 0; m < 4; ++m) {
          const f32x4 v0 = acc[ai][bj][m][0] + b0, v1 = acc[ai][bj][m][1] + b1;
          u32x4 w; w.x = pk2(sigm(v0.x), sigm(v0.y)); w.y = pk2(sigm(v0.z), sigm(v0.w)); w.z = pk2(sigm(v1.x), sigm(v1.y)); w.w = pk2(sigm(v1.z), sigm(v1.w));
          *(u32x4*)(gsc + org + (size_t)(128 * ai + 16 * m) * 1024 + 128 * bj) = w;
        }
      }
    } else {
      UNR for (int bj = 0; bj < 2; ++bj) {
        u32x4 g[2][4], a[2][4];
        UNR for (int ai = 0; ai < 2; ++ai) UNR for (int m = 0; m < 4; ++m) { const size_t o = org + (size_t)(128 * ai + 16 * m) * 1024 + 128 * bj; g[ai][m] = *(const u32x4*)(gsc + o); if (u.sub != 1) a[ai][m] = *(const u32x4*)(merged + o); }
        UNR for (int ai = 0; ai < 2; ++ai) UNR for (int m = 0; m < 4; ++m) {
          const size_t o = org + (size_t)(128 * ai + 16 * m) * 1024 + 128 * bj;
          const u32x4 gg = g[ai][m];
          f32x4 v0 = acc[ai][bj][m][0], v1 = acc[ai][bj][m][1];
          v0.x *= bf_lo(gg.x); v0.y *= bf_hi(gg.x); v0.z *= bf_lo(gg.y); v0.w *= bf_hi(gg.y); v1.x *= bf_lo(gg.z); v1.y *= bf_hi(gg.z); v1.z *= bf_lo(gg.w); v1.w *= bf_hi(gg.w);
          if (u.sub != 1) { const u32x4 aa = a[ai][m]; v0.x += bf_lo(aa.x); v0.y += bf_hi(aa.x); v0.z += bf_lo(aa.y); v0.w += bf_hi(aa.y); v1.x += bf_lo(aa.z); v1.y += bf_hi(aa.z); v1.z += bf_lo(aa.w); v1.w += bf_hi(aa.w); }
          u32x4 w; w.x = pk2(v0.x, v0.y); w.y = pk2(v0.z, v0.w); w.z = pk2(v1.x, v1.y); w.w = pk2(v1.z, v1.w); *(u32x4*)(merged + o) = w;
        }
        asm volatile("" ::: "memory");
      }
    }
  }
};
struct EpiOut {
  const float* x; float* out;
  __device__ __forceinline__ void run(Acc& acc, const UnitD& u, int wr, int wc, int fr, int fq) const {
    const size_t org = (size_t)(u.row0 + 64 * wr + fr) * 1024 + u.col0 + 32 * wc + 8 * fq;
    UNR for (int bj = 0; bj < 2; ++bj) {
      f32x4 xv[2][4][2];
      UNR for (int ai = 0; ai < 2; ++ai) UNR for (int m = 0; m < 4; ++m) { const size_t o = org + (size_t)(128 * ai + 16 * m) * 1024 + 128 * bj; xv[ai][m][0] = *(const f32x4*)(x + o); xv[ai][m][1] = *(const f32x4*)(x + o + 4); }
      UNR for (int ai = 0; ai < 2; ++ai) UNR for (int m = 0; m < 4; ++m) { const size_t o = org + (size_t)(128 * ai + 16 * m) * 1024 + 128 * bj;
        *(f32x4*)(out + o) = xv[ai][m][0] + acc[ai][bj][m][0]; *(f32x4*)(out + o + 4) = xv[ai][m][1] + acc[ai][bj][m][1]; }
      asm volatile("" ::: "memory");
    }
  }
};
struct EpiSoftmax {
  LAS float* P;
  __device__ __forceinline__ void run(Acc& acc, const UnitD& u, int wr, int wc, int fr, int fq) const {
    float mx[2][4], sm[2][4];
    UNR for (int ai = 0; ai < 2; ++ai) UNR for (int m = 0; m < 4; ++m) { float x = -3.0e38f;
      UNR for (int bj = 0; bj < 2; ++bj) UNR for (int n = 0; n < 2; ++n) UNR for (int j = 0; j < 4; ++j) { acc[ai][bj][m][n][j] *= 0.0625f; x = fmaxf(x, acc[ai][bj][m][n][j]); }
      mx[ai][m] = x; }
    row_allreduce<true>(mx, P, wr, wc, fr, fq);
    UNR for (int ai = 0; ai < 2; ++ai) UNR for (int m = 0; m < 4; ++m) { float s = 0.f;
      UNR for (int bj = 0; bj < 2; ++bj) UNR for (int n = 0; n < 2; ++n) UNR for (int j = 0; j < 4; ++j) { const float e = __expf(acc[ai][bj][m][n][j] - mx[ai][m]); acc[ai][bj][m][n][j] = e; s += e; }
      sm[ai][m] = s; }
    row_allreduce<false>(sm, P, wr, wc, fr, fq);
    UNR for (int ai = 0; ai < 2; ++ai) UNR for (int m = 0; m < 4; ++m) {
      const float inv = 1.0f / sm[ai][m];
      bf16_t* rowp = (bf16_t*)u.out + (size_t)ROWOF(ai, m) * u.ldc;
      UNR for (int bj = 0; bj < 2; ++bj) { const f32x4 v0 = acc[ai][bj][m][0] * inv, v1 = acc[ai][bj][m][1] * inv;
        u32x4 w; w.x = pk2(v0.x, v0.y); w.y = pk2(v0.z, v0.w); w.z = pk2(v1.x, v1.y); w.w = pk2(v1.z, v1.w); *(u32x4*)(rowp + COLOF(bj, 0)) = w; }
    }
  }
};
struct EpiU2 {
  LAS float* P; LAS float* deni; const float* m_denp; const float* m_Bc; const float* m_Mt; const bf16_t* og; const float* norm_g; const float* skip; bf16_t* xc;
  __device__ __forceinline__ void run(Acc& acc, const UnitD& u, int wr, int wc, int fr, int fq) const {
    const int h = u.aux0, unit = u.aux1, tok0 = u.row0;
    float s1[2][4], s2[2][4];
    UNR for (int ai = 0; ai < 2; ++ai) UNR for (int m = 0; m < 4; ++m) {
      const int r = ROWOF(ai, m); const size_t tok = (size_t)tok0 + r;
      const f32x4 dp = *(const f32x4*)(m_denp + ((size_t)unit * 256 + r) * 4);
      const float den = (dp.x + dp.y) + (dp.z + dp.w) + deni[r];
      const float mt = m_Bc[tok * 4 + h];
      const float inv = 1.0f / fmaxf(fabsf(den), __expf(-mt));
      float s = 0.f;
      const bf16_t* ogp = og + tok * 1024 + h * 256 + 32 * wc + 8 * fq;
      UNR for (int bj = 0; bj < 2; ++bj) {
        const u32x4 o = *(const u32x4*)(ogp + 128 * bj);
        f32x4 v0 = acc[ai][bj][m][0] * inv, v1 = acc[ai][bj][m][1] * inv;
        v0.x *= bf_lo(o.x); v0.y *= bf_hi(o.x); v0.z *= bf_lo(o.y); v0.w *= bf_hi(o.y); v1.x *= bf_lo(o.z); v1.y *= bf_hi(o.z); v1.z *= bf_lo(o.w); v1.w *= bf_hi(o.w);
        acc[ai][bj][m][0] = v0; acc[ai][bj][m][1] = v1; s += ((v0.x + v0.y) + (v0.z + v0.w)) + ((v1.x + v1.y) + (v1.z + v1.w));
      }
      s1[ai][m] = s;
      if (m == 3) asm volatile("" ::: "memory");
    }
    row_allreduce<false>(s1, P, wr, wc, fr, fq);
    UNR for (int ai = 0; ai < 2; ++ai) UNR for (int m = 0; m < 4; ++m) { const float mu = s1[ai][m] * (1.0f / 256.0f); float s = 0.f;
      UNR for (int bj = 0; bj < 2; ++bj) UNR for (int n = 0; n < 2; ++n) { f32x4 v = acc[ai][bj][m][n] - mu; acc[ai][bj][m][n] = v; s += (v.x * v.x + v.y * v.y) + (v.z * v.z + v.w * v.w); }
      s2[ai][m] = s; }
    row_allreduce<false>(s2, P, wr, wc, fr, fq);
    UNR for (int ai = 0; ai < 2; ++ai) UNR for (int m = 0; m < 4; ++m) s2[ai][m] = 1.0f / sqrtf(s2[ai][m] * (1.0f / 256.0f) + 1e-6f);
    bf16_t* xb = xc + (size_t)(tok0 + 64 * wr + fr) * 1024 + h * 256 + 32 * wc + 8 * fq;
    UNR for (int bj = 0; bj < 2; ++bj) {
      const int ch = h * 256 + COLOF(bj, 0);
      const f32x4 g0 = *(const f32x4*)(norm_g + ch), g1 = *(const f32x4*)(norm_g + ch + 4), k0 = *(const f32x4*)(skip + ch), k1 = *(const f32x4*)(skip + ch + 4);
      UNR for (int ai = 0; ai < 2; ++ai) {
        u32x4 xq[4];
        UNR for (int m = 0; m < 4; ++m) xq[m] = *(const u32x4*)(xb + (size_t)(128 * ai + 16 * m) * 1024 + 128 * bj);
        UNR for (int m = 0; m < 4; ++m) {
          const u32x4 xv = xq[m];
          const f32x4 v0 = acc[ai][bj][m][0] * s2[ai][m], v1 = acc[ai][bj][m][1] * s2[ai][m];
          u32x4 w; w.x = pk2(v0.x * g0.x + k0.x * bf_lo(xv.x), v0.y * g0.y + k0.y * bf_hi(xv.x)); w.y = pk2(v0.z * g0.z + k0.z * bf_lo(xv.y), v0.w * g0.w + k0.w * bf_hi(xv.y));
          w.z = pk2(v1.x * g1.x + k1.x * bf_lo(xv.z), v1.y * g1.y + k1.y * bf_hi(xv.z)); w.w = pk2(v1.z * g1.z + k1.z * bf_lo(xv.w), v1.w * g1.w + k1.w * bf_hi(xv.w));
          *(u32x4*)(xb + (size_t)(128 * ai + 16 * m) * 1024 + 128 * bj) = w;
        }
        asm volatile("" ::: "memory");
      }
    }
  }
};

struct EpiOutNorm {
  const float* x; float* out; const float* g; LAS float* P; float* xch; unsigned* cnt;
  __device__ __forceinline__ void run(Acc& acc, const UnitD& u, int wr, int wc, int fr, int fq) const {
    const int pm = u.aux0, pn = u.aux1;
    const size_t org = (size_t)(u.row0 + 64 * wr + fr) * 1024 + u.col0 + 32 * wc + 8 * fq;
    UNR for (int bj = 0; bj < 2; ++bj) UNR for (int ai = 0; ai < 2; ++ai) {
      f32x4 xv[4][2];
      UNR for (int m = 0; m < 4; ++m) { const size_t o = org + (size_t)(128 * ai + 16 * m) * 1024 + 128 * bj; xv[m][0] = *(const f32x4*)(x + o); xv[m][1] = *(const f32x4*)(x + o + 4); }
      UNR for (int m = 0; m < 4; ++m) { acc[ai][bj][m][0] += xv[m][0]; acc[ai][bj][m][1] += xv[m][1]; }
      asm volatile("" ::: "memory");
    }
    float ss[2][4];
    UNR for (int ai = 0; ai < 2; ++ai) UNR for (int m = 0; m < 4; ++m) { float s = 0.f;
      UNR for (int bj = 0; bj < 2; ++bj) UNR for (int n = 0; n < 2; ++n) { const f32x4 v = acc[ai][bj][m][n]; s += (v.x * v.x + v.y * v.y) + (v.z * v.z + v.w * v.w); }
      ss[ai][m] = s; }
    row_allreduce<false>(ss, P, wr, wc, fr, fq);
    if (wc == 0 && fq == 0) {
      UNR for (int ai = 0; ai < 2; ++ai) UNR for (int m = 0; m < 4; ++m)
        __hip_atomic_store(xch + ((size_t)(pm * 256 + ROWOF(ai, m))) * 4 + pn, ss[ai][m], __ATOMIC_RELAXED, __HIP_MEMORY_SCOPE_AGENT);
    }
    asm volatile("s_waitcnt vmcnt(0)" ::: "memory");
    __syncthreads();
    if (threadIdx.x == 0) {
      unsigned* c = cnt + 64 * pm;
      __hip_atomic_fetch_add(c, 1u, __ATOMIC_RELAXED, __HIP_MEMORY_SCOPE_AGENT);
      unsigned sp = 0;
      while (__hip_atomic_load(c, __ATOMIC_RELAXED, __HIP_MEMORY_SCOPE_AGENT) < 4u) { __builtin_amdgcn_s_sleep(1); if (++sp > (1u << 22)) break; }
      __builtin_amdgcn_fence(__ATOMIC_ACQUIRE, "agent");
      asm volatile("s_waitcnt vmcnt(0)" ::: "memory");
    }
    __syncthreads();
    UNR for (int ai = 0; ai < 2; ++ai) UNR for (int m = 0; m < 4; ++m) {
      const float* sl = xch + ((size_t)(pm * 256 + ROWOF(ai, m))) * 4;
      const float t = (__hip_atomic_load(sl, __ATOMIC_RELAXED, __HIP_MEMORY_SCOPE_AGENT) + __hip_atomic_load(sl + 1, __ATOMIC_RELAXED, __HIP_MEMORY_SCOPE_AGENT))
                    + (__hip_atomic_load(sl + 2, __ATOMIC_RELAXED, __HIP_MEMORY_SCOPE_AGENT) + __hip_atomic_load(sl + 3, __ATOMIC_RELAXED, __HIP_MEMORY_SCOPE_AGENT));
      ss[ai][m] = 1.0f / sqrtf(t * (1.0f / 1024.0f) + 1e-6f);
    }
    int fr3 = fr, fq3 = fq; asm volatile("" : "+v"(fr3), "+v"(fq3));
    const size_t org2 = (size_t)(u.row0 + 64 * wr + fr3) * 1024 + u.col0 + 32 * wc + 8 * fq3;
    UNR for (int bj = 0; bj < 2; ++bj) {
      const f32x4 g0 = *(const f32x4*)(g + u.col0 + COLOF(bj, 0)), g1 = *(const f32x4*)(g + u.col0 + COLOF(bj, 1));
      UNR for (int ai = 0; ai < 2; ++ai) UNR for (int m = 0; m < 4; ++m) { const size_t o = org2 + (size_t)(128 * ai + 16 * m) * 1024 + 128 * bj;
        *(f32x4*)(out + o) = acc[ai][bj][m][0] * ss[ai][m] * g0; *(f32x4*)(out + o + 4) = acc[ai][bj][m][1] * ss[ai][m] * g1; }
    }
  }
};

struct SchedTiles {
  const char* A; const char* Bt; char* out0; char* out1; const float* bias; int nN, G, c;
  __device__ __forceinline__ bool next(int i, UnitD& u) const {
    int pm, pn; if (!static_tile((long)i * G + c, 64, nN, pm, pn)) return false;
    u.A0 = u.A1 = A + (size_t)pm * 256 * 1024 * 2; u.B0 = u.B1 = Bt + (size_t)pn * 256 * 1024 * 2;
    u.out = ((pn >> 2) ? out1 : out0) + ((size_t)pm * 256 * 1024 + (pn & 3) * 256) * 2; u.bias = bias ? bias + pn * 256 : nullptr; u.ldc = 1024; u.sub = 0;
    u.row0 = pm * 256; u.col0 = (pn & 3) * 256; u.aux0 = 0; u.aux1 = 0; return true;
  }
};
struct SchedOne { UnitD u; bool has; __device__ __forceinline__ bool next(int i, UnitD& o) const { if (i != 0 || !has) return false; o = u; return true; } };
struct SchedP3X {
  const char* xc; const char* mx; const char* wq; const char* wk; const char* wo; char* q; char* k; char* og; const float* b_o; int G, c;
  __device__ __forceinline__ bool next(int i, UnitD& u) const {
    const int L = i * G + c; if (L >= 768) return false;
    const int kind = L >> 8, idx = L & 255, pm = idx >> 2, h = idx & 3;
    const size_t to = ((size_t)pm * 256 * 1024 + h * 256) * 2;
    u.A0 = u.A1 = (kind == 2 ? mx : xc) + to; u.B0 = u.B1 = wq + (size_t)(kind == 0 ? 0 : kind == 1 ? 524288 : 1572864) + (size_t)h * 131072;
    u.out = q + (size_t)kind * SLOT + to; u.bias = kind == 2 ? b_o + h * 256 : nullptr; u.ldc = 1024; u.sub = kind == 2 ? 1 : 0;
    u.row0 = pm * 256; u.col0 = h * 256; u.aux0 = h; u.aux1 = 0; return true;
  }
};
struct SchedP3Y {
  const char* xc; const char* mx; const char* wk; const char* wv; char* vt; char* ktw; int G, c, base, count;
  __device__ __forceinline__ bool next(int i, UnitD& u) const {
    const int Lr = i * G + c; if (Lr >= count) return false;
    const int L = base + Lr;
    const int kind = L >> 8, unit = L & 255, bh = unit >> 5, ci = unit & 31, b = bh >> 2, h = bh & 3, tok0 = b * SEQ + ci * 256;
    u.A0 = u.A1 = (kind ? wk : wv) + (size_t)h * 131072; u.B0 = u.B1 = (kind ? xc : mx) + ((size_t)tok0 * 1024 + h * 256) * 2;
    u.out = (kind ? ktw : vt) + (size_t)unit * 131072; u.bias = nullptr; u.ldc = 256; u.sub = kind ? 2 : 0; u.row0 = tok0; u.col0 = 0; u.aux0 = h; u.aux1 = unit; return true;
  }
};
struct SchedZ {
  const char* hn; const char* wint; char* y0; char* y1; char* y2; const float* binr; int G, c;
  __device__ __forceinline__ bool next(int i, UnitD& u) const {
    const int L = i * G + c; if (L >= 768) return false;
    const int br = L >> 8, r = L & 255, pm = (r & 7) * 8 + (r >> 5), pn = (r >> 3) & 3;
    u.A0 = u.A1 = hn + (size_t)pm * 256 * 1024 * 2; u.B0 = u.B1 = wint + (size_t)(3072 + br * 1024 + pn * 256) * 1024 * 2;
    u.out = (char*)((size_t)y0 * (size_t)(br == 0) + (size_t)y1 * (size_t)(br == 1) + (size_t)y2 * (size_t)(br == 2)) + ((size_t)pm * 256 * 1024 + pn * 256) * 2; u.bias = binr + 3072 + br * 1024 + pn * 256; u.ldc = 1024; u.sub = 0; u.row0 = pm * 256; u.col0 = pn * 256; u.aux0 = 0; u.aux1 = 0; return true;
  }
};
struct SchedMerge {
  const char* hn; const char* wint; const char* wbt; const char* y0; const char* y1; const char* y2; const float* binr; int G, c;
  __device__ __forceinline__ bool next(int i, UnitD& u) const {
    const int tile = (i / 6) * G + c; if (tile >= 256) return false;
    const int kind = i % 6, n = kind >> 1, pm = (tile & 7) * 8 + (tile >> 5), pn = (tile >> 3) & 3;
    if ((kind & 1) == 0) { u.A0 = u.A1 = hn + (size_t)pm * 256 * 1024 * 2; u.B0 = u.B1 = wint + (size_t)(6144 + n * 1024 + pn * 256) * 1024 * 2; u.bias = binr + 6144 + n * 1024 + pn * 256; }
    else { u.A0 = u.A1 = (const char*)((size_t)y0 * (size_t)(n == 0) + (size_t)y1 * (size_t)(n == 1) + (size_t)y2 * (size_t)(n == 2)) + (size_t)pm * 256 * 1024 * 2; u.B0 = u.B1 = wbt + (size_t)(n * 1024 + pn * 256) * 1024 * 2; u.bias = nullptr; }
    u.out = nullptr; u.ldc = 1024; u.sub = kind; u.row0 = pm * 256; u.col0 = pn * 256; u.aux0 = 0; u.aux1 = 0; return true;
  }
};
struct SchedLru {
  const char* u_; const char* wl; int G, c;
  __device__ __forceinline__ bool next(int i, UnitD& u) const {
    const int L = i * G + c; if (L >= 512) return false;
    const int pm = (L & 7) * 8 + (L >> 6), pn = (L >> 3) & 7;
    u.A0 = u.A1 = u_ + ((size_t)pm * 256 * 1024 + (pn >> 1) * 256) * 2; u.B0 = u.B1 = wl + (size_t)pn * 131072;
    u.out = nullptr; u.bias = nullptr; u.ldc = 1024; u.sub = 0; u.row0 = pm * 256; u.col0 = (pn >> 1) * 256 + (pn & 1) * 128; u.aux0 = 0; u.aux1 = 0; return true;
  }
};

template <int NR>
__device__ __forceinline__ void rmsnorm_rows_bf16(const float* xr, const float* g, bf16_t* o, int lane) {
  f32x4 v[NR][4]; float s[NR];
#pragma unroll
  for (int r = 0; r < NR; ++r)
#pragma unroll
    for (int j = 0; j < 4; ++j) v[r][j] = ((const f32x4*)(xr + (size_t)r * 1024))[lane + 64 * j];
#pragma unroll
  for (int r = 0; r < NR; ++r) { float t = 0.f;
#pragma unroll
    for (int j = 0; j < 4; ++j) t += (v[r][j].x * v[r][j].x + v[r][j].y * v[r][j].y) + (v[r][j].z * v[r][j].z + v[r][j].w * v[r][j].w);
    s[r] = 1.0f / sqrtf(wave_sum(t) * (1.0f / 1024.0f) + 1e-6f); }
#pragma unroll
  for (int j = 0; j < 4; ++j) { const f32x4 gg = ((const f32x4*)g)[lane + 64 * j];
#pragma unroll
    for (int r = 0; r < NR; ++r) { u32x2 w; w.x = pk2(v[r][j].x * s[r] * gg.x, v[r][j].y * s[r] * gg.y); w.y = pk2(v[r][j].z * s[r] * gg.z, v[r][j].w * s[r] * gg.w); ((u32x2*)(o + (size_t)r * 1024))[lane + 64 * j] = w; } }
}
__device__ __forceinline__ void rmsnorm_row_bf16(const float* xr, const float* g, bf16_t* o, int lane) { rmsnorm_rows_bf16<1>(xr, g, o, lane); }

template <class RowMap>
__device__ __forceinline__ void transpose_tile(const float* __restrict__ src, int N, int K, int k0, int n0, bf16_t* dst, RowMap rm, float scale, LAS float* scr) {
  const int tid = threadIdx.x;
  { const int n4 = tid & 15, kk = tid >> 4;
    f32x4 a[4], b[4];
#pragma unroll
    for (int cb = 0; cb < 4; ++cb) { a[cb] = *(const f32x4*)(src + (size_t)(k0 + kk) * N + n0 + cb * 64 + 4 * n4); b[cb] = *(const f32x4*)(src + (size_t)(k0 + kk + 32) * N + n0 + cb * 64 + 4 * n4); }
#pragma unroll
    for (int cb = 0; cb < 4; ++cb) { LAS float* s0 = scr + kk * 261 + cb * 64 + 4 * n4; LAS float* s1 = s0 + 32 * 261;
      s0[0] = a[cb].x; s0[1] = a[cb].y; s0[2] = a[cb].z; s0[3] = a[cb].w; s1[0] = b[cb].x; s1[1] = b[cb].y; s1[2] = b[cb].z; s1[3] = b[cb].w; } }
  __syncthreads();
#pragma unroll
  for (int cb = 0; cb < 4; ++cb) { const int nn = cb * 64 + (tid >> 3), kc = tid & 7; const LAS float* s = scr + (kc * 8) * 261 + nn;
    u32x4 o; o.x = pk2(s[0] * scale, s[261] * scale); o.y = pk2(s[522] * scale, s[783] * scale); o.z = pk2(s[1044] * scale, s[1305] * scale); o.w = pk2(s[1566] * scale, s[1827] * scale);
    *(u32x4*)(dst + (size_t)rm(n0 + nn) * K + k0 + kc * 8) = o; }
  __syncthreads();
}
struct RmId { __device__ __forceinline__ int operator()(int n) const { return n; } };
struct RmWin { __device__ __forceinline__ int operator()(int n) const { const int b = n >> 10; const int mb = b == 0 ? 1 : b == 1 ? 3 : b == 2 ? 0 : b == 3 ? 4 : b == 4 ? 2 : b; return mb * 1024 + (n & 1023); } };
struct RmLru { int mat; __device__ __forceinline__ int operator()(int o) const { const int pnl = o >> 7, cl = o & 127; return pnl * 256 + 128 * (cl >> 6) + 32 * ((cl >> 4) & 3) + 8 * ((cl >> 2) & 3) + 4 * mat + (cl & 3); } };

template <bool MAX>
__device__ __forceinline__ float block_excl_scan(float v, LAS float* tmp) {
  const int lane = threadIdx.x & 63, wid = threadIdx.x >> 6;
  const float ident = MAX ? -3.0e38f : 0.f;
  float inc = v;
#pragma unroll
  for (int o = 1; o < 64; o <<= 1) { const float y = __shfl_up(inc, o); if (lane >= o) inc = MAX ? fmaxf(inc, y) : inc + y; }
  if (lane == 63) tmp[wid] = inc;
  __syncthreads();
  float base = ident;
  for (int w = 0; w < wid; ++w) base = MAX ? fmaxf(base, tmp[w]) : base + tmp[w];
  float ex = __shfl_up(inc, 1); if (lane == 0) ex = ident;
  __syncthreads();
  return MAX ? fmaxf(base, ex) : base + ex;
}

template <bool MLSTM>
__device__ __forceinline__ void conv_rows(const Params& p, const bf16_t* src, bf16_t* dst, const float* cw, const float* cb, float* gates, const float* b_if, LAS float* wxc, LAS float* wxm, int gw, int NW, int lane) {
  for (int t = gw; t < T; t += NW) {
    const int tl = t & (SEQ - 1);
    float g[8];
#pragma unroll
    for (int j = 0; j < 8; ++j) g[j] = 0.f;
#pragma unroll
    for (int i = 0; i < 2; ++i) { const int c0 = i * 512 + lane * 8;
      float o[8], xm[8];
      { const f32x4 a = *(const f32x4*)(cb + c0), b = *(const f32x4*)(cb + c0 + 4);
        o[0] = a.x; o[1] = a.y; o[2] = a.z; o[3] = a.w; o[4] = b.x; o[5] = b.y; o[6] = b.z; o[7] = b.w; }
#pragma unroll
      for (int e = 0; e < 8; ++e) xm[e] = 0.f;
#pragma unroll
      for (int k = 0; k < 4; ++k) {
        if (tl - 3 + k >= 0) {
          const u32x4 v = *(const u32x4*)(src + (size_t)(t - 3 + k) * 1024 + c0);
          const f32x4 wa = *(const f32x4*)(cw + k * 1024 + c0), wb = *(const f32x4*)(cw + k * 1024 + c0 + 4);
          const float xv[8] = {bf_lo(v.x), bf_hi(v.x), bf_lo(v.y), bf_hi(v.y), bf_lo(v.z), bf_hi(v.z), bf_lo(v.w), bf_hi(v.w)};
          const float wv[8] = {wa.x, wa.y, wa.z, wa.w, wb.x, wb.y, wb.z, wb.w};
#pragma unroll
          for (int e = 0; e < 8; ++e) { o[e] += wv[e] * xv[e]; if (k == 3) xm[e] = xv[e]; }
        }
      }
      if (MLSTM) {
#pragma unroll
        for (int e = 0; e < 8; ++e) o[e] = o[e] * sigm(o[e]);
#pragma unroll
        for (int e = 0; e < 8; ++e) { const int c = c0 + e;
          const f32x4 a0 = *(const LAS f32x4*)(wxc + c * 8), a1 = *(const LAS f32x4*)(wxc + c * 8 + 4), m0 = *(const LAS f32x4*)(wxm + c * 8), m1 = *(const LAS f32x4*)(wxm + c * 8 + 4);
          g[0] += o[e] * a0.x + xm[e] * m0.x; g[1] += o[e] * a0.y + xm[e] * m0.y; g[2] += o[e] * a0.z + xm[e] * m0.z; g[3] += o[e] * a0.w + xm[e] * m0.w;
          g[4] += o[e] * a1.x + xm[e] * m1.x; g[5] += o[e] * a1.y + xm[e] * m1.y; g[6] += o[e] * a1.z + xm[e] * m1.z; g[7] += o[e] * a1.w + xm[e] * m1.w; }
      }
      u32x4 ov; ov.x = pk2(o[0], o[1]); ov.y = pk2(o[2], o[3]); ov.z = pk2(o[4], o[5]); ov.w = pk2(o[6], o[7]);
      *(u32x4*)(dst + (size_t)t * 1024 + c0) = ov;
    }
    if (MLSTM) {
#pragma unroll
      for (int j = 0; j < 8; ++j) g[j] = wave_sum(g[j]);
      if (lane == 0) {
        f32x4 o0, o1;
        o0.x = g[0] + b_if[0]; o0.y = g[1] + b_if[1]; o0.z = g[2] + b_if[2]; o0.w = g[3] + b_if[3];
        o1.x = logsigm(g[4] + b_if[4]); o1.y = logsigm(g[5] + b_if[5]); o1.z = logsigm(g[6] + b_if[6]); o1.w = logsigm(g[7] + b_if[7]);
        *(f32x4*)(gates + (size_t)t * 8) = o0; *(f32x4*)(gates + (size_t)t * 8 + 4) = o1;
      }
    }
  }
}

template <bool SILU>
__device__ __forceinline__ void conv_stream(const bf16_t* src, bf16_t* dst, const float* cw, const float* cb, int gtid, int GT) {
  for (int g = gtid; g < 131072; g += GT) {
    const int cg = g & 127, tb = g >> 7, c0 = cg * 8, t0 = tb * 16;
    const bool first = ((t0 & (SEQ - 1)) == 0);
    u32x4 xr[19];
#pragma unroll
    for (int i = 0; i < 19; ++i) { if (i < 3 && first) xr[i] = (u32x4){0u, 0u, 0u, 0u}; else xr[i] = *(const u32x4*)(src + (size_t)(t0 - 3 + i) * 1024 + c0); }
    float w[4][8], bs[8];
#pragma unroll
    for (int k = 0; k < 4; ++k) { const f32x4 a = *(const f32x4*)(cw + k * 1024 + c0), b = *(const f32x4*)(cw + k * 1024 + c0 + 4);
      w[k][0] = a.x; w[k][1] = a.y; w[k][2] = a.z; w[k][3] = a.w; w[k][4] = b.x; w[k][5] = b.y; w[k][6] = b.z; w[k][7] = b.w; }
    { const f32x4 a = *(const f32x4*)(cb + c0), b = *(const f32x4*)(cb + c0 + 4); bs[0] = a.x; bs[1] = a.y; bs[2] = a.z; bs[3] = a.w; bs[4] = b.x; bs[5] = b.y; bs[6] = b.z; bs[7] = b.w; }
#pragma unroll
    for (int t = 0; t < 16; ++t) {
      float o[8];
#pragma unroll
      for (int e = 0; e < 8; ++e) o[e] = bs[e];
#pragma unroll
      for (int k = 0; k < 4; ++k) { const u32x4 v = xr[t + k];
        o[0] += w[k][0] * bf_lo(v.x); o[1] += w[k][1] * bf_hi(v.x); o[2] += w[k][2] * bf_lo(v.y); o[3] += w[k][3] * bf_hi(v.y);
        o[4] += w[k][4] * bf_lo(v.z); o[5] += w[k][5] * bf_hi(v.z); o[6] += w[k][6] * bf_lo(v.w); o[7] += w[k][7] * bf_hi(v.w); }
      if (SILU) {
#pragma unroll
        for (int e = 0; e < 8; ++e) o[e] = o[e] * sigm(o[e]); }
      u32x4 ov; ov.x = pk2(o[0], o[1]); ov.y = pk2(o[2], o[3]); ov.z = pk2(o[4], o[5]); ov.w = pk2(o[6], o[7]);
      *(u32x4*)(dst + (size_t)(t0 + t) * 1024 + c0) = ov;
    }
  }
}
__device__ __forceinline__ void gates_gemm(const bf16_t* xc, const bf16_t* xm, const bf16_t* wgT, float* part, int gw, int NW, int lane) {
  const int i16 = lane & 15, kg = lane >> 4;
  for (int item = gw; item < 2048; item += NW) {
    const int tile = item >> 1, half = item & 1, tok0 = tile * 16;
    f32x4 acc = {0.f, 0.f, 0.f, 0.f};
    const bf16_t* ap = (half ? xm : xc) + (size_t)(tok0 + i16) * 1024 + kg * 8;
    const bf16_t* bp = wgT + (size_t)i16 * 2048 + half * 1024 + kg * 8;
#pragma unroll 16
    for (int ks = 0; ks < 32; ++ks) { const bf16x8 a = *(const bf16x8*)(ap + ks * 32), b = *(const bf16x8*)(bp + ks * 32); acc = __builtin_amdgcn_mfma_f32_16x16x32_bf16(a, b, acc, 0, 0, 0); }
    if (i16 < 8) *(f32x4*)(part + ((size_t)half * 8 + i16) * T + tok0 + 4 * kg) = acc;
  }
}

#define XB_TMO      128
#define XB_XCNT(j)  (256  + 64 * (j))
#define XB_XSUB(j)  (1280 + 64 * (j))
#define XB_XGEN(j)  (2304 + 64 * (j))
#define XB_TOP      3328
#define XB_TOPGEN   3392
#define XCD_BAR_WORDS 3456
#define XB_SPIN_CAP (1u << 18)
__device__ __forceinline__ unsigned xb_ld(unsigned* p)              { return __hip_atomic_load(p, __ATOMIC_RELAXED, __HIP_MEMORY_SCOPE_AGENT); }
__device__ __forceinline__ unsigned xb_add(unsigned* p, unsigned v) { return __hip_atomic_fetch_add(p, v, __ATOMIC_RELAXED, __HIP_MEMORY_SCOPE_AGENT); }
__device__ __forceinline__ unsigned xb_xcc_id() { return (unsigned)__builtin_amdgcn_s_getreg((3 << 11) | 20) & 0xFu; }
#define XB_SPIN(cond, bar) do { unsigned _sp = 0; while (cond) { __builtin_amdgcn_s_sleep(1); \
    if ((++_sp & 255u) == 0u) { if (xb_ld(&(bar)[XB_TMO])) break; if (_sp > XB_SPIN_CAP) { atomicAdd(&(bar)[XB_TMO], 1u); break; } } } } while (0)
struct XcdBarrier { unsigned* bar; unsigned x; volatile LAS unsigned* st; };
__device__ __forceinline__ XcdBarrier xcd_barrier_post(unsigned* bar, volatile LAS unsigned* st) {
    XcdBarrier b; b.bar = bar; b.x = xb_xcc_id(); b.st = st;
    if (threadIdx.x == 0) (void)xb_add(&bar[XB_XCNT(b.x)], 1u);
    return b;
}
__device__ __forceinline__ void xcd_barrier_complete(unsigned* bar, unsigned x, unsigned& nloc, unsigned& nx) {
    const unsigned G = gridDim.x * gridDim.y * gridDim.z;
    unsigned sum, cnt, mine, sp = 0u;
    for (;;) {
        sum = 0u; cnt = 0u; mine = 0u;
#pragma unroll
        for (unsigned j = 0; j < 16; ++j) { const unsigned c = xb_ld(&bar[XB_XCNT(j)]); sum += c; cnt += (c > 0u) ? 1u : 0u; mine = (j == x) ? c : mine; }
        if (sum == G) break;
        __builtin_amdgcn_s_sleep(1);
        if ((++sp & 255u) == 0u) { if (xb_ld(&bar[XB_TMO])) break; if (sp > XB_SPIN_CAP) { atomicAdd(&bar[XB_TMO], 1u); break; } }
    }
    nloc = mine > 0u ? mine : 1u; nx = cnt > 0u ? cnt : 1u;
}
__device__ __forceinline__ void xcd_barrier(const XcdBarrier& b) {
    asm volatile("s_waitcnt vmcnt(0)" ::: "memory");
    __syncthreads();
    if (threadIdx.x == 0) {
        unsigned* bar = b.bar;
        __builtin_amdgcn_s_waitcnt(0);
        unsigned nloc = b.st[0], nx = b.st[1];
        if (nloc == 0u) { xcd_barrier_complete(bar, b.x, nloc, nx); b.st[0] = nloc; b.st[1] = nx; }
        const unsigned old = xb_add(&bar[XB_XSUB(b.x)], 1u);
        const unsigned gen = old / nloc;
        if (old + 1u == (gen + 1u) * nloc) {
            __builtin_amdgcn_fence(__ATOMIC_RELEASE, "agent");
            asm volatile("s_waitcnt vmcnt(0)" ::: "memory");
            const unsigned og = xb_add(&bar[XB_TOP], 1u);
            const unsigned tg = og / nx;
            if (og + 1u == (tg + 1u) * nx) xb_add(&bar[XB_TOPGEN], 1u);
            else XB_SPIN(xb_ld(&bar[XB_TOPGEN]) == tg, bar);
            __builtin_amdgcn_fence(__ATOMIC_ACQUIRE, "agent");
            xb_add(&bar[XB_XGEN(b.x)], 1u);
            asm volatile("s_waitcnt vmcnt(0)" ::: "memory");
        } else {
            XB_SPIN(xb_ld(&bar[XB_XGEN(b.x)]) == gen, bar);
            __builtin_amdgcn_fence(__ATOMIC_ACQUIRE, "agent");
            asm volatile("s_waitcnt vmcnt(0)" ::: "memory");
        }
    }
    __syncthreads();
}

#define W0 ((char*)p.ws + O_SLOTS)
#define W1 ((char*)p.ws + O_SLOTS + SLOT)
#define W2 ((char*)p.ws + O_SLOTS + 2 * SLOT)
#define W3 ((char*)p.ws + O_SLOTS + 3 * SLOT)
#define W4 ((char*)p.ws + O_SLOTS + 4 * SLOT)
#define W5 ((char*)p.ws + O_SLOTS + 5 * SLOT)
#define D0 ((char*)p.out)
#define D1 ((char*)p.out + SLOT)
#define WinT ((const char*)p.ws + O_WINT)
#define WbT ((const char*)p.ws + O_WBT)
#define WoutT ((const char*)p.ws + O_WOUTT)
#define WkvT ((const char*)p.ws + O_WKVT)
#define WqT ((const char*)p.ws + O_WQT)
#define WkT ((const char*)p.ws + O_WKT)
#define WvT ((const char*)p.ws + O_WVT)
#define WoT ((const char*)p.ws + O_WOT)
#define WlruT ((const char*)p.ws + O_WLRUT)
#define binR ((float*)(p.ws + O_BINR))
#define Wxc ((float*)(p.ws + O_WXC))
#define Wxm ((float*)(p.ws + O_WXM))
#define gates ((float*)(p.ws + O_GATES))
#define Bc ((float*)(p.ws + O_BC))
#define Av ((float*)(p.ws + O_AV))
#define Mt ((float*)(p.ws + O_MT))
#define denp ((float*)(p.ws + O_DENP))
#define nkloc ((float*)(p.ws + O_NKLOC))
#define nprev ((float*)(p.ws + O_NPREV))
#define Kmem ((char*)p.ws + O_KMEM)
#define VmemT ((char*)p.ws + O_VMEMT)
#define memN ((char*)p.ws + O_MEMN)
#define hend ((float*)(p.ws + O_HEND))
#define slog ((float*)(p.ws + O_SLOG))
#define carry ((float*)(p.ws + O_CARRY))
__device__ __forceinline__ void transpose_item(const Params& p, int it, LAS float* ldsf) {
  int r = it;
  if (r < 576) { transpose_tile(p.in[3], 9216, 1024, (r / 36) * 64, (r % 36) * 256, (bf16_t*)WinT, RmWin(), 1.0f, ldsf); return; } r -= 576;
  if (r < 192) { const int n_ = r >> 6, q = r & 63; transpose_tile(p.in[25] + (size_t)n_ * 1048576, 1024, 1024, (q >> 2) * 64, (q & 3) * 256, (bf16_t*)WbT + (size_t)n_ * 1048576, RmId(), 1.0f, ldsf); return; } r -= 192;
  if (r < 64) { transpose_tile(p.in[26], 1024, 1024, (r >> 2) * 64, (r & 3) * 256, (bf16_t*)WoutT, RmId(), 1.0f, ldsf); return; } r -= 64;
  if (r < 128) { transpose_tile(p.in[24], 2048, 1024, (r >> 3) * 64, (r & 7) * 256, (bf16_t*)WkvT, RmId(), 1.0f, ldsf); return; } r -= 128;
  if (r < 64) { const int mat = r >> 4, q = r & 15, h = q >> 2, kb = q & 3;
    const float* srcp = (mat == 0 ? p.in[14] : mat == 1 ? p.in[15] : mat == 2 ? p.in[16] : p.in[17]) + (size_t)h * 65536;
    bf16_t* dstp = (bf16_t*)WqT + (size_t)mat * 262144 + (size_t)h * 65536;
    transpose_tile(srcp, 256, 256, kb * 64, 0, dstp, RmId(), mat == 1 ? 0.0625f : 1.0f, ldsf); return; } r -= 64;
  { const int mat = r >> 4, q = r & 15, g = q >> 2, kb = q & 3; RmLru rm; rm.mat = mat;
    transpose_tile((mat == 0 ? p.in[7] : p.in[9]) + (size_t)g * 65536, 256, 256, kb * 64, 0, (bf16_t*)WlruT + (size_t)g * 131072, rm, 1.0f, ldsf); }
}

constexpr unsigned ALLPH = (1u << 18) - 1u;
template <unsigned MASK>
__global__ void __launch_bounds__(512) mk_fwd(Params p) {
  extern __shared__ __attribute__((aligned(16))) unsigned char smem[];
  LAS unsigned char* lds = (LAS unsigned char*)smem;
  LAS float* ldsf = (LAS float*)lds;
  LAS float* xP = (LAS float*)(lds + STAGE_BYTES);
  LAS float* xD = (LAS float*)(lds + STAGE_BYTES + 4096);
  LAS float* xW = (LAS float*)(lds + STAGE_BYTES + 5120);
  LAS float* xT = (LAS float*)(lds + STAGE_BYTES + 7168);
  cg::grid_group grid = cg::this_grid();
  volatile LAS unsigned* xst = (volatile LAS unsigned*)(lds + STAGE_BYTES + 8192);
  if (threadIdx.x == 0) { xst[0] = 0u; xst[1] = 0u; }
  __syncthreads();
  XcdBarrier xb; if constexpr (MASK == ALLPH) xb = xcd_barrier_post((unsigned*)(p.ws + O_BAR), xst);
  const int G = gridDim.x, wg = blockIdx.x, NW = G * 8, GT = G * 512;
  const float* x = p.in[0];

  if constexpr ((MASK >> 0) & 1) {
  int tid = threadIdx.x; asm volatile("" : "+v"(tid)); const int lane = tid & 63, wid = tid >> 6, gw = wg * 8 + wid, gtid = wg * 512 + tid; (void)lane; (void)gw; (void)gtid;
  {
    for (int e = wg; e < 256; e += G) {
      const int it = e < 64 ? (e >> 2) * 36 + 8 + (e & 3) : e < 192 ? 832 + (e - 64) : 960 + (e - 192);
      transpose_item(p, it, ldsf);
    }
    for (int row = gw * 4; row < T; row += NW * 4) rmsnorm_rows_bf16<4>(x + (size_t)row * 1024, p.in[2], (bf16_t*)W0 + (size_t)row * 1024, lane);
    for (int row = gw; row < 512; row += NW) rmsnorm_row_bf16(p.in[1] + (size_t)row * 1024, p.in[23], (bf16_t*)memN + (size_t)row * 1024, lane);
    for (int w = gw; w < 2048; w += NW) {
      const int which = w >> 10, i = w & 1023, h = i >> 8, ii = i & 255;
      float a[8];
#pragma unroll
      for (int j = 0; j < 8; ++j) a[j] = 0.f;
      const float* wif = p.in[19];
#pragma unroll
      for (int jj = 0; jj < 4; ++jj) { const int o = lane + 64 * jj;
        if (which == 0) {
          const float wq = p.in[14][(size_t)h * 65536 + ii * 256 + o], wk = p.in[15][(size_t)h * 65536 + ii * 256 + o];
          const f32x4 q0 = *(const f32x4*)(wif + (size_t)(h * 256 + o) * 8), q1 = *(const f32x4*)(wif + (size_t)(h * 256 + o) * 8 + 4);
          const f32x4 k0 = *(const f32x4*)(wif + (size_t)(1024 + h * 256 + o) * 8), k1 = *(const f32x4*)(wif + (size_t)(1024 + h * 256 + o) * 8 + 4);
          a[0] += wq * q0.x + wk * k0.x; a[1] += wq * q0.y + wk * k0.y; a[2] += wq * q0.z + wk * k0.z; a[3] += wq * q0.w + wk * k0.w;
          a[4] += wq * q1.x + wk * k1.x; a[5] += wq * q1.y + wk * k1.y; a[6] += wq * q1.z + wk * k1.z; a[7] += wq * q1.w + wk * k1.w;
        } else {
          const float wv = p.in[16][(size_t)h * 65536 + ii * 256 + o];
          const f32x4 v0 = *(const f32x4*)(wif + (size_t)(2048 + h * 256 + o) * 8), v1 = *(const f32x4*)(wif + (size_t)(2048 + h * 256 + o) * 8 + 4);
          a[0] += wv * v0.x; a[1] += wv * v0.y; a[2] += wv * v0.z; a[3] += wv * v0.w; a[4] += wv * v1.x; a[5] += wv * v1.y; a[6] += wv * v1.z; a[7] += wv * v1.w;
        } }
#pragma unroll
      for (int j = 0; j < 8; ++j) a[j] = wave_sum(a[j]);
      if (lane == 0) { bf16_t* d = (bf16_t*)(p.ws + O_WGT) + which * 1024 + i;
#pragma unroll
        for (int j = 0; j < 8; ++j) { d[(size_t)j * 2048] = (bf16_t)(pk2(a[j], 0.f) & 0xffffu); d[(size_t)(8 + j) * 2048] = 0; } }
    }
    for (int n = gtid; n < 9216; n += GT) binR[RmWin()((int)n)] = p.in[4][n];
  }
  }
  if constexpr (MASK == ALLPH) xcd_barrier(xb);

  if constexpr ((MASK >> 1) & 1) {
  int tid = threadIdx.x; asm volatile("" : "+v"(tid)); const int lane = tid & 63, wid = tid >> 6, gw = wg * 8 + wid, gtid = wg * 512 + tid; (void)lane; (void)gw; (void)gtid;
  {
    SchedTiles S; S.A = W0; S.Bt = WinT; S.out0 = W1; S.out1 = W1; S.bias = binR; S.nN = 4; S.G = G; S.c = wg;
    EpiBf16 E; E.m_Av = Av; E.m_Mt = Mt;
    gemm_phase<SchedTiles, EpiBf16, false>(lds, 1024, 1024, 16, 16, S, E);
  }
  }
  if constexpr (MASK == ALLPH) xcd_barrier(xb);

  if constexpr ((MASK >> 2) & 1) {
  int tid = threadIdx.x; asm volatile("" : "+v"(tid)); const int lane = tid & 63, wid = tid >> 6, gw = wg * 8 + wid, gtid = wg * 512 + tid; (void)lane; (void)gw; (void)gtid;
  {
    conv_stream<true>((const bf16_t*)W1, (bf16_t*)W2, p.in[12], p.in[13], gtid, GT);
  }
  }
  if constexpr (MASK == ALLPH) xcd_barrier(xb);

  if constexpr ((MASK >> 3) & 1) {
  int tid = threadIdx.x; asm volatile("" : "+v"(tid)); const int lane = tid & 63, wid = tid >> 6, gw = wg * 8 + wid, gtid = wg * 512 + tid; (void)lane; (void)gw; (void)gtid;
  {
    EpiBf16 E; E.m_Av = Av; E.m_Mt = Mt;
    SchedP3X SX; SX.xc = W2; SX.mx = W1; SX.wq = WqT; SX.wk = WkT; SX.wo = WoT; SX.q = W3; SX.k = W4; SX.og = W5; SX.b_o = p.in[18]; SX.G = G; SX.c = wg;
    gemm_phase<SchedP3X, EpiBf16, false>(lds, 1024, 256, 4, 4, SX, E);
    gates_gemm((const bf16_t*)W2, (const bf16_t*)W1, (const bf16_t*)(p.ws + O_WGT), gates, gw, NW, lane);
  }
  }
  if constexpr (MASK == ALLPH) xcd_barrier(xb);

  if constexpr ((MASK >> 4) & 1) {
  int tid = threadIdx.x; asm volatile("" : "+v"(tid)); const int lane = tid & 63, wid = tid >> 6, gw = wg * 8 + wid, gtid = wg * 512 + tid; (void)lane; (void)gw; (void)gtid;
  if (wg < 8) {
    const int b = wg >> 2, h = wg & 3;
    const size_t t0 = (size_t)b * SEQ + (size_t)tid * 16;
    float c[16], ig[16];
    float run = 0.f;
    { const float bi = p.in[20][h], bf = p.in[20][4 + h];
      const float* gi0 = gates + (size_t)h * T + t0; const float* gi1 = gates + (size_t)(8 + h) * T + t0;
      const float* gf0 = gates + (size_t)(4 + h) * T + t0; const float* gf1 = gates + (size_t)(12 + h) * T + t0;
#pragma unroll
      for (int k4 = 0; k4 < 4; ++k4) { const f32x4 a0 = *(const f32x4*)(gi0 + 4 * k4), a1 = *(const f32x4*)(gi1 + 4 * k4), f0 = *(const f32x4*)(gf0 + 4 * k4), f1 = *(const f32x4*)(gf1 + 4 * k4);
#pragma unroll
        for (int e = 0; e < 4; ++e) { ig[4 * k4 + e] = a0[e] + a1[e] + bi; run += logsigm(f0[e] + f1[e] + bf); c[4 * k4 + e] = run; } } }
    const float off = block_excl_scan<false>(run, xT);
    float pmx = -3.0e38f;
#pragma unroll
    for (int k = 0; k < 16; ++k) { c[k] += off; ig[k] = ig[k] - c[k]; pmx = fmaxf(pmx, ig[k]); }
    const float offm = block_excl_scan<true>(pmx, xT);
    float rm = offm;
#pragma unroll
    for (int k = 0; k < 16; ++k) { rm = fmaxf(rm, ig[k]); const float mtv = fmaxf(rm, 0.f); Bc[(t0 + k) * 4 + h] = c[k] + mtv;   Av[(t0 + k) * 4 + h] = ig[k]; Mt[(t0 + k) * 4 + h] = mtv; }
  } else if (wg < 24) {
    const int idx = wg - 8; SchedOne S; S.has = true;
    if (idx < 8) { const int pm = idx >> 2, pn = idx & 3;
      S.u.A0 = S.u.A1 = memN + (size_t)pm * 256 * 1024 * 2; S.u.B0 = S.u.B1 = WkvT + (size_t)pn * 256 * 1024 * 2; S.u.out = Kmem + ((size_t)pm * 256 * 1024 + pn * 256) * 2; S.u.ldc = 1024; }
    else { const int pm = (idx - 8) >> 1, b = (idx - 8) & 1;
      S.u.A0 = S.u.A1 = WkvT + (size_t)(1024 + pm * 256) * 1024 * 2; S.u.B0 = S.u.B1 = memN + (size_t)b * 256 * 1024 * 2; S.u.out = VmemT + (size_t)(b * 1024 + pm * 256) * 256 * 2; S.u.ldc = 256; }
    S.u.bias = nullptr; S.u.sub = 0; S.u.row0 = 0; S.u.col0 = 0; S.u.aux0 = 0; S.u.aux1 = 0;
    EpiBf16 E; E.m_Av = Av; E.m_Mt = Mt;
    gemm_phase<SchedOne, EpiBf16, false>(lds, 1024, 1024, 16, 16, S, E);
  } else {
    for (int l = wg - 24; l < 800; l += G - 24) {
      int it;
      if (l < 512) { const int j = l & 31; it = (l >> 5) * 36 + (j < 8 ? j : j + 4); }
      else if (l < 704) it = 576 + (l - 512); else if (l < 768) it = 768 + (l - 704); else it = 1024 + (l - 768);
      transpose_item(p, it, ldsf);
    }
    EpiBf16 E; E.m_Av = Av; E.m_Mt = Mt;
    SchedP3Y SY; SY.xc = W2; SY.mx = W1; SY.wk = WkT; SY.wv = WvT; SY.vt = D0; SY.ktw = D1; SY.G = G - 24; SY.c = wg - 24; SY.base = 0; SY.count = 256;
    gemm_phase<SchedP3Y, EpiBf16, false>(lds, 256, 1024, 4, 4, SY, E);
  }
  }
  if constexpr (MASK == ALLPH) xcd_barrier(xb);

  if constexpr ((MASK >> 5) & 1) {
  int tid = threadIdx.x; asm volatile("" : "+v"(tid)); const int lane = tid & 63, wid = tid >> 6, gw = wg * 8 + wid, gtid = wg * 512 + tid; (void)lane; (void)gw; (void)gtid;
  { EpiBf16 E; E.m_Av = Av; E.m_Mt = Mt;
    SchedP3Y SY; SY.xc = W2; SY.mx = W1; SY.wk = WkT; SY.wv = WvT; SY.vt = D0; SY.ktw = D1; SY.G = G; SY.c = wg; SY.base = 256; SY.count = 256;
    gemm_phase<SchedP3Y, EpiBf16, false>(lds, 256, 1024, 4, 4, SY, E);
    asm volatile("s_waitcnt vmcnt(0)" ::: "memory"); __syncthreads(); }
  if (wg < 256) { const int unit = wg;
    const int bh = unit >> 5, ci = unit & 31, b = bh >> 2, h = bh & 3, tok0 = b * SEQ + ci * 256;
    { SchedOne S; S.has = true; S.u.A0 = S.u.A1 = D0 + (size_t)unit * 131072; S.u.B0 = S.u.B1 = D1 + (size_t)unit * 131072; S.u.out = W1 + (size_t)unit * 131072; S.u.bias = nullptr; S.u.ldc = 256; S.u.sub = 0;
      S.u.row0 = tok0; S.u.col0 = 0; S.u.aux0 = h; S.u.aux1 = unit;
      EpiBf16 E; E.m_Av = Av; E.m_Mt = Mt;
      gemm_phase<SchedOne, EpiBf16, false>(lds, 256, 256, 4, 4, S, E); }
    { SchedOne S; S.has = true; const size_t to = ((size_t)tok0 * 1024 + h * 256) * 2;
      S.u.A0 = S.u.A1 = W3 + to; S.u.B0 = S.u.B1 = W4 + to; S.u.out = W0 + to; S.u.bias = nullptr; S.u.ldc = 1024; S.u.sub = 0; S.u.row0 = tok0; S.u.col0 = 0; S.u.aux0 = h; S.u.aux1 = unit;
      EpiU1 E; E.m_Av = Av; E.m_Mt = Mt; E.m_denp = denp;
      gemm_phase<SchedOne, EpiU1, false>(lds, 1024, 1024, 4, 4, S, E); }
    { const float mprev = ci == 0 ? 0.f : Mt[(size_t)(tok0 - 1) * 4 + h];
      const int r = tid >> 1, hf = tid & 1;
      const float sc = __expf(mprev - Mt[(size_t)(tok0 + r) * 4 + h]);
      u32x4* qp = (u32x4*)((bf16_t*)W3 + (size_t)(tok0 + r) * 1024 + h * 256 + hf * 128);
      u32x4 v[16];
#pragma unroll
      for (int i = 0; i < 16; ++i) v[i] = qp[i];
#pragma unroll
      for (int i = 0; i < 16; ++i) { u32x4 o;
        o.x = pk2(bf_lo(v[i].x) * sc, bf_hi(v[i].x) * sc); o.y = pk2(bf_lo(v[i].y) * sc, bf_hi(v[i].y) * sc); o.z = pk2(bf_lo(v[i].z) * sc, bf_hi(v[i].z) * sc); o.w = pk2(bf_lo(v[i].w) * sc, bf_hi(v[i].w) * sc); qp[i] = o; } }
    { const float me = Mt[(size_t)(tok0 + 255) * 4 + h];
      if (tid < 256) xW[tid] = __expf(Av[(size_t)(tok0 + tid) * 4 + h] - me);
      __syncthreads();
      const int cg8 = tid & 31, sg = tid >> 5;
      const bf16_t* kp = (const bf16_t*)W4 + (size_t)(tok0 + sg * 16) * 1024 + h * 256 + cg8 * 8;
      u32x4 v[16];
#pragma unroll
      for (int i = 0; i < 16; ++i) v[i] = *(const u32x4*)(kp + (size_t)i * 1024);
      float a[8];
#pragma unroll
      for (int j = 0; j < 8; ++j) a[j] = 0.f;
#pragma unroll
      for (int i = 0; i < 16; ++i) { const float w = xW[sg * 16 + i];
        a[0] += w * bf_lo(v[i].x); a[1] += w * bf_hi(v[i].x); a[2] += w * bf_lo(v[i].y); a[3] += w * bf_hi(v[i].y); a[4] += w * bf_lo(v[i].z); a[5] += w * bf_hi(v[i].z); a[6] += w * bf_lo(v[i].w); a[7] += w * bf_hi(v[i].w); }
#pragma unroll
      for (int j = 0; j < 8; ++j) ldsf[sg * 256 + cg8 * 8 + j] = a[j];
      __syncthreads();
      if (tid < 256) { float s = 0.f;
#pragma unroll
        for (int g2 = 0; g2 < 16; ++g2) s += ldsf[g2 * 256 + tid];
        nkloc[(size_t)unit * 256 + tid] = s; }
      __syncthreads(); }
  }
  }
  if constexpr (MASK == ALLPH) xcd_barrier(xb);

  if constexpr ((MASK >> 6) & 1) {
  int tid = threadIdx.x; asm volatile("" : "+v"(tid)); const int lane = tid & 63, wid = tid >> 6, gw = wg * 8 + wid, gtid = wg * 512 + tid; (void)lane; (void)gw; (void)gtid;
  {
    for (int g = gtid; g < 131072; g += GT) {
      const int bh = (int)(g >> 14), e4 = (int)(g & 16383), b = bh >> 2, h = bh & 3;
      u32x2* base = (u32x2*)((bf16_t*)W1 + (size_t)bh * 32 * 65536 + (size_t)e4 * 4);
      u32x2 kv[32]; float me[32];
#pragma unroll
      for (int c = 0; c < 32; ++c) { kv[c] = base[(size_t)c * 16384]; me[c] = Mt[(size_t)(b * SEQ + c * 256 + 255) * 4 + h]; }
      float C0 = 0.f, C1 = 0.f, C2 = 0.f, C3 = 0.f; float mprev = 0.f;
#pragma unroll
      for (int c = 0; c < 32; ++c) {
        const float dec = __expf(mprev - me[c]); mprev = me[c];
        u32x2 w; w.x = pk2(C0, C1); w.y = pk2(C2, C3); base[(size_t)c * 16384] = w;
        C0 = dec * C0 + bf_lo(kv[c].x); C1 = dec * C1 + bf_hi(kv[c].x); C2 = dec * C2 + bf_lo(kv[c].y); C3 = dec * C3 + bf_hi(kv[c].y);
      }
    }
    for (int g = gtid; g < 2048; g += GT) {
      const int bh = (int)(g >> 8), col = (int)(g & 255), b = bh >> 2, h = bh & 3;
      float nk[32], me[32];
#pragma unroll
      for (int c = 0; c < 32; ++c) { nk[c] = nkloc[(size_t)(bh * 32 + c) * 256 + col]; me[c] = Mt[(size_t)(b * SEQ + c * 256 + 255) * 4 + h]; }
      float n = 0.f, mprev = 0.f;
#pragma unroll
      for (int c = 0; c < 32; ++c) { const float dec = __expf(mprev - me[c]); mprev = me[c]; nprev[(size_t)(bh * 32 + c) * 256 + col] = n; n = dec * n + nk[c]; }
    }
    for (int row = gw * 4; row < T; row += NW * 4) rmsnorm_rows_bf16<4>(x + (size_t)row * 1024, p.in[2], (bf16_t*)W4 + (size_t)row * 1024, lane);
  }
  }
  if constexpr (MASK == ALLPH) xcd_barrier(xb);

  if constexpr ((MASK >> 7) & 1) {
  int tid = threadIdx.x; asm volatile("" : "+v"(tid)); const int lane = tid & 63, wid = tid >> 6, gw = wg * 8 + wid, gtid = wg * 512 + tid; (void)lane; (void)gw; (void)gtid;
  if (wg < 256) { const int unit = wg;
    const int bh = unit >> 5, ci = unit & 31, b = bh >> 2, h = bh & 3, tok0 = b * SEQ + ci * 256;
    { if (tid < 256) xW[tid] = nprev[(size_t)unit * 256 + tid];
      __syncthreads();
      const int r = tid >> 1, hf = tid & 1;
      const u32x4* qp = (const u32x4*)((const bf16_t*)W3 + (size_t)(tok0 + r) * 1024 + h * 256 + hf * 128);
      u32x4 v[16];
#pragma unroll
      for (int i = 0; i < 16; ++i) v[i] = qp[i];
      float s = 0.f;
#pragma unroll
      for (int i = 0; i < 16; ++i) { const LAS float* nv = xW + hf * 128 + i * 8;
        const f32x4 n0 = *(const LAS f32x4*)nv, n1 = *(const LAS f32x4*)(nv + 4);
        s += bf_lo(v[i].x) * n0.x + bf_hi(v[i].x) * n0.y + bf_lo(v[i].y) * n0.z + bf_hi(v[i].y) * n0.w + bf_lo(v[i].z) * n1.x + bf_hi(v[i].z) * n1.y + bf_lo(v[i].w) * n1.z + bf_hi(v[i].w) * n1.w; }
      s += __shfl_xor(s, 1);
      if (hf == 0) xD[r] = s;
      __syncthreads(); }
    SchedOne S; S.has = true; const size_t to = ((size_t)tok0 * 1024 + h * 256) * 2;
    S.u.A0 = W0 + to; S.u.A1 = W3 + to; S.u.B0 = D0 + (size_t)unit * 131072; S.u.B1 = W1 + (size_t)unit * 131072;
    S.u.out = nullptr; S.u.bias = nullptr; S.u.ldc = 1024; S.u.sub = 0; S.u.row0 = tok0; S.u.col0 = 0; S.u.aux0 = h; S.u.aux1 = unit;
    EpiU2 E; E.P = xP; E.deni = xD; E.m_denp = denp; E.m_Bc = Bc; E.m_Mt = Mt; E.og = (const bf16_t*)W5; E.norm_g = p.in[21]; E.skip = p.in[22]; E.xc = (bf16_t*)W2;
    gemm_phase<SchedOne, EpiU2, true>(lds, 1024, 256, 8, 4, S, E);
    __syncthreads();
  }
  }
  if constexpr (MASK == ALLPH) xcd_barrier(xb);

  if constexpr ((MASK >> 8) & 1) {
  int tid = threadIdx.x; asm volatile("" : "+v"(tid)); const int lane = tid & 63, wid = tid >> 6, gw = wg * 8 + wid, gtid = wg * 512 + tid; (void)lane; (void)gw; (void)gtid;
  {
    SchedTiles S; S.A = W4; S.Bt = WinT + (size_t)1024 * 1024 * 2; S.out0 = W0; S.out1 = W1; S.bias = binR + 1024; S.nN = 8; S.G = G; S.c = wg;
    EpiBf16 E; E.m_Av = Av; E.m_Mt = Mt;
    gemm_phase<SchedTiles, EpiBf16, false>(lds, 1024, 1024, 16, 16, S, E);
  }
  }
  if constexpr (MASK == ALLPH) xcd_barrier(xb);

  if constexpr ((MASK >> 9) & 1) {
  int tid = threadIdx.x; asm volatile("" : "+v"(tid)); const int lane = tid & 63, wid = tid >> 6, gw = wg * 8 + wid, gtid = wg * 512 + tid; (void)lane; (void)gw; (void)gtid;
  {
    conv_stream<false>((const bf16_t*)W0, (bf16_t*)W3, p.in[5], p.in[6], gtid, GT);
    if (wg < 256) { const int L = wg;
      const int pm = L >> 2, h = L & 3, b = pm >> 5;
      { SchedOne S; S.has = true;
        S.u.A0 = S.u.A1 = W1 + ((size_t)pm * 256 * 1024 + h * 256) * 2; S.u.B0 = S.u.B1 = Kmem + ((size_t)b * 256 * 1024 + h * 256) * 2; S.u.out = W5 + (size_t)L * 131072; S.u.bias = nullptr; S.u.ldc = 256; S.u.sub = 0;
        S.u.row0 = 0; S.u.col0 = 0; S.u.aux0 = 0; S.u.aux1 = 0;
        EpiSoftmax E; E.P = xP;
        gemm_phase<SchedOne, EpiSoftmax, true>(lds, 1024, 1024, 4, 4, S, E); }
      asm volatile("s_waitcnt vmcnt(0)" ::: "memory"); __syncthreads();
      { SchedOne S; S.has = true;
        S.u.A0 = S.u.A1 = W5 + (size_t)L * 131072; S.u.B0 = S.u.B1 = VmemT + (size_t)(b * 1024 + h * 256) * 256 * 2; S.u.out = D0 + ((size_t)pm * 256 * 1024 + h * 256) * 2; S.u.bias = nullptr; S.u.ldc = 1024; S.u.sub = 0;
        S.u.row0 = 0; S.u.col0 = 0; S.u.aux0 = 0; S.u.aux1 = 0;
        EpiBf16 E; E.m_Av = Av; E.m_Mt = Mt;
        gemm_phase<SchedOne, EpiBf16, false>(lds, 256, 256, 4, 4, S, E); }
      __syncthreads();
    }
  }
  }
  if constexpr (MASK == ALLPH) xcd_barrier(xb);

  if constexpr ((MASK >> 10) & 1) {
  int tid = threadIdx.x; asm volatile("" : "+v"(tid)); const int lane = tid & 63, wid = tid >> 6, gw = wg * 8 + wid, gtid = wg * 512 + tid; (void)lane; (void)gw; (void)gtid;
  {
    SchedLru S; S.u_ = W3; S.wl = WlruT; S.G = G; S.c = wg;
    EpiLru E; E.b_a = p.in[8]; E.b_x = p.in[10]; E.lam = p.in[11]; E.u = (const bf16_t*)W3; E.loga = (bf16_t*)W0; E.bb = (bf16_t*)W1;
    gemm_phase<SchedLru, EpiLru, false>(lds, 1024, 256, 4, 4, S, E);
    asm volatile("s_waitcnt vmcnt(0)" ::: "memory"); __syncthreads();
#pragma unroll 1
    for (int i = 0; i < 2; ++i) { const int L = i * G + wg; if (L < 512) {
      const int pm = (L & 7) * 8 + (L >> 6), pn = (L >> 3) & 7;
      const int ch = (pn >> 1) * 256 + (pn & 1) * 128 + (tid & 127), j = pm * 4 + (tid >> 7);
      const bf16_t* la = (const bf16_t*)W0 + (size_t)j * 64 * 1024 + ch; const bf16_t* bp = (const bf16_t*)W1 + (size_t)j * 64 * 1024 + ch;
      float h = 0.f, s = 0.f;
#pragma unroll 16
      for (int t = 0; t < 64; ++t) { const float l = bf2f(la[(size_t)t * 1024]); h = __expf(l) * h + bf2f(bp[(size_t)t * 1024]); s += l; }
      hend[(size_t)j * 1024 + ch] = h; slog[(size_t)j * 1024 + ch] = s; } }
  }
  }
  if constexpr (MASK == ALLPH) xcd_barrier(xb);

  if constexpr ((MASK >> 11) & 1) {
  int tid = threadIdx.x; asm volatile("" : "+v"(tid)); const int lane = tid & 63, wid = tid >> 6, gw = wg * 8 + wid, gtid = wg * 512 + tid; (void)lane; (void)gw; (void)gtid;
  }

  if constexpr ((MASK >> 12) & 1) {
  int tid = threadIdx.x; asm volatile("" : "+v"(tid)); const int lane = tid & 63, wid = tid >> 6, gw = wg * 8 + wid, gtid = wg * 512 + tid; (void)lane; (void)gw; (void)gtid;
  }

  if constexpr ((MASK >> 13) & 1) {
  int tid = threadIdx.x; asm volatile("" : "+v"(tid)); const int lane = tid & 63, wid = tid >> 6, gw = wg * 8 + wid, gtid = wg * 512 + tid; (void)lane; (void)gw; (void)gtid;
  for (int g = gtid; g < 131072; g += GT) {
    const int cp = (int)(g & 511), j = (int)(g >> 9);
    const unsigned* la = (const unsigned*)((const bf16_t*)W0 + (size_t)j * 64 * 1024 + cp * 2);
    const unsigned* bp = (const unsigned*)((const bf16_t*)W1 + (size_t)j * 64 * 1024 + cp * 2);
    unsigned* yo = (unsigned*)((bf16_t*)W3 + (size_t)j * 64 * 1024 + cp * 2);
    float h0 = 0.f, h1 = 0.f;
    { const int jb = (j >> 7) * 128, jl = j & 127;
#pragma unroll 8
      for (int jj = 0; jj < jl; ++jj) { const size_t o = (size_t)(jb + jj) * 1024 + cp * 2;
        const float sx = slog[o], sy = slog[o + 1], ex = hend[o], ey = hend[o + 1];
        h0 = __expf(sx) * h0 + ex; h1 = __expf(sy) * h1 + ey; } }
#pragma unroll 1
    for (int tb = 0; tb < 64; tb += 16) {
      unsigned av[16], bw[16];
#pragma unroll
      for (int t = 0; t < 16; ++t) { av[t] = la[(size_t)(tb + t) * 512]; bw[t] = bp[(size_t)(tb + t) * 512]; }
#pragma unroll
      for (int t = 0; t < 16; ++t) { h0 = __expf(bf_lo(av[t])) * h0 + bf_lo(bw[t]); h1 = __expf(bf_hi(av[t])) * h1 + bf_hi(bw[t]); yo[(size_t)(tb + t) * 512] = pk2(h0, h1); }
    }
  }
  }
  if constexpr (MASK == ALLPH) xcd_barrier(xb);

  if constexpr ((MASK >> 14) & 1) {
  int tid = threadIdx.x; asm volatile("" : "+v"(tid)); const int lane = tid & 63, wid = tid >> 6, gw = wg * 8 + wid, gtid = wg * 512 + tid; (void)lane; (void)gw; (void)gtid;
  {
    SchedZ S; S.hn = W4; S.wint = WinT; S.y0 = W3; S.y1 = W2; S.y2 = D0; S.binr = binR; S.G = G; S.c = wg;
    EpiZ E;
    gemm_phase<SchedZ, EpiZ, false>(lds, 1024, 1024, 16, 16, S, E);
  }
  }
  if constexpr (MASK == ALLPH) xcd_barrier(xb);

  if constexpr ((MASK >> 15) & 1) {
  int tid = threadIdx.x; asm volatile("" : "+v"(tid)); const int lane = tid & 63, wid = tid >> 6, gw = wg * 8 + wid, gtid = wg * 512 + tid; (void)lane; (void)gw; (void)gtid;
  {
    SchedMerge S; S.hn = W4; S.wint = WinT; S.wbt = WbT; S.y0 = W3; S.y1 = W2; S.y2 = D0; S.binr = binR; S.G = G; S.c = wg;
    EpiMerge E; E.gsc = (bf16_t*)D1; E.macc = (float*)W0; E.merged = (bf16_t*)W5;
    gemm_phase<SchedMerge, EpiMerge, false>(lds, 1024, 1024, 16, 16, S, E);
  }
  }
  if constexpr (MASK == ALLPH) xcd_barrier(xb);

  if constexpr ((MASK >> 16) & 1) {
  int tid = threadIdx.x; asm volatile("" : "+v"(tid)); const int lane = tid & 63, wid = tid >> 6, gw = wg * 8 + wid, gtid = wg * 512 + tid; (void)lane; (void)gw; (void)gtid;
  {
    int pm, pn; SchedOne S; S.has = static_tile((long)wg, 64, 4, pm, pn);
    S.u.A0 = S.u.A1 = W5 + (size_t)pm * 256 * 1024 * 2; S.u.B0 = S.u.B1 = WoutT + (size_t)pn * 256 * 1024 * 2; S.u.out = nullptr; S.u.bias = nullptr; S.u.ldc = 1024; S.u.sub = 0;
    S.u.row0 = pm * 256; S.u.col0 = pn * 256; S.u.aux0 = pm; S.u.aux1 = pn;
    EpiOutNorm E; E.x = x; E.out = p.out; E.g = p.in[27]; E.P = xP; E.xch = (float*)(p.ws + O_XCH); E.cnt = (unsigned*)(p.ws + O_CNT);
    gemm_phase<SchedOne, EpiOutNorm, true>(lds, 1024, 1024, 16, 16, S, E);
  }
  }


  if constexpr ((MASK >> 17) & 1) {
  int tid = threadIdx.x; asm volatile("" : "+v"(tid)); const int lane = tid & 63, wid = tid >> 6, gw = wg * 8 + wid, gtid = wg * 512 + tid; (void)lane; (void)gw; (void)gtid;
  }
}

#ifndef MK_SINGLE
#define MK_SINGLE 1
#endif
template <unsigned MASK>
static void launch_phase(const Params& p, int grid, size_t lds, hipStream_t stream) {
  static bool attr = false;
  if (!attr) { (void)hipFuncSetAttribute((const void*)mk_fwd<MASK>, hipFuncAttributeMaxDynamicSharedMemorySize, (int)lds); attr = true; }
  hipLaunchKernelGGL(mk_fwd<MASK>, dim3(grid), dim3(512), lds, stream, p);
}
extern "C" void kernel_launch(void* const* d_in, const int* in_sizes, int n_in, void* d_out, int out_size, void* d_ws, size_t ws_size, hipStream_t stream) {
  constexpr size_t kDynLds = STAGE_BYTES + 16384;
  static int grid_blocks = 0;
  if (!grid_blocks) {
    int dev = 0, cus = 0, per_cu = 0;
    (void)hipGetDevice(&dev);
    (void)hipDeviceGetAttribute(&cus, hipDeviceAttributeMultiprocessorCount, dev);
#if MK_SINGLE
    (void)hipFuncSetAttribute((const void*)mk_fwd<ALLPH>, hipFuncAttributeMaxDynamicSharedMemorySize, (int)kDynLds);
    (void)hipOccupancyMaxActiveBlocksPerMultiprocessor(&per_cu, (const void*)mk_fwd<ALLPH>, 512, kDynLds);
    if (per_cu < 1) fprintf(stderr, "occupancy query says %d blocks/CU\n", per_cu);
#endif
    if (ws_size < WS_NEED) fprintf(stderr, "workspace too small: %zu < %zu\n", ws_size, (size_t)WS_NEED);
    grid_blocks = 256; if (cus < 256) fprintf(stderr, "this kernel needs 256 CUs, device has %d\n", cus);
  }
  Params p{};
  for (int i = 0; i < 28; ++i) p.in[i] = (const float*)d_in[i];
  p.out = (float*)d_out; p.ws = (unsigned char*)d_ws;
#if MK_SINGLE
  (void)hipMemsetAsync((unsigned char*)d_ws + O_BAR, 0, 32768, stream);
  void* args[] = {&p};
  hipError_t e = hipLaunchCooperativeKernel((void*)mk_fwd<ALLPH>, dim3(grid_blocks), dim3(512), args, kDynLds, stream);
  if (e != hipSuccess) fprintf(stderr, "cooperative launch failed: %s (grid %d)\n", hipGetErrorString(e), grid_blocks);
#else
  const int g = grid_blocks;
  launch_phase<1u << 0>(p, g, kDynLds, stream); launch_phase<1u << 1>(p, g, kDynLds, stream); launch_phase<1u << 2>(p, g, kDynLds, stream); launch_phase<1u << 3>(p, g, kDynLds, stream);
  launch_phase<1u << 4>(p, g, kDynLds, stream); launch_phase<1u << 5>(p, g, kDynLds, stream); launch_phase<1u << 6>(p, g, kDynLds, stream); launch_phase<1u << 7>(p, g, kDynLds, stream);
  launch_phase<1u << 8>(p, g, kDynLds, stream); launch_phase<1u << 9>(p, g, kDynLds, stream); launch_phase<1u << 10>(p, g, kDynLds, stream); launch_phase<1u << 11>(p, g, kDynLds, stream);
  launch_phase<1u << 12>(p, g, kDynLds, stream); launch_phase<1u << 13>(p, g, kDynLds, stream); launch_phase<1u << 14>(p, g, kDynLds, stream); launch_phase<1u << 15>(p, g, kDynLds, stream);
  launch_phase<1u << 16>(p, g, kDynLds, stream); launch_phase<1u << 17>(p, g, kDynLds, stream);
#endif
}
```

```cpp
#include <hip/hip_runtime.h>
#include <hip/hip_cooperative_groups.h>
#include <cstdio>
namespace cg = cooperative_groups;

#define LAS __attribute__((address_space(3)))
typedef unsigned short bf16_t;
typedef short bf16x8 __attribute__((ext_vector_type(8)));
typedef float f32x4 __attribute__((ext_vector_type(4)));
typedef unsigned u32x4 __attribute__((ext_vector_type(4)));
typedef unsigned u32x2 __attribute__((ext_vector_type(2)));

constexpr int T = 16384, DM = 1024, SEQ = 8192;
constexpr size_t SLOT = (size_t)T * DM * 2;

constexpr size_t O_WINT = 0;
constexpr size_t O_WBT = O_WINT + (size_t)9216 * 1024 * 2;
constexpr size_t O_WOUTT = O_WBT + (size_t)3 * 1024 * 1024 * 2;
constexpr size_t O_WKVT = O_WOUTT + (size_t)1024 * 1024 * 2;
constexpr size_t O_WQT = O_WKVT + (size_t)2048 * 1024 * 2;
constexpr size_t O_WKT = O_WQT + 524288;
constexpr size_t O_WVT = O_WKT + 524288;
constexpr size_t O_WOT = O_WVT + 524288;
constexpr size_t O_WLRUT = O_WOT + 524288;
constexpr size_t O_BINR = O_WLRUT + 1048576;
constexpr size_t O_WXC = O_BINR + 36864;
constexpr size_t O_WXM = O_WXC + 32768;
constexpr size_t O_GATES = O_WXM + 32768;
constexpr size_t O_BC = O_GATES + (size_t)T * 16 * 4;
constexpr size_t O_AV = O_BC + (size_t)T * 4 * 4;
constexpr size_t O_MT = O_AV + (size_t)T * 4 * 4;
constexpr size_t O_DENP = O_MT + (size_t)T * 4 * 4;
constexpr size_t O_NKLOC = O_DENP + 1048576;
constexpr size_t O_NPREV = O_NKLOC + 262144;
constexpr size_t O_KMEM = O_NPREV + 262144;
constexpr size_t O_VMEMT = O_KMEM + 1048576;
constexpr size_t O_MEMN = O_VMEMT + 1048576;
constexpr size_t O_HEND = O_MEMN + 1048576;
constexpr size_t O_SLOG = O_HEND + 1048576;
constexpr size_t O_CARRY = O_SLOG + 1048576;
constexpr size_t O_BAR = O_CARRY + 1048576;
constexpr size_t O_CNT = O_BAR + 16384;
constexpr size_t O_XCH = O_CNT + 16384;
constexpr size_t O_WGT = O_XCH + 262144;
constexpr size_t O_SMALL_END = O_WGT + 65536;
constexpr size_t O_SLOTS = (size_t)46 * 1024 * 1024;
static_assert(O_SMALL_END <= O_SLOTS, "small region overflow");
constexpr size_t WS_NEED = O_SLOTS + 6 * SLOT;

struct Params { const float* in[28]; float* out; unsigned char* ws; };

__device__ __forceinline__ unsigned pk2(float lo, float hi) { unsigned r; asm volatile("v_cvt_pk_bf16_f32 %0, %1, %2" : "=v"(r) : "v"(lo), "v"(hi)); return r; }
__device__ __forceinline__ float bf_lo(unsigned w) { return __uint_as_float(w << 16); }
__device__ __forceinline__ float bf_hi(unsigned w) { return __uint_as_float(w & 0xffff0000u); }
__device__ __forceinline__ float bf2f(bf16_t b) { return __uint_as_float(((unsigned)b) << 16); }
__device__ __forceinline__ float sigm(float x) { return 1.0f / (1.0f + __expf(-x)); }
__device__ __forceinline__ float logsigm(float x) { return fminf(x, 0.f) - log1pf(expf(-fabsf(x))); }
__device__ __forceinline__ float wave_sum(float v) {
#pragma unroll
  for (int o = 1; o < 64; o <<= 1) v += __shfl_xor(v, o);
  return v;
}

constexpr int BM = 256, BK = 64, HALF = 128, HTB = HALF * BK * 2, STAGE_BYTES = 8 * HTB;
__device__ __forceinline__ int lds_byte(int r, int c) { const int st = (r >> 4) * 2 + (c >> 5), rr = r & 15, cc = c & 31, ob = rr * 64 + cc * 2; return st * 1024 + (ob ^ (((ob >> 9) & 1) << 5)); }
__device__ __forceinline__ void stage_rc(int b, int& R, int& C) { const int st = b / 1024, sb = b % 1024, swz = sb ^ (((sb >> 9) & 1) << 5); R = (st >> 1) * 16 + swz / 64; C = (st & 1) * 32 + (swz % 64) / 2; }

__device__ __forceinline__ int perm32(int rho) { const int n = rho >> 4, i = rho & 15; return 8 * (i >> 2) + 4 * n + (i & 3); }
struct UnitD { const char* A0; const char* A1; const char* B0; const char* B1; char* out; const float* bias; int ldc, sub, row0, col0, aux0, aux1; };

__device__ __forceinline__ bool static_tile(long L, int nM, int nN, int& pm, int& pn) {
  const int nwg = nM * nN; if (L >= nwg) return false;
  int wgid = (int)L; { const int q = nwg / 8, r = nwg % 8, xcd = wgid % 8, off = wgid / 8; wgid = (xcd < r ? xcd * (q + 1) : r * (q + 1) + (xcd - r) * q) + off; }
  const int nig = 8 * nN, gid = wgid / nig, fm = gid * 8, gsz = (nM - fm) < 8 ? (nM - fm) : 8;
  pm = fm + ((wgid % nig) % gsz); pn = (wgid % nig) / gsz; return true;
}

#define ROWOF(ai, m) (128 * (ai) + 64 * wr + 16 * (m) + fr)
#define COLOF(bj, n) (128 * (bj) + 32 * wc + 8 * fq + 4 * (n))
#define UNR _Pragma("unroll")

#ifndef GP_SP2
#define GP_SP2 0
#endif
#ifndef GP_ALIGN
#define GP_ALIGN 1
#endif
template <class Sched, class Epi, bool DRAIN>
__device__ __forceinline__ void gemm_phase(LAS unsigned char* lds, const int lda, const int ldb, const int nt, const int nt0, const Sched& S, const Epi& E) {
  int tid = threadIdx.x; asm volatile("" : "+v"(tid));
  const int wid = __builtin_amdgcn_readfirstlane(tid >> 6), lane = tid & 63, wr = wid >> 2, wc = wid & 3, fr = lane & 15, fq = lane >> 4;
  unsigned voffA, voffB;
  { int R, C; stage_rc(tid * 16, R, C); const int Rb = (R & ~31) + perm32(R & 31); voffA = (unsigned)(R * lda + C) * 2u; voffB = (unsigned)(Rb * ldb + C) * 2u; }
  const size_t qstepA = (size_t)64 * lda * 2, qstepB = (size_t)64 * ldb * 2;
  const size_t kstep = (size_t)(BK * 2);
  const size_t hstepA = (size_t)HALF * lda * 2, hstepB = (size_t)HALF * ldb * 2;
  const unsigned ldsw = (unsigned)wid * 1024u;
  const int aoff = lds_byte(wr * 64 + fr, fq * 8), boff = lds_byte(wc * 32 + fr, fq * 8);
#define G_SA(b, h) (((b) * 2 + (h)) * HTB)
#define G_SB(b, h) ((4 + (b) * 2 + (h)) * HTB)
#define qoffA qstepA
#define qoffB qstepB
#define voffA_ voffA
#define G_STAGE(bufoff, gbase, voff) do { _Pragma("unroll") for (int _i = 0; _i < 2; ++_i) \
    __builtin_amdgcn_global_load_lds((const unsigned*)((const char*)(gbase) + (size_t)_i * q##voff + v##voff), (LAS unsigned*)(lds + (bufoff) + ldsw + _i * 8192), 16, 0, 0); } while (0)
#define G_LDA(dst, b, h) do { _Pragma("unroll") for (int m = 0; m < 4; ++m) _Pragma("unroll") for (int k = 0; k < 2; ++k) dst[m][k] = *(const LAS bf16x8*)(lds + G_SA(b, h) + aoff + m * 2048 + k * 1024); } while (0)
#define G_LDB(dst, b, h) do { _Pragma("unroll") for (int n = 0; n < 2; ++n) _Pragma("unroll") for (int k = 0; k < 2; ++k) dst[n][k] = *(const LAS bf16x8*)(lds + G_SB(b, h) + boff + n * 2048 + k * 1024); } while (0)
#define G_MMA(ai, bj, At, Bt) do { __builtin_amdgcn_s_setprio(1); _Pragma("unroll") for (int m = 0; m < 4; ++m) _Pragma("unroll") for (int n = 0; n < 2; ++n) _Pragma("unroll") for (int k = 0; k < 2; ++k) \
    acc[ai][bj][m][n] = __builtin_amdgcn_mfma_f32_16x16x32_bf16(Bt[n][k], At[m][k], acc[ai][bj][m][n], 0, 0, 0); __builtin_amdgcn_s_setprio(0); } while (0)
#define G_WAIT_V(n) asm volatile("s_waitcnt vmcnt(" #n ")" ::: "memory")
#define G_WAIT_L(n) asm volatile("s_waitcnt lgkmcnt(" #n ")" ::: "memory")
#define G_BAR __builtin_amdgcn_s_barrier()
#define G_SCHED __builtin_amdgcn_sched_barrier(0)
  UnitD cur, nxt; int ui = 0;
  if (!S.next(0, cur)) return;
  f32x4 acc[2][2][4][2];
#pragma unroll
  for (int a = 0; a < 2; ++a)
#pragma unroll
    for (int b = 0; b < 2; ++b)
#pragma unroll
      for (int m = 0; m < 4; ++m)
#pragma unroll
        for (int n = 0; n < 2; ++n) acc[a][b][m][n] = (f32x4){0.f, 0.f, 0.f, 0.f};
  bf16x8 At[4][2], B0[2][2], B1[2][2];
  {
    const char* cA = cur.A0; const char* cB = cur.B0;
#if GP_SP2
    G_STAGE(G_SB(0, 0), cB, offB); G_STAGE(G_SB(0, 1), cB + hstepB, offB); G_STAGE(G_SA(0, 0), cA, offA); G_STAGE(G_SA(0, 1), cA + hstepA, offA);
    if (wr == 1) G_BAR;
    G_WAIT_V(2); G_BAR;
    G_STAGE(G_SB(1, 0), cB + kstep, offB); G_STAGE(G_SA(1, 0), cA + kstep, offA); G_STAGE(G_SB(1, 1), cB + hstepB + kstep, offB);
    G_WAIT_V(6); G_BAR;
#else
    G_STAGE(G_SB(0, 0), cB, offB); G_STAGE(G_SA(0, 0), cA, offA); G_STAGE(G_SB(0, 1), cB + hstepB, offB); G_STAGE(G_SA(0, 1), cA + hstepA, offA);
    if (wr == 1) G_BAR;
    G_WAIT_V(4); G_BAR;
    G_STAGE(G_SB(1, 0), cB + kstep, offB); G_STAGE(G_SA(1, 0), cA + kstep, offA); G_STAGE(G_SB(1, 1), cB + hstepB + kstep, offB);
    G_WAIT_V(6); G_BAR;
#endif
  }
  for (;;) {
    const bool has_next = S.next(ui + 1, nxt);
    const char* nA = has_next ? nxt.A0 : cur.A0; const char* nB = has_next ? nxt.B0 : cur.B0;
    for (int t = 0; t < nt; t += 2) {
      const bool last = (t == nt - 2);
      const char* a1 = (t + 1 < nt0) ? cur.A0 + (size_t)(t + 1) * kstep : cur.A1 + (size_t)(t + 1 - nt0) * kstep;
      const char* a2; const char* b2;
      if (last) { a2 = nA; b2 = nB; }
      else if (t + 2 < nt0) { a2 = cur.A0 + (size_t)(t + 2) * kstep; b2 = cur.B0 + (size_t)(t + 2) * kstep; }
      else { a2 = cur.A1 + (size_t)(t + 2 - nt0) * kstep; b2 = cur.B1 + (size_t)(t + 2 - nt0) * kstep; }
      const char* a3 = a2 + kstep; const char* b3 = b2 + kstep;
#if GP_SP2
      G_LDB(B0, 0, 0); G_LDB(B1, 0, 1); G_SCHED; G_LDA(At, 0, 0); G_STAGE(G_SA(1, 1), a1 + hstepA, offA);
      G_WAIT_V(8); G_WAIT_L(0); G_BAR; G_MMA(0, 0, At, B0); G_MMA(0, 1, At, B1); G_BAR; G_SCHED;
      G_LDA(At, 0, 1); G_STAGE(G_SB(0, 0), b2, offB); G_STAGE(G_SB(0, 1), b2 + hstepB, offB); G_STAGE(G_SA(0, 0), a2, offA);
      G_WAIT_V(8); G_WAIT_L(0); G_BAR; G_MMA(1, 0, At, B0); G_MMA(1, 1, At, B1); G_BAR; G_SCHED;
      G_LDB(B0, 1, 0); G_LDB(B1, 1, 1); G_SCHED; G_LDA(At, 1, 0); G_STAGE(G_SA(0, 1), a2 + hstepA, offA);
      G_WAIT_V(8); G_WAIT_L(0); G_BAR; G_MMA(0, 0, At, B0); G_MMA(0, 1, At, B1); G_BAR; G_SCHED;
      G_LDA(At, 1, 1); G_STAGE(G_SB(1, 0), b3, offB); G_STAGE(G_SB(1, 1), b3 + hstepB, offB); G_STAGE(G_SA(1, 0), a3, offA);
      G_WAIT_V(8); G_WAIT_L(0); G_BAR; G_MMA(1, 0, At, B0); G_MMA(1, 1, At, B1); G_BAR; G_SCHED;
#else
      G_LDB(B0, 0, 0); G_SCHED; G_LDA(At, 0, 0); G_STAGE(G_SA(1, 1), a1 + hstepA, offA);
      G_WAIT_L(8); G_BAR; G_WAIT_L(0); G_MMA(0, 0, At, B0); G_BAR; G_SCHED;
      G_LDB(B1, 0, 1); G_STAGE(G_SB(0, 0), b2, offB);
      G_BAR; G_WAIT_L(0); G_MMA(0, 1, At, B1); G_BAR;
      G_LDA(At, 0, 1); G_STAGE(G_SA(0, 0), a2, offA);
      G_BAR; G_WAIT_L(0); G_MMA(1, 0, At, B0); G_BAR; G_SCHED;
      G_STAGE(G_SB(0, 1), b2 + hstepB, offB);
      G_WAIT_V(6); G_BAR; G_MMA(1, 1, At, B1); G_BAR;
      G_LDB(B0, 1, 0); G_SCHED; G_LDA(At, 1, 0); G_STAGE(G_SA(0, 1), a2 + hstepA, offA);
      G_WAIT_L(8); G_BAR; G_WAIT_L(0); G_MMA(0, 0, At, B0); G_BAR; G_SCHED;
      G_LDB(B1, 1, 1); G_STAGE(G_SB(1, 0), b3, offB);
      G_BAR; G_WAIT_L(0); G_MMA(0, 1, At, B1); G_BAR;
      G_LDA(At, 1, 1); G_STAGE(G_SA(1, 0), a3, offA);
      G_BAR; G_WAIT_L(0); G_MMA(1, 0, At, B0); G_BAR; G_SCHED;
      G_STAGE(G_SB(1, 1), b3 + hstepB, offB);
      G_WAIT_V(6); G_BAR; G_MMA(1, 1, At, B1); G_BAR;
#endif
    }
#if GP_ALIGN
    if (wr == 0) G_BAR;
#endif
    if constexpr (!DRAIN) { int fr2 = fr, fq2 = fq; asm volatile("" : "+v"(fr2), "+v"(fq2)); E.run(acc, cur, wr, wc, fr2, fq2); }
    if (!has_next) break;
#pragma unroll
    for (int a = 0; a < 2; ++a)
#pragma unroll
      for (int b = 0; b < 2; ++b)
#pragma unroll
        for (int m = 0; m < 4; ++m)
#pragma unroll
          for (int n = 0; n < 2; ++n) acc[a][b][m][n] = (f32x4){0.f, 0.f, 0.f, 0.f};
    cur = nxt; ++ui;
#if GP_ALIGN
    if (wr == 1) G_BAR;
#endif
  }
  G_WAIT_V(0);
#if !GP_ALIGN
  if (wr == 0) G_BAR;
#endif
  G_BAR;
  if constexpr (DRAIN) { int fr2 = fr, fq2 = fq; asm volatile("" : "+v"(fr2), "+v"(fq2)); E.run(acc, cur, wr, wc, fr2, fq2); }
#undef G_SA
#undef G_SB
#undef G_STAGE
#undef G_LDA
#undef G_LDB
#undef G_MMA
#undef G_WAIT_V
#undef G_WAIT_L
#undef G_BAR
#undef G_SCHED
}

typedef f32x4 Acc[2][2][4][2];

template <bool MAX>
__device__ __forceinline__ void row_allreduce(float (&v)[2][4], LAS float* P, int wr, int wc, int fr, int fq) {
  UNR for (int ai = 0; ai < 2; ++ai) UNR for (int m = 0; m < 4; ++m) {
    float x = v[ai][m];
    float y = __shfl_xor(x, 16); x = MAX ? fmaxf(x, y) : x + y;
    y = __shfl_xor(x, 32); x = MAX ? fmaxf(x, y) : x + y;
    if (fq == 0) P[ROWOF(ai, m) * 4 + wc] = x;
  }
  __syncthreads();
  UNR for (int ai = 0; ai < 2; ++ai) UNR for (int m = 0; m < 4; ++m) {
    const f32x4 q = *(const LAS f32x4*)(P + ROWOF(ai, m) * 4);
    v[ai][m] = MAX ? fmaxf(fmaxf(q.x, q.y), fmaxf(q.z, q.w)) : (q.x + q.y) + (q.z + q.w);
  }
  __syncthreads();
}

struct EpiBf16 {
  const float* m_Av; const float* m_Mt;
  __device__ __forceinline__ void run(Acc& acc, const UnitD& u, int wr, int wc, int fr, int fq) const {
    bf16_t* base = (bf16_t*)u.out + (size_t)(64 * wr + fr) * u.ldc + 32 * wc + 8 * fq;
    UNR for (int bj = 0; bj < 2; ++bj) {
      f32x4 b0 = u.bias ? *(const f32x4*)(u.bias + COLOF(bj, 0)) : (f32x4){0.f, 0.f, 0.f, 0.f};
      f32x4 b1 = u.bias ? *(const f32x4*)(u.bias + COLOF(bj, 1)) : (f32x4){0.f, 0.f, 0.f, 0.f};
      if (u.sub == 2) { const float me = m_Mt[(size_t)(u.row0 + 255) * 4 + u.aux0];
        UNR for (int j = 0; j < 4; ++j) { b0[j] = __expf(m_Av[(size_t)(u.row0 + COLOF(bj, 0) + j) * 4 + u.aux0] - me); b1[j] = __expf(m_Av[(size_t)(u.row0 + COLOF(bj, 1) + j) * 4 + u.aux0] - me); } }
      UNR for (int ai = 0; ai < 2; ++ai) UNR for (int m = 0; m < 4; ++m) {
        f32x4 v0 = acc[ai][bj][m][0], v1 = acc[ai][bj][m][1];
        if (u.sub == 2) { v0 = v0 * b0; v1 = v1 * b1; } else { v0 = v0 + b0; v1 = v1 + b1; }
        if (u.sub == 1) { v0.x = sigm(v0.x); v0.y = sigm(v0.y); v0.z = sigm(v0.z); v0.w = sigm(v0.w); v1.x = sigm(v1.x); v1.y = sigm(v1.y); v1.z = sigm(v1.z); v1.w = sigm(v1.w); }
        u32x4 w; w.x = pk2(v0.x, v0.y); w.y = pk2(v0.z, v0.w); w.z = pk2(v1.x, v1.y); w.w = pk2(v1.z, v1.w);
        *(u32x4*)(base + (size_t)(128 * ai + 16 * m) * u.ldc + 128 * bj) = w;
      }
      asm volatile("" ::: "memory");
    }
  }
};
struct EpiU1 {
  const float* m_Av; const float* m_Mt; float* m_denp;
  __device__ __forceinline__ void run(Acc& acc, const UnitD& u, int wr, int wc, int fr, int fq) const {
    const int h = u.aux0, unit = u.aux1, tok0 = u.row0;
    float av[2][8];
    UNR for (int bj = 0; bj < 2; ++bj) UNR for (int j = 0; j < 8; ++j) av[bj][j] = m_Av[(size_t)(tok0 + COLOF(bj, 0) + j) * 4 + h];
    float mtv[2][4];
    UNR for (int ai = 0; ai < 2; ++ai) UNR for (int m = 0; m < 4; ++m) mtv[ai][m] = m_Mt[(size_t)(tok0 + ROWOF(ai, m)) * 4 + h];
    UNR for (int ai = 0; ai < 2; ++ai) UNR for (int m = 0; m < 4; ++m) {
      const int r = ROWOF(ai, m);
      const float mt = mtv[ai][m];
      bf16_t* rowp = (bf16_t*)u.out + (size_t)r * u.ldc;
      float rs = 0.f;
      UNR for (int bj = 0; bj < 2; ++bj) {
        float v[8];
        UNR for (int j = 0; j < 8; ++j) { const int c = COLOF(bj, 0) + j; const float w = (c <= r) ? __expf(av[bj][j] - mt) : 0.f; v[j] = acc[ai][bj][m][j >> 2][j & 3] * w; rs += v[j]; }
        u32x4 w2; w2.x = pk2(v[0], v[1]); w2.y = pk2(v[2], v[3]); w2.z = pk2(v[4], v[5]); w2.w = pk2(v[6], v[7]);
        *(u32x4*)(rowp + COLOF(bj, 0)) = w2;
      }
      rs += __shfl_xor(rs, 16); rs += __shfl_xor(rs, 32);
      if (fq == 0) m_denp[((size_t)unit * 256 + r) * 4 + wc] = rs;
      asm volatile("" ::: "memory");
    }
  }
};
struct EpiLru {
  const float* b_a; const float* b_x; const float* lam; const bf16_t* u; bf16_t* loga; bf16_t* bb;
  __device__ __forceinline__ void run(Acc& acc, const UnitD& ud, int wr, int wc, int fr, int fq) const {
    const int chb = ud.col0;
    UNR for (int bj = 0; bj < 2; ++bj) {
      const int ch = chb + 64 * bj + 16 * wc + 4 * fq;
      const f32x4 ba = *(const f32x4*)(b_a + ch), bx = *(const f32x4*)(b_x + ch), l = *(const f32x4*)(lam + ch);
      f32x4 ls;
      UNR for (int j = 0; j < 4; ++j) ls[j] = 8.0f * logsigm(l[j]);
      const size_t o0 = ((size_t)ud.row0 + 64 * wr + fr) * 1024 + ch;
      UNR for (int ai = 0; ai < 2; ++ai) { u32x2 uq[4];
      UNR for (int m = 0; m < 4; ++m) uq[m] = *(const u32x2*)(u + o0 + (size_t)(128 * ai + 16 * m) * 1024);
      UNR for (int m = 0; m < 4; ++m) {
        const size_t o = o0 + (size_t)(128 * ai + 16 * m) * 1024;
        const u32x2 uw = uq[m];
        const float uu[4] = {bf_lo(uw.x), bf_hi(uw.x), bf_lo(uw.y), bf_hi(uw.y)};
        float la[4], bv[4];
        UNR for (int j = 0; j < 4; ++j) {
          const float rg = sigm(acc[ai][bj][m][0][j] + ba[j]);
          const float ig = sigm(acc[ai][bj][m][1][j] + bx[j]);
          la[j] = rg * ls[j];
          const float x2 = 2.0f * la[j];
          const float om = (x2 > -0.02f) ? -(x2 * (1.0f + x2 * (0.5f + x2 * (1.0f / 6.0f)))) : 1.0f - __expf(x2);
          bv[j] = sqrtf(fmaxf(om, 0.f)) * ig * uu[j];
        }
        u32x2 w1; w1.x = pk2(la[0], la[1]); w1.y = pk2(la[2], la[3]);
        u32x2 w2; w2.x = pk2(bv[0], bv[1]); w2.y = pk2(bv[2], bv[3]);
        *(u32x2*)(loga + o) = w1; *(u32x2*)(bb + o) = w2;
      }
      asm volatile("" ::: "memory"); }
    }
  }
};
struct EpiZ {
  __device__ __forceinline__ void run(Acc& acc, const UnitD& u, int wr, int wc, int fr, int fq) const {
    bf16_t* base = (bf16_t*)u.out + (size_t)(64 * wr + fr) * u.ldc + 32 * wc + 8 * fq;
    UNR for (int bj = 0; bj < 2; ++bj) {
      const f32x4 b0 = *(const f32x4*)(u.bias + COLOF(bj, 0)), b1 = *(const f32x4*)(u.bias + COLOF(bj, 1));
      u32x4 o[2][4];
      UNR for (int ai = 0; ai < 2; ++ai) UNR for (int m = 0; m < 4; ++m) o[ai][m] = *(const u32x4*)(base + (size_t)(128 * ai + 16 * m) * u.ldc + 128 * bj);
      UNR for (int ai = 0; ai < 2; ++ai) UNR for (int m = 0; m < 4; ++m) {
        const f32x4 z0 = acc[ai][bj][m][0] + b0, z1 = acc[ai][bj][m][1] + b1; const u32x4 ov = o[ai][m];
        u32x4 w; w.x = pk2(bf_lo(ov.x) * z0.x * sigm(z0.x), bf_hi(ov.x) * z0.y * sigm(z0.y)); w.y = pk2(bf_lo(ov.y) * z0.z * sigm(z0.z), bf_hi(ov.y) * z0.w * sigm(z0.w));
        w.z = pk2(bf_lo(ov.z) * z1.x * sigm(z1.x), bf_hi(ov.z) * z1.y * sigm(z1.y)); w.w = pk2(bf_lo(ov.w) * z1.z * sigm(z1.z), bf_hi(ov.w) * z1.w * sigm(z1.w));
        *(u32x4*)(base + (size_t)(128 * ai + 16 * m) * u.ldc + 128 * bj) = w;
      }
      asm volatile("" ::: "memory");
    }
  }
};
struct EpiMerge {
  bf16_t* gsc; float* macc; bf16_t* merged;
  __device__ __forceinline__ void run(Acc& acc, const UnitD& u, int wr, int wc, int fr, int fq) const {
    const size_t org = (size_t)(u.row0 + 64 * wr + fr) * 1024 + u.col0 + 32 * wc + 8 * fq;
    if ((u.sub & 1) == 0) {
      UNR for (int bj = 0; bj < 2; ++bj) {
        const f32x4 b0 = *(const f32x4*)(u.bias + COLOF(bj, 0)), b1 = *(const f32x4*)(u.bias + COLOF(bj, 1));
        UNR for (int ai = 0; ai < 2; ++ai) UNR for (int m = 0; m < 4; ++m) {
          const f32x4 v0 = acc[ai][bj][m][0] + b0, v1 = acc[ai][bj][m][1] + b1;
          u32x4 w; w.x = pk2(sigm(v0.x), sigm(v0.y)); w.y = pk2(sigm(v0.z), sigm(v0.w)); w.z = pk2(sigm(v1.x), sigm(v1.y)); w.w = pk2(sigm(v1.z), sigm(v1.w));
          *(u32x4*)(gsc + org + (size_t)(128 * ai + 16 * m) * 1024 + 128 * bj) = w;
        }
      }
    } else {
      UNR for (int bj = 0; bj < 2; ++bj) {
        u32x4 g[2][4], a[2][4];
        UNR for (int ai = 0; ai < 2; ++ai) UNR for (int m = 0; m < 4; ++m) { const size_t o = org + (size_t)(128 * ai + 16 * m) * 1024 + 128 * bj; g[ai][m] = *(const u32x4*)(gsc + o); if (u.sub != 1) a[ai][m] = *(const u32x4*)(merged + o); }
        UNR for (int ai = 0; ai < 2; ++ai) UNR for (int m = 0; m < 4; ++m) {
          const size_t o = org + (size_t)(128 * ai + 16 * m) * 1024 + 128 * bj;
          const u32x4 gg = g[ai][m];
          f32x4 v0 = acc[ai][bj][m][0], v1 = acc[ai][bj][m][1];
          v0.x *= bf_lo(gg.x); v0.y *= bf_hi(gg.x); v0.z *= bf_lo(gg.y); v0.w *= bf_hi(gg.y); v1.x *= bf_lo(gg.z); v1.y *= bf_hi(gg.z); v1.z *= bf_lo(gg.w); v1.w *= bf_hi(gg.w);
          if (u.sub != 1) { const u32x4 aa = a[ai][m]; v0.x += bf_lo(aa.x); v0.y += bf_hi(aa.x); v0.z += bf_lo(aa.y); v0.w += bf_hi(aa.y); v1.x += bf_lo(aa.z); v1.y += bf_hi(aa.z); v1.z += bf_lo(aa.w); v1.w += bf_hi(aa.w); }
          u32x4 w; w.x = pk2(v0.x, v0.y); w.y = pk2(v0.z, v0.w); w.z = pk2(v1.x, v1.y); w.w = pk2(v1.z, v1.w); *(u32x4*)(merged + o) = w;
        }
        asm volatile("" ::: "memory");
      }
    }
  }
};
struct EpiOut {
  const float* x; float* out;
  __device__ __forceinline__ void run(Acc& acc, const UnitD& u, int wr, int wc, int fr, int fq) const {
    const size_t org = (size_t)(u.row0 + 64 * wr + fr) * 1024 + u.col0 + 32 * wc + 8 * fq;
    UNR for (int bj = 0; bj < 2; ++bj) {
      f32x4 xv[2][4][2];
      UNR for (int ai = 0; ai < 2; ++ai) UNR for (int m = 0; m < 4; ++m) { const size_t o = org + (size_t)(128 * ai + 16 * m) * 1024 + 128 * bj; xv[ai][m][0] = *(const f32x4*)(x + o); xv[ai][m][1] = *(const f32x4*)(x + o + 4); }
      UNR for (int ai = 0; ai < 2; ++ai) UNR for (int m = 0; m < 4; ++m) { const size_t o = org + (size_t)(128 * ai + 16 * m) * 1024 + 128 * bj;
        *(f32x4*)(out + o) = xv[ai][m][0] + acc[ai][bj][m][0]; *(f32x4*)(out + o + 4) = xv[ai][m][1] + acc[ai][bj][m][1]; }
      asm volatile("" ::: "memory");
    }
  }
};
struct EpiSoftmax {
  LAS float* P;
  __device__ __forceinline__ void run(Acc& acc, const UnitD& u, int wr, int wc, int fr, int fq) const {
    float mx[2][4], sm[2][4];
    UNR for (int ai = 0; ai < 2; ++ai) UNR for (int m = 0; m < 4; ++m) { float x = -3.0e38f;
      UNR for (int bj = 0; bj < 2; ++bj) UNR for (int n = 0; n < 2; ++n) UNR for (int j = 0; j < 4; ++j) { acc[ai][bj][m][n][j] *= 0.0625f; x = fmaxf(x, acc[ai][bj][m][n][j]); }
      mx[ai][m] = x; }
    row_allreduce<true>(mx, P, wr, wc, fr, fq);
    UNR for (int ai = 0; ai < 2; ++ai) UNR for (int m = 0; m < 4; ++m) { float s = 0.f;
      UNR for (int bj = 0; bj < 2; ++bj) UNR for (int n = 0; n < 2; ++n) UNR for (int j = 0; j < 4; ++j) { const float e = __expf(acc[ai][bj][m][n][j] - mx[ai][m]); acc[ai][bj][m][n][j] = e; s += e; }
      sm[ai][m] = s; }
    row_allreduce<false>(sm, P, wr, wc, fr, fq);
    UNR for (int ai = 0; ai < 2; ++ai) UNR for (int m = 0; m < 4; ++m) {
      const float inv = 1.0f / sm[ai][m];
      bf16_t* rowp = (bf16_t*)u.out + (size_t)ROWOF(ai, m) * u.ldc;
      UNR for (int bj = 0; bj < 2; ++bj) { const f32x4 v0 = acc[ai][bj][m][0] * inv, v1 = acc[ai][bj][m][1] * inv;
        u32x4 w; w.x = pk2(v0.x, v0.y); w.y = pk2(v0.z, v0.w); w.z = pk2(v1.x, v1.y); w.w = pk2(v1.z, v1.w); *(u32x4*)(rowp + COLOF(bj, 0)) = w; }
    }
  }
};
struct EpiU2 {
  LAS float* P; LAS float* deni; const float* m_denp; const float* m_Bc; const float* m_Mt; const bf16_t* og; const float* norm_g; const float* skip; bf16_t* xc;
  __device__ __forceinline__ void run(Acc& acc, const UnitD& u, int wr, int wc, int fr, int fq) const {
    const int h = u.aux0, unit = u.aux1, tok0 = u.row0;
    float s1[2][4], s2[2][4];
    UNR for (int ai = 0; ai < 2; ++ai) UNR for (int m = 0; m < 4; ++m) {
      const int r = ROWOF(ai, m); const size_t tok = (size_t)tok0 + r;
      const f32x4 dp = *(const f32x4*)(m_denp + ((size_t)unit * 256 + r) * 4);
      const float den = (dp.x + dp.y) + (dp.z + dp.w) + deni[r];
      const float mt = m_Bc[tok * 4 + h];
      const float inv = 1.0f / fmaxf(fabsf(den), __expf(-mt));
      float s = 0.f;
      const bf16_t* ogp = og + tok * 1024 + h * 256 + 32 * wc + 8 * fq;
      UNR for (int bj = 0; bj < 2; ++bj) {
        const u32x4 o = *(const u32x4*)(ogp + 128 * bj);
        f32x4 v0 = acc[ai][bj][m][0] * inv, v1 = acc[ai][bj][m][1] * inv;
        v0.x *= bf_lo(o.x); v0.y *= bf_hi(o.x); v0.z *= bf_lo(o.y); v0.w *= bf_hi(o.y); v1.x *= bf_lo(o.z); v1.y *= bf_hi(o.z); v1.z *= bf_lo(o.w); v1.w *= bf_hi(o.w);
        acc[ai][bj][m][0] = v0; acc[ai][bj][m][1] = v1; s += ((v0.x + v0.y) + (v0.z + v0.w)) + ((v1.x + v1.y) + (v1.z + v1.w));
      }
      s1[ai][m] = s;
      if (m == 3) asm volatile("" ::: "memory");
    }
    row_allreduce<false>(s1, P, wr, wc, fr, fq);
    UNR for (int ai = 0; ai < 2; ++ai) UNR for (int m = 0; m < 4; ++m) { const float mu = s1[ai][m] * (1.0f / 256.0f); float s = 0.f;
      UNR for (int bj = 0; bj < 2; ++bj) UNR for (int n = 0; n < 2; ++n) { f32x4 v = acc[ai][bj][m][n] - mu; acc[ai][bj][m][n] = v; s += (v.x * v.x + v.y * v.y) + (v.z * v.z + v.w * v.w); }
      s2[ai][m] = s; }
    row_allreduce<false>(s2, P, wr, wc, fr, fq);
    UNR for (int ai = 0; ai < 2; ++ai) UNR for (int m = 0; m < 4; ++m) s2[ai][m] = 1.0f / sqrtf(s2[ai][m] * (1.0f / 256.0f) + 1e-6f);
    bf16_t* xb = xc + (size_t)(tok0 + 64 * wr + fr) * 1024 + h * 256 + 32 * wc + 8 * fq;
    UNR for (int bj = 0; bj < 2; ++bj) {
      const int ch = h * 256 + COLOF(bj, 0);
      const f32x4 g0 = *(const f32x4*)(norm_g + ch), g1 = *(const f32x4*)(norm_g + ch + 4), k0 = *(const f32x4*)(skip + ch), k1 = *(const f32x4*)(skip + ch + 4);
      UNR for (int ai = 0; ai < 2; ++ai) {
        u32x4 xq[4];
        UNR for (int m = 0; m < 4; ++m) xq[m] = *(const u32x4*)(xb + (size_t)(128 * ai + 16 * m) * 1024 + 128 * bj);
        UNR for (int m = 0; m < 4; ++m) {
          const u32x4 xv = xq[m];
          const f32x4 v0 = acc[ai][bj][m][0] * s2[ai][m], v1 = acc[ai][bj][m][1] * s2[ai][m];
          u32x4 w; w.x = pk2(v0.x * g0.x + k0.x * bf_lo(xv.x), v0.y * g0.y + k0.y * bf_hi(xv.x)); w.y = pk2(v0.z * g0.z + k0.z * bf_lo(xv.y), v0.w * g0.w + k0.w * bf_hi(xv.y));
          w.z = pk2(v1.x * g1.x + k1.x * bf_lo(xv.z), v1.y * g1.y + k1.y * bf_hi(xv.z)); w.w = pk2(v1.z * g1.z + k1.z * bf_lo(xv.w), v1.w * g1.w + k1.w * bf_hi(xv.w));
          *(u32x4*)(xb + (size_t)(128 * ai + 16 * m) * 1024 + 128 * bj) = w;
        }
        asm volatile("" ::: "memory");
      }
    }
  }
};

struct EpiOutNorm {
  const float* x; float* out; const float* g; LAS float* P; float* xch; unsigned* cnt;
  __device__ __forceinline__ void run(Acc& acc, const UnitD& u, int wr, int wc, int fr, int fq) const {
    const int pm = u.aux0, pn = u.aux1;
    const size_t org = (size_t)(u.row0 + 64 * wr + fr) * 1024 + u.col0 + 32 * wc + 8 * fq;
    UNR for (int bj = 0; bj < 2; ++bj) UNR for (int ai = 0; ai < 2; ++ai) {
      f32x4 xv[4][2];
      UNR for (int m = 0; m < 4; ++m) { const size_t o = org + (size_t)(128 * ai + 16 * m) * 1024 + 128 * bj; xv[m][0] = *(const f32x4*)(x + o); xv[m][1] = *(const f32x4*)(x + o + 4); }
      UNR for (int m = 0; m < 4; ++m) { acc[ai][bj][m][0] += xv[m][0]; acc[ai][bj][m][1] += xv[m][1]; }
      asm volatile("" ::: "memory");
    }
    float ss[2][4];
    UNR for (int ai = 0; ai < 2; ++ai) UNR for (int m = 0; m < 4; ++m) { float s = 0.f;
      UNR for (int bj = 0; bj < 2; ++bj) UNR for (int n = 0; n < 2; ++n) { const f32x4 v = acc[ai][bj][m][n]; s += (v.x * v.x + v.y * v.y) + (v.z * v.z + v.w * v.w); }
      ss[ai][m] = s; }
    row_allreduce<false>(ss, P, wr, wc, fr, fq);
    if (wc == 0 && fq == 0) {
      UNR for (int ai = 0; ai < 2; ++ai) UNR for (int m = 0; m < 4; ++m)
        __hip_atomic_store(xch + ((size_t)(pm * 256 + ROWOF(ai, m))) * 4 + pn, ss[ai][m], __ATOMIC_RELAXED, __HIP_MEMORY_SCOPE_AGENT);
    }
    asm volatile("s_waitcnt vmcnt(0)" ::: "memory");
    __syncthreads();
    if (threadIdx.x == 0) {
      unsigned* c = cnt + 64 * pm;
      __hip_atomic_fetch_add(c, 1u, __ATOMIC_RELAXED, __HIP_MEMORY_SCOPE_AGENT);
      unsigned sp = 0;
      while (__hip_atomic_load(c, __ATOMIC_RELAXED, __HIP_MEMORY_SCOPE_AGENT) < 4u) { __builtin_amdgcn_s_sleep(1); if (++sp > (1u << 22)) break; }
      __builtin_amdgcn_fence(__ATOMIC_ACQUIRE, "agent");
      asm volatile("s_waitcnt vmcnt(0)" ::: "memory");
    }
    __syncthreads();
    UNR for (int ai = 0; ai < 2; ++ai) UNR for (int m = 0; m < 4; ++m) {
      const float* sl = xch + ((size_t)(pm * 256 + ROWOF(ai, m))) * 4;
      const float t = (__hip_atomic_load(sl, __ATOMIC_RELAXED, __HIP_MEMORY_SCOPE_AGENT) + __hip_atomic_load(sl + 1, __ATOMIC_RELAXED, __HIP_MEMORY_SCOPE_AGENT))
                    + (__hip_atomic_load(sl + 2, __ATOMIC_RELAXED, __HIP_MEMORY_SCOPE_AGENT) + __hip_atomic_load(sl + 3, __ATOMIC_RELAXED, __HIP_MEMORY_SCOPE_AGENT));
      ss[ai][m] = 1.0f / sqrtf(t * (1.0f / 1024.0f) + 1e-6f);
    }
    int fr3 = fr, fq3 = fq; asm volatile("" : "+v"(fr3), "+v"(fq3));
    const size_t org2 = (size_t)(u.row0 + 64 * wr + fr3) * 1024 + u.col0 + 32 * wc + 8 * fq3;
    UNR for (int bj = 0; bj < 2; ++bj) {
      const f32x4 g0 = *(const f32x4*)(g + u.col0 + COLOF(bj, 0)), g1 = *(const f32x4*)(g + u.col0 + COLOF(bj, 1));
      UNR for (int ai = 0; ai < 2; ++ai) UNR for (int m = 0; m < 4; ++m) { const size_t o = org2 + (size_t)(128 * ai + 16 * m) * 1024 + 128 * bj;
        *(f32x4*)(out + o) = acc[ai][bj][m][0] * ss[ai][m] * g0; *(f32x4*)(out + o + 4) = acc[ai][bj][m][1] * ss[ai][m] * g1; }
    }
  }
};

struct SchedTiles {
  const char* A; const char* Bt; char* out0; char* out1; const float* bias; int nN, G, c;
  __device__ __forceinline__ bool next(int i, UnitD& u) const {
    int pm, pn; if (!static_tile((long)i * G + c, 64, nN, pm, pn)) return false;
    u.A0 = u.A1 = A + (size_t)pm * 256 * 1024 * 2; u.B0 = u.B1 = Bt + (size_t)pn * 256 * 1024 * 2;
    u.out = ((pn >> 2) ? out1 : out0) + ((size_t)pm * 256 * 1024 + (pn & 3) * 256) * 2; u.bias = bias ? bias + pn * 256 : nullptr; u.ldc = 1024; u.sub = 0;
    u.row0 = pm * 256; u.col0 = (pn & 3) * 256; u.aux0 = 0; u.aux1 = 0; return true;
  }
};
struct SchedOne { UnitD u; bool has; __device__ __forceinline__ bool next(int i, UnitD& o) const { if (i != 0 || !has) return false; o = u; return true; } };
struct SchedP3X {
  const char* xc; const char* mx; const char* wq; const char* wk; const char* wo; char* q; char* k; char* og; const float* b_o; int G, c;
  __device__ __forceinline__ bool next(int i, UnitD& u) const {
    const int L = i * G + c; if (L >= 768) return false;
    const int kind = L >> 8, idx = L & 255, pm = idx >> 2, h = idx & 3;
    const size_t to = ((size_t)pm * 256 * 1024 + h * 256) * 2;
    u.A0 = u.A1 = (kind == 2 ? mx : xc) + to; u.B0 = u.B1 = wq + (size_t)(kind == 0 ? 0 : kind == 1 ? 524288 : 1572864) + (size_t)h * 131072;
    u.out = q + (size_t)kind * SLOT + to; u.bias = kind == 2 ? b_o + h * 256 : nullptr; u.ldc = 1024; u.sub = kind == 2 ? 1 : 0;
    u.row0 = pm * 256; u.col0 = h * 256; u.aux0 = h; u.aux1 = 0; return true;
  }
};
struct SchedP3Y {
  const char* xc; const char* mx; const char* wk; const char* wv; char* vt; char* ktw; int G, c, base, count;
  __device__ __forceinline__ bool next(int i, UnitD& u) const {
    const int Lr = i * G + c; if (Lr >= count) return false;
    const int L = base + Lr;
    const int kind = L >> 8, unit = L & 255, bh = unit >> 5, ci = unit & 31, b = bh >> 2, h = bh & 3, tok0 = b * SEQ + ci * 256;
    u.A0 = u.A1 = (kind ? wk : wv) + (size_t)h * 131072; u.B0 = u.B1 = (kind ? xc : mx) + ((size_t)tok0 * 1024 + h * 256) * 2;
    u.out = (kind ? ktw : vt) + (size_t)unit * 131072; u.bias = nullptr; u.ldc = 256; u.sub = kind ? 2 : 0; u.row0 = tok0; u.col0 = 0; u.aux0 = h; u.aux1 = unit; return true;
  }
};
struct SchedZ {
  const char* hn; const char* wint; char* y0; char* y1; char* y2; const float* binr; int G, c;
  __device__ __forceinline__ bool next(int i, UnitD& u) const {
    const int L = i * G + c; if (L >= 768) return false;
    const int br = L >> 8, r = L & 255, pm = (r & 7) * 8 + (r >> 5), pn = (r >> 3) & 3;
    u.A0 = u.A1 = hn + (size_t)pm * 256 * 1024 * 2; u.B0 = u.B1 = wint + (size_t)(3072 + br * 1024 + pn * 256) * 1024 * 2;
    u.out = (char*)((size_t)y0 * (size_t)(br == 0) + (size_t)y1 * (size_t)(br == 1) + (size_t)y2 * (size_t)(br == 2)) + ((size_t)pm * 256 * 1024 + pn * 256) * 2; u.bias = binr + 3072 + br * 1024 + pn * 256; u.ldc = 1024; u.sub = 0; u.row0 = pm * 256; u.col0 = pn * 256; u.aux0 = 0; u.aux1 = 0; return true;
  }
};
struct SchedMerge {
  const char* hn; const char* wint; const char* wbt; const char* y0; const char* y1; const char* y2; const float* binr; int G, c;
  __device__ __forceinline__ bool next(int i, UnitD& u) const {
    const int tile = (i / 6) * G + c; if (tile >= 256) return false;
    const int kind = i % 6, n = kind >> 1, pm = (tile & 7) * 8 + (tile >> 5), pn = (tile >> 3) & 3;
    if ((kind & 1) == 0) { u.A0 = u.A1 = hn + (size_t)pm * 256 * 1024 * 2; u.B0 = u.B1 = wint + (size_t)(6144 + n * 1024 + pn * 256) * 1024 * 2; u.bias = binr + 6144 + n * 1024 + pn * 256; }
    else { u.A0 = u.A1 = (const char*)((size_t)y0 * (size_t)(n == 0) + (size_t)y1 * (size_t)(n == 1) + (size_t)y2 * (size_t)(n == 2)) + (size_t)pm * 256 * 1024 * 2; u.B0 = u.B1 = wbt + (size_t)(n * 1024 + pn * 256) * 1024 * 2; u.bias = nullptr; }
    u.out = nullptr; u.ldc = 1024; u.sub = kind; u.row0 = pm * 256; u.col0 = pn * 256; u.aux0 = 0; u.aux1 = 0; return true;
  }
};
struct SchedLru {
  const char* u_; const char* wl; int G, c;
  __device__ __forceinline__ bool next(int i, UnitD& u) const {
    const int L = i * G + c; if (L >= 512) return false;
    const int pm = (L & 7) * 8 + (L >> 6), pn = (L >> 3) & 7;
    u.A0 = u.A1 = u_ + ((size_t)pm * 256 * 1024 + (pn >> 1) * 256) * 2; u.B0 = u.B1 = wl + (size_t)pn * 131072;
    u.out = nullptr; u.bias = nullptr; u.ldc = 1024; u.sub = 0; u.row0 = pm * 256; u.col0 = (pn >> 1) * 256 + (pn & 1) * 128; u.aux0 = 0; u.aux1 = 0; return true;
  }
};

template <int NR>
__device__ __forceinline__ void rmsnorm_rows_bf16(const float* xr, const float* g, bf16_t* o, int lane) {
  f32x4 v[NR][4]; float s[NR];
#pragma unroll
  for (int r = 0; r < NR; ++r)
#pragma unroll
    for (int j = 0; j < 4; ++j) v[r][j] = ((const f32x4*)(xr + (size_t)r * 1024))[lane + 64 * j];
#pragma unroll
  for (int r = 0; r < NR; ++r) { float t = 0.f;
#pragma unroll
    for (int j = 0; j < 4; ++j) t += (v[r][j].x * v[r][j].x + v[r][j].y * v[r][j].y) + (v[r][j].z * v[r][j].z + v[r][j].w * v[r][j].w);
    s[r] = 1.0f / sqrtf(wave_sum(t) * (1.0f / 1024.0f) + 1e-6f); }
#pragma unroll
  for (int j = 0; j < 4; ++j) { const f32x4 gg = ((const f32x4*)g)[lane + 64 * j];
#pragma unroll
    for (int r = 0; r < NR; ++r) { u32x2 w; w.x = pk2(v[r][j].x * s[r] * gg.x, v[r][j].y * s[r] * gg.y); w.y = pk2(v[r][j].z * s[r] * gg.z, v[r][j].w * s[r] * gg.w); ((u32x2*)(o + (size_t)r * 1024))[lane + 64 * j] = w; } }
}
__device__ __forceinline__ void rmsnorm_row_bf16(const float* xr, const float* g, bf16_t* o, int lane) { rmsnorm_rows_bf16<1>(xr, g, o, lane); }

template <class RowMap>
__device__ __forceinline__ void transpose_tile(const float* __restrict__ src, int N, int K, int k0, int n0, bf16_t* dst, RowMap rm, float scale, LAS float* scr) {
  const int tid = threadIdx.x;
  { const int n4 = tid & 15, kk = tid >> 4;
    f32x4 a[4], b[4];
#pragma unroll
    for (int cb = 0; cb < 4; ++cb) { a[cb] = *(const f32x4*)(src + (size_t)(k0 + kk) * N + n0 + cb * 64 + 4 * n4); b[cb] = *(const f32x4*)(src + (size_t)(k0 + kk + 32) * N + n0 + cb * 64 + 4 * n4); }
#pragma unroll
    for (int cb = 0; cb < 4; ++cb) { LAS float* s0 = scr + kk * 261 + cb * 64 + 4 * n4; LAS float* s1 = s0 + 32 * 261;
      s0[0] = a[cb].x; s0[1] = a[cb].y; s0[2] = a[cb].z; s0[3] = a[cb].w; s1[0] = b[cb].x; s1[1] = b[cb].y; s1[2] = b[cb].z; s1[3] = b[cb].w; } }
  __syncthreads();
#pragma unroll
  for (int cb = 0; cb < 4; ++cb) { const int nn = cb * 64 + (tid >> 3), kc = tid & 7; const LAS float* s = scr + (kc * 8) * 261 + nn;
    u32x4 o; o.x = pk2(s[0] * scale, s[261] * scale); o.y = pk2(s[522] * scale, s[783] * scale); o.z = pk2(s[1044] * scale, s[1305] * scale); o.w = pk2(s[1566] * scale, s[1827] * scale);
    *(u32x4*)(dst + (size_t)rm(n0 + nn) * K + k0 + kc * 8) = o; }
  __syncthreads();
}
struct RmId { __device__ __forceinline__ int operator()(int n) const { return n; } };
struct RmWin { __device__ __forceinline__ int operator()(int n) const { const int b = n >> 10; const int mb = b == 0 ? 1 : b == 1 ? 3 : b == 2 ? 0 : b == 3 ? 4 : b == 4 ? 2 : b; return mb * 1024 + (n & 1023); } };
struct RmLru { int mat; __device__ __forceinline__ int operator()(int o) const { const int pnl = o >> 7, cl = o & 127; return pnl * 256 + 128 * (cl >> 6) + 32 * ((cl >> 4) & 3) + 8 * ((cl >> 2) & 3) + 4 * mat + (cl & 3); } };

template <bool MAX>
__device__ __forceinline__ float block_excl_scan(float v, LAS float* tmp) {
  const int lane = threadIdx.x & 63, wid = threadIdx.x >> 6;
  const float ident = MAX ? -3.0e38f : 0.f;
  float inc = v;
#pragma unroll
  for (int o = 1; o < 64; o <<= 1) { const float y = __shfl_up(inc, o); if (lane >= o) inc = MAX ? fmaxf(inc, y) : inc + y; }
  if (lane == 63) tmp[wid] = inc;
  __syncthreads();
  float base = ident;
  for (int w = 0; w < wid; ++w) base = MAX ? fmaxf(base, tmp[w]) : base + tmp[w];
  float ex = __shfl_up(inc, 1); if (lane == 0) ex = ident;
  __syncthreads();
  return MAX ? fmaxf(base, ex) : base + ex;
}

template <bool MLSTM>
__device__ __forceinline__ void conv_rows(const Params& p, const bf16_t* src, bf16_t* dst, const float* cw, const float* cb, float* gates, const float* b_if, LAS float* wxc, LAS float* wxm, int gw, int NW, int lane) {
  for (int t = gw; t < T; t += NW) {
    const int tl = t & (SEQ - 1);
    float g[8];
#pragma unroll
    for (int j = 0; j < 8; ++j) g[j] = 0.f;
#pragma unroll
    for (int i = 0; i < 2; ++i) { const int c0 = i * 512 + lane * 8;
      float o[8], xm[8];
      { const f32x4 a = *(const f32x4*)(cb + c0), b = *(const f32x4*)(cb + c0 + 4);
        o[0] = a.x; o[1] = a.y; o[2] = a.z; o[3] = a.w; o[4] = b.x; o[5] = b.y; o[6] = b.z; o[7] = b.w; }
#pragma unroll
      for (int e = 0; e < 8; ++e) xm[e] = 0.f;
#pragma unroll
      for (int k = 0; k < 4; ++k) {
        if (tl - 3 + k >= 0) {
          const u32x4 v = *(const u32x4*)(src + (size_t)(t - 3 + k) * 1024 + c0);
          const f32x4 wa = *(const f32x4*)(cw + k * 1024 + c0), wb = *(const f32x4*)(cw + k * 1024 + c0 + 4);
          const float xv[8] = {bf_lo(v.x), bf_hi(v.x), bf_lo(v.y), bf_hi(v.y), bf_lo(v.z), bf_hi(v.z), bf_lo(v.w), bf_hi(v.w)};
          const float wv[8] = {wa.x, wa.y, wa.z, wa.w, wb.x, wb.y, wb.z, wb.w};
#pragma unroll
          for (int e = 0; e < 8; ++e) { o[e] += wv[e] * xv[e]; if (k == 3) xm[e] = xv[e]; }
        }
      }
      if (MLSTM) {
#pragma unroll
        for (int e = 0; e < 8; ++e) o[e] = o[e] * sigm(o[e]);
#pragma unroll
        for (int e = 0; e < 8; ++e) { const int c = c0 + e;
          const f32x4 a0 = *(const LAS f32x4*)(wxc + c * 8), a1 = *(const LAS f32x4*)(wxc + c * 8 + 4), m0 = *(const LAS f32x4*)(wxm + c * 8), m1 = *(const LAS f32x4*)(wxm + c * 8 + 4);
          g[0] += o[e] * a0.x + xm[e] * m0.x; g[1] += o[e] * a0.y + xm[e] * m0.y; g[2] += o[e] * a0.z + xm[e] * m0.z; g[3] += o[e] * a0.w + xm[e] * m0.w;
          g[4] += o[e] * a1.x + xm[e] * m1.x; g[5] += o[e] * a1.y + xm[e] * m1.y; g[6] += o[e] * a1.z + xm[e] * m1.z; g[7] += o[e] * a1.w + xm[e] * m1.w; }
      }
      u32x4 ov; ov.x = pk2(o[0], o[1]); ov.y = pk2(o[2], o[3]); ov.z = pk2(o[4], o[5]); ov.w = pk2(o[6], o[7]);
      *(u32x4*)(dst + (size_t)t * 1024 + c0) = ov;
    }
    if (MLSTM) {
#pragma unroll
      for (int j = 0; j < 8; ++j) g[j] = wave_sum(g[j]);
      if (lane == 0) {
        f32x4 o0, o1;
        o0.x = g[0] + b_if[0]; o0.y = g[1] + b_if[1]; o0.z = g[2] + b_if[2]; o0.w = g[3] + b_if[3];
        o1.x = logsigm(g[4] + b_if[4]); o1.y = logsigm(g[5] + b_if[5]); o1.z = logsigm(g[6] + b_if[6]); o1.w = logsigm(g[7] + b_if[7]);
        *(f32x4*)(gates + (size_t)t * 8) = o0; *(f32x4*)(gates + (size_t)t * 8 + 4) = o1;
      }
    }
  }
}

template <bool SILU>
__device__ __forceinline__ void conv_stream(const bf16_t* src, bf16_t* dst, const float* cw, const float* cb, int gtid, int GT) {
  for (int g = gtid; g < 131072; g += GT) {
    const int cg = g & 127, tb = g >> 7, c0 = cg * 8, t0 = tb * 16;
    const bool first = ((t0 & (SEQ - 1)) == 0);
    u32x4 xr[19];
#pragma unroll
    for (int i = 0; i < 19; ++i) { if (i < 3 && first) xr[i] = (u32x4){0u, 0u, 0u, 0u}; else xr[i] = *(const u32x4*)(src + (size_t)(t0 - 3 + i) * 1024 + c0); }
    float w[4][8], bs[8];
#pragma unroll
    for (int k = 0; k < 4; ++k) { const f32x4 a = *(const f32x4*)(cw + k * 1024 + c0), b = *(const f32x4*)(cw + k * 1024 + c0 + 4);
      w[k][0] = a.x; w[k][1] = a.y; w[k][2] = a.z; w[k][3] = a.w; w[k][4] = b.x; w[k][5] = b.y; w[k][6] = b.z; w[k][7] = b.w; }
    { const f32x4 a = *(const f32x4*)(cb + c0), b = *(const f32x4*)(cb + c0 + 4); bs[0] = a.x; bs[1] = a.y; bs[2] = a.z; bs[3] = a.w; bs[4] = b.x; bs[5] = b.y; bs[6] = b.z; bs[7] = b.w; }
#pragma unroll
    for (int t = 0; t < 16; ++t) {
      float o[8];
#pragma unroll
      for (int e = 0; e < 8; ++e) o[e] = bs[e];
#pragma unroll
      for (int k = 0; k < 4; ++k) { const u32x4 v = xr[t + k];
        o[0] += w[k][0] * bf_lo(v.x); o[1] += w[k][1] * bf_hi(v.x); o[2] += w[k][2] * bf_lo(v.y); o[3] += w[k][3] * bf_hi(v.y);
        o[4] += w[k][4] * bf_lo(v.z); o[5] += w[k][5] * bf_hi(v.z); o[6] += w[k][6] * bf_lo(v.w); o[7] += w[k][7] * bf_hi(v.w); }
      if (SILU) {
#pragma unroll
        for (int e = 0; e < 8; ++e) o[e] = o[e] * sigm(o[e]); }
      u32x4 ov; ov.x = pk2(o[0], o[1]); ov.y = pk2(o[2], o[3]); ov.z = pk2(o[4], o[5]); ov.w = pk2(o[6], o[7]);
      *(u32x4*)(dst + (size_t)(t0 + t) * 1024 + c0) = ov;
    }
  }
}
__device__ __forceinline__ void gates_gemm(const bf16_t* xc, const bf16_t* xm, const bf16_t* wgT, float* part, int gw, int NW, int lane) {
  const int i16 = lane & 15, kg = lane >> 4;
  for (int item = gw; item < 2048; item += NW) {
    const int tile = item >> 1, half = item & 1, tok0 = tile * 16;
    f32x4 acc = {0.f, 0.f, 0.f, 0.f};
    const bf16_t* ap = (half ? xm : xc) + (size_t)(tok0 + i16) * 1024 + kg * 8;
    const bf16_t* bp = wgT + (size_t)i16 * 2048 + half * 1024 + kg * 8;
#pragma unroll 16
    for (int ks = 0; ks < 32; ++ks) { const bf16x8 a = *(const bf16x8*)(ap + ks * 32), b = *(const bf16x8*)(bp + ks * 32); acc = __builtin_amdgcn_mfma_f32_16x16x32_bf16(a, b, acc, 0, 0, 0); }
    if (i16 < 8) *(f32x4*)(part + ((size_t)half * 8 + i16) * T + tok0 + 4 * kg) = acc;
  }
}

#define XB_TMO      128
#define XB_XCNT(j)  (256  + 64 * (j))
#define XB_XSUB(j)  (1280 + 64 * (j))
#define XB_XGEN(j)  (2304 + 64 * (j))
#define XB_TOP      3328
#define XB_TOPGEN   3392
#define XCD_BAR_WORDS 3456
#define XB_SPIN_CAP (1u << 18)
__device__ __forceinline__ unsigned xb_ld(unsigned* p)              { return __hip_atomic_load(p, __ATOMIC_RELAXED, __HIP_MEMORY_SCOPE_AGENT); }
__device__ __forceinline__ unsigned xb_add(unsigned* p, unsigned v) { return __hip_atomic_fetch_add(p, v, __ATOMIC_RELAXED, __HIP_MEMORY_SCOPE_AGENT); }
__device__ __forceinline__ unsigned xb_xcc_id() { return (unsigned)__builtin_amdgcn_s_getreg((3 << 11) | 20) & 0xFu; }
#define XB_SPIN(cond, bar) do { unsigned _sp = 0; while (cond) { __builtin_amdgcn_s_sleep(1); \
    if ((++_sp & 255u) == 0u) { if (xb_ld(&(bar)[XB_TMO])) break; if (_sp > XB_SPIN_CAP) { atomicAdd(&(bar)[XB_TMO], 1u); break; } } } } while (0)
struct XcdBarrier { unsigned* bar; unsigned x; volatile LAS unsigned* st; };
__device__ __forceinline__ XcdBarrier xcd_barrier_post(unsigned* bar, volatile LAS unsigned* st) {
    XcdBarrier b; b.bar = bar; b.x = xb_xcc_id(); b.st = st;
    if (threadIdx.x == 0) (void)xb_add(&bar[XB_XCNT(b.x)], 1u);
    return b;
}
__device__ __forceinline__ void xcd_barrier_complete(unsigned* bar, unsigned x, unsigned& nloc, unsigned& nx) {
    const unsigned G = gridDim.x * gridDim.y * gridDim.z;
    unsigned sum, cnt, mine, sp = 0u;
    for (;;) {
        sum = 0u; cnt = 0u; mine = 0u;
#pragma unroll
        for (unsigned j = 0; j < 16; ++j) { const unsigned c = xb_ld(&bar[XB_XCNT(j)]); sum += c; cnt += (c > 0u) ? 1u : 0u; mine = (j == x) ? c : mine; }
        if (sum == G) break;
        __builtin_amdgcn_s_sleep(1);
        if ((++sp & 255u) == 0u) { if (xb_ld(&bar[XB_TMO])) break; if (sp > XB_SPIN_CAP) { atomicAdd(&bar[XB_TMO], 1u); break; } }
    }
    nloc = mine > 0u ? mine : 1u; nx = cnt > 0u ? cnt : 1u;
}
__device__ __forceinline__ void xcd_barrier(const XcdBarrier& b) {
    asm volatile("s_waitcnt vmcnt(0)" ::: "memory");
    __syncthreads();
    if (threadIdx.x == 0) {
        unsigned* bar = b.bar;
        __builtin_amdgcn_s_waitcnt(0);
        unsigned nloc = b.st[0], nx = b.st[1];
        if (nloc == 0u) { xcd_barrier_complete(bar, b.x, nloc, nx); b.st[0] = nloc; b.st[1] = nx; }
        const unsigned old = xb_add(&bar[XB_XSUB(b.x)], 1u);
        const unsigned gen = old / nloc;
        if (old + 1u == (gen + 1u) * nloc) {
            __builtin_amdgcn_fence(__ATOMIC_RELEASE, "agent");
            asm volatile("s_waitcnt vmcnt(0)" ::: "memory");
            const unsigned og = xb_add(&bar[XB_TOP], 1u);
            const unsigned tg = og / nx;
            if (og + 1u == (tg + 1u) * nx) xb_add(&bar[XB_TOPGEN], 1u);
            else XB_SPIN(xb_ld(&bar[XB_TOPGEN]) == tg, bar);
            __builtin_amdgcn_fence(__ATOMIC_ACQUIRE, "agent");
            xb_add(&bar[XB_XGEN(b.x)], 1u);
            asm volatile("s_waitcnt vmcnt(0)" ::: "memory");
        } else {
            XB_SPIN(xb_ld(&bar[XB_XGEN(b.x)]) == gen, bar);
            __builtin_amdgcn_fence(__ATOMIC_ACQUIRE, "agent");
            asm volatile("s_waitcnt vmcnt(0)" ::: "memory");
        }
    }
    __syncthreads();
}

#define W0 ((char*)p.ws + O_SLOTS)
#define W1 ((char*)p.ws + O_SLOTS + SLOT)
#define W2 ((char*)p.ws + O_SLOTS + 2 * SLOT)
#define W3 ((char*)p.ws + O_SLOTS + 3 * SLOT)
#define W4 ((char*)p.ws + O_SLOTS + 4 * SLOT)
#define W5 ((char*)p.ws + O_SLOTS + 5 * SLOT)
#define D0 ((char*)p.out)
#define D1 ((char*)p.out + SLOT)
#define WinT ((const char*)p.ws + O_WINT)
#define WbT ((const char*)p.ws + O_WBT)
#define WoutT ((const char*)p.ws + O_WOUTT)
#define WkvT ((const char*)p.ws + O_WKVT)
#define WqT ((const char*)p.ws + O_WQT)
#define WkT ((const char*)p.ws + O_WKT)
#define WvT ((const char*)p.ws + O_WVT)
#define WoT ((const char*)p.ws + O_WOT)
#define WlruT ((const char*)p.ws + O_WLRUT)
#define binR ((float*)(p.ws + O_BINR))
#define Wxc ((float*)(p.ws + O_WXC))
#define Wxm ((float*)(p.ws + O_WXM))
#define gates ((float*)(p.ws + O_GATES))
#define Bc ((float*)(p.ws + O_BC))
#define Av ((float*)(p.ws + O_AV))
#define Mt ((float*)(p.ws + O_MT))
#define denp ((float*)(p.ws + O_DENP))
#define nkloc ((float*)(p.ws + O_NKLOC))
#define nprev ((float*)(p.ws + O_NPREV))
#define Kmem ((char*)p.ws + O_KMEM)
#define VmemT ((char*)p.ws + O_VMEMT)
#define memN ((char*)p.ws + O_MEMN)
#define hend ((float*)(p.ws + O_HEND))
#define slog ((float*)(p.ws + O_SLOG))
#define carry ((float*)(p.ws + O_CARRY))
__device__ __forceinline__ void transpose_item(const Params& p, int it, LAS float* ldsf) {
  int r = it;
  if (r < 576) { transpose_tile(p.in[3], 9216, 1024, (r / 36) * 64, (r % 36) * 256, (bf16_t*)WinT, RmWin(), 1.0f, ldsf); return; } r -= 576;
  if (r < 192) { const int n_ = r >> 6, q = r & 63; transpose_tile(p.in[25] + (size_t)n_ * 1048576, 1024, 1024, (q >> 2) * 64, (q & 3) * 256, (bf16_t*)WbT + (size_t)n_ * 1048576, RmId(), 1.0f, ldsf); return; } r -= 192;
  if (r < 64) { transpose_tile(p.in[26], 1024, 1024, (r >> 2) * 64, (r & 3) * 256, (bf16_t*)WoutT, RmId(), 1.0f, ldsf); return; } r -= 64;
  if (r < 128) { transpose_tile(p.in[24], 2048, 1024, (r >> 3) * 64, (r & 7) * 256, (bf16_t*)WkvT, RmId(), 1.0f, ldsf); return; } r -= 128;
  if (r < 64) { const int mat = r >> 4, q = r & 15, h = q >> 2, kb = q & 3;
    const float* srcp = (mat == 0 ? p.in[14] : mat == 1 ? p.in[15] : mat == 2 ? p.in[16] : p.in[17]) + (size_t)h * 65536;
    bf16_t* dstp = (bf16_t*)WqT + (size_t)mat * 262144 + (size_t)h * 65536;
    transpose_tile(srcp, 256, 256, kb * 64, 0, dstp, RmId(), mat == 1 ? 0.0625f : 1.0f, ldsf); return; } r -= 64;
  { const int mat = r >> 4, q = r & 15, g = q >> 2, kb = q & 3; RmLru rm; rm.mat = mat;
    transpose_tile((mat == 0 ? p.in[7] : p.in[9]) + (size_t)g * 65536, 256, 256, kb * 64, 0, (bf16_t*)WlruT + (size_t)g * 131072, rm, 1.0f, ldsf); }
}

constexpr unsigned ALLPH = (1u << 18) - 1u;
template <unsigned MASK>
__global__ void __launch_bounds__(512) mk_fwd(Params p) {
  extern __shared__ __attribute__((aligned(16))) unsigned char smem[];
  LAS unsigned char* lds = (LAS unsigned char*)smem;
  LAS float* ldsf = (LAS float*)lds;
  LAS float* xP = (LAS float*)(lds + STAGE_BYTES);
  LAS float* xD = (LAS float*)(lds + STAGE_BYTES + 4096);
  LAS float* xW = (LAS float*)(lds + STAGE_BYTES + 5120);
  LAS float* xT = (LAS float*)(lds + STAGE_BYTES + 7168);
  cg::grid_group grid = cg::this_grid();
  volatile LAS unsigned* xst = (volatile LAS unsigned*)(lds + STAGE_BYTES + 8192);
  if (threadIdx.x == 0) { xst[0] = 0u; xst[1] = 0u; }
  __syncthreads();
  XcdBarrier xb; if constexpr (MASK == ALLPH) xb = xcd_barrier_post((unsigned*)(p.ws + O_BAR), xst);
  const int G = gridDim.x, wg = blockIdx.x, NW = G * 8, GT = G * 512;
  const float* x = p.in[0];

  if constexpr ((MASK >> 0) & 1) {
  int tid = threadIdx.x; asm volatile("" : "+v"(tid)); const int lane = tid & 63, wid = tid >> 6, gw = wg * 8 + wid, gtid = wg * 512 + tid; (void)lane; (void)gw; (void)gtid;
  {
    for (int e = wg; e < 256; e += G) {
      const int it = e < 64 ? (e >> 2) * 36 + 8 + (e & 3) : e < 192 ? 832 + (e - 64) : 960 + (e - 192);
      transpose_item(p, it, ldsf);
    }
    for (int row = gw * 4; row < T; row += NW * 4) rmsnorm_rows_bf16<4>(x + (size_t)row * 1024, p.in[2], (bf16_t*)W0 + (size_t)row * 1024, lane);
    for (int row = gw; row < 512; row += NW) rmsnorm_row_bf16(p.in[1] + (size_t)row * 1024, p.in[23], (bf16_t*)memN + (size_t)row * 1024, lane);
    for (int w = gw; w < 2048; w += NW) {
      const int which = w >> 10, i = w & 1023, h = i >> 8, ii = i & 255;
      float a[8];
#pragma unroll
      for (int j = 0; j < 8; ++j) a[j] = 0.f;
      const float* wif = p.in[19];
#pragma unroll
      for (int jj = 0; jj < 4; ++jj) { const int o = lane + 64 * jj;
        if (which == 0) {
          const float wq = p.in[14][(size_t)h * 65536 + ii * 256 + o], wk = p.in[15][(size_t)h * 65536 + ii * 256 + o];
          const f32x4 q0 = *(const f32x4*)(wif + (size_t)(h * 256 + o) * 8), q1 = *(const f32x4*)(wif + (size_t)(h * 256 + o) * 8 + 4);
          const f32x4 k0 = *(const f32x4*)(wif + (size_t)(1024 + h * 256 + o) * 8), k1 = *(const f32x4*)(wif + (size_t)(1024 + h * 256 + o) * 8 + 4);
          a[0] += wq * q0.x + wk * k0.x; a[1] += wq * q0.y + wk * k0.y; a[2] += wq * q0.z + wk * k0.z; a[3] += wq * q0.w + wk * k0.w;
          a[4] += wq * q1.x + wk * k1.x; a[5] += wq * q1.y + wk * k1.y; a[6] += wq * q1.z + wk * k1.z; a[7] += wq * q1.w + wk * k1.w;
        } else {
          const float wv = p.in[16][(size_t)h * 65536 + ii * 256 + o];
          const f32x4 v0 = *(const f32x4*)(wif + (size_t)(2048 + h * 256 + o) * 8), v1 = *(const f32x4*)(wif + (size_t)(2048 + h * 256 + o) * 8 + 4);
          a[0] += wv * v0.x; a[1] += wv * v0.y; a[2] += wv * v0.z; a[3] += wv * v0.w; a[4] += wv * v1.x; a[5] += wv * v1.y; a[6] += wv * v1.z; a[7] += wv * v1.w;
        } }
#pragma unroll
      for (int j = 0; j < 8; ++j) a[j] = wave_sum(a[j]);
      if (lane == 0) { bf16_t* d = (bf16_t*)(p.ws + O_WGT) + which * 1024 + i;
#pragma unroll
        for (int j = 0; j < 8; ++j) { d[(size_t)j * 2048] = (bf16_t)(pk2(a[j], 0.f) & 0xffffu); d[(size_t)(8 + j) * 2048] = 0; } }
    }
    for (int n = gtid; n < 9216; n += GT) binR[RmWin()((int)n)] = p.in[4][n];
  }
  }
  if constexpr (MASK == ALLPH) xcd_barrier(xb);

  if constexpr ((MASK >> 1) & 1) {
  int tid = threadIdx.x; asm volatile("" : "+v"(tid)); const int lane = tid & 63, wid = tid >> 6, gw = wg * 8 + wid, gtid = wg * 512 + tid; (void)lane; (void)gw; (void)gtid;
  {
    SchedTiles S; S.A = W0; S.Bt = WinT; S.out0 = W1; S.out1 = W1; S.bias = binR; S.nN = 4; S.G = G; S.c = wg;
    EpiBf16 E; E.m_Av = Av; E.m_Mt = Mt;
    gemm_phase<SchedTiles, EpiBf16, false>(lds, 1024, 1024, 16, 16, S, E);
  }
  }
  if constexpr (MASK == ALLPH) xcd_barrier(xb);

  if constexpr ((MASK >> 2) & 1) {
  int tid = threadIdx.x; asm volatile("" : "+v"(tid)); const int lane = tid & 63, wid = tid >> 6, gw = wg * 8 + wid, gtid = wg * 512 + tid; (void)lane; (void)gw; (void)gtid;
  {
    conv_stream<true>((const bf16_t*)W1, (bf16_t*)W2, p.in[12], p.in[13], gtid, GT);
  }
  }
  if constexpr (MASK == ALLPH) xcd_barrier(xb);

  if constexpr ((MASK >> 3) & 1) {
  int tid = threadIdx.x; asm volatile("" : "+v"(tid)); const int lane = tid & 63, wid = tid >> 6, gw = wg * 8 + wid, gtid = wg * 512 + tid; (void)lane; (void)gw; (void)gtid;
  {
    EpiBf16 E; E.m_Av = Av; E.m_Mt = Mt;
    SchedP3X SX; SX.xc = W2; SX.mx = W1; SX.wq = WqT; SX.wk = WkT; SX.wo = WoT; SX.q = W3; SX.k = W4; SX.og = W5; SX.b_o = p.in[18]; SX.G = G; SX.c = wg;
    gemm_phase<SchedP3X, EpiBf16, false>(lds, 1024, 256, 4, 4, SX, E);
    gates_gemm((const bf16_t*)W2, (const bf16_t*)W1, (const bf16_t*)(p.ws + O_WGT), gates, gw, NW, lane);
  }
  }
  if constexpr (MASK == ALLPH) xcd_barrier(xb);

  if constexpr ((MASK >> 4) & 1) {
  int tid = threadIdx.x; asm volatile("" : "+v"(tid)); const int lane = tid & 63, wid = tid >> 6, gw = wg * 8 + wid, gtid = wg * 512 + tid; (void)lane; (void)gw; (void)gtid;
  if (wg < 8) {
    const int b = wg >> 2, h = wg & 3;
    const size_t t0 = (size_t)b * SEQ + (size_t)tid * 16;
    float c[16], ig[16];
    float run = 0.f;
    { const float bi = p.in[20][h], bf = p.in[20][4 + h];
      const float* gi0 = gates + (size_t)h * T + t0; const float* gi1 = gates + (size_t)(8 + h) * T + t0;
      const float* gf0 = gates + (size_t)(4 + h) * T + t0; const float* gf1 = gates + (size_t)(12 + h) * T + t0;
#pragma unroll
      for (int k4 = 0; k4 < 4; ++k4) { const f32x4 a0 = *(const f32x4*)(gi0 + 4 * k4), a1 = *(const f32x4*)(gi1 + 4 * k4), f0 = *(const f32x4*)(gf0 + 4 * k4), f1 = *(const f32x4*)(gf1 + 4 * k4);
#pragma unroll
        for (int e = 0; e < 4; ++e) { ig[4 * k4 + e] = a0[e] + a1[e] + bi; run += logsigm(f0[e] + f1[e] + bf); c[4 * k4 + e] = run; } } }
    const float off = block_excl_scan<false>(run, xT);
    float pmx = -3.0e38f;
#pragma unroll
    for (int k = 0; k < 16; ++k) { c[k] += off; ig[k] = ig[k] - c[k]; pmx = fmaxf(pmx, ig[k]); }
    const float offm = block_excl_scan<true>(pmx, xT);
    float rm = offm;
#pragma unroll
    for (int k = 0; k < 16; ++k) { rm = fmaxf(rm, ig[k]); const float mtv = fmaxf(rm, 0.f); Bc[(t0 + k) * 4 + h] = c[k] + mtv;   Av[(t0 + k) * 4 + h] = ig[k]; Mt[(t0 + k) * 4 + h] = mtv; }
  } else if (wg < 24) {
    const int idx = wg - 8; SchedOne S; S.has = true;
    if (idx < 8) { const int pm = idx >> 2, pn = idx & 3;
      S.u.A0 = S.u.A1 = memN + (size_t)pm * 256 * 1024 * 2; S.u.B0 = S.u.B1 = WkvT + (size_t)pn * 256 * 1024 * 2; S.u.out = Kmem + ((size_t)pm * 256 * 1024 + pn * 256) * 2; S.u.ldc = 1024; }
    else { const int pm = (idx - 8) >> 1, b = (idx - 8) & 1;
      S.u.A0 = S.u.A1 = WkvT + (size_t)(1024 + pm * 256) * 1024 * 2; S.u.B0 = S.u.B1 = memN + (size_t)b * 256 * 1024 * 2; S.u.out = VmemT + (size_t)(b * 1024 + pm * 256) * 256 * 2; S.u.ldc = 256; }
    S.u.bias = nullptr; S.u.sub = 0; S.u.row0 = 0; S.u.col0 = 0; S.u.aux0 = 0; S.u.aux1 = 0;
    EpiBf16 E; E.m_Av = Av; E.m_Mt = Mt;
    gemm_phase<SchedOne, EpiBf16, false>(lds, 1024, 1024, 16, 16, S, E);
  } else {
    for (int l = wg - 24; l < 800; l += G - 24) {
      int it;
      if (l < 512) { const int j = l & 31; it = (l >> 5) * 36 + (j < 8 ? j : j + 4); }
      else if (l < 704) it = 576 + (l - 512); else if (l < 768) it = 768 + (l - 704); else it = 1024 + (l - 768);
      transpose_item(p, it, ldsf);
    }
    EpiBf16 E; E.m_Av = Av; E.m_Mt = Mt;
    SchedP3Y SY; SY.xc = W2; SY.mx = W1; SY.wk = WkT; SY.wv = WvT; SY.vt = D0; SY.ktw = D1; SY.G = G - 24; SY.c = wg - 24; SY.base = 0; SY.count = 256;
    gemm_phase<SchedP3Y, EpiBf16, false>(lds, 256, 1024, 4, 4, SY, E);
  }
  }
  if constexpr (MASK == ALLPH) xcd_barrier(xb);

  if constexpr ((MASK >> 5) & 1) {
  int tid = threadIdx.x; asm volatile("" : "+v"(tid)); const int lane = tid & 63, wid = tid >> 6, gw = wg * 8 + wid, gtid = wg * 512 + tid; (void)lane; (void)gw; (void)gtid;
  { EpiBf16 E; E.m_Av = Av; E.m_Mt = Mt;
    SchedP3Y SY; SY.xc = W2; SY.mx = W1; SY.wk = WkT; SY.wv = WvT; SY.vt = D0; SY.ktw = D1; SY.G = G; SY.c = wg; SY.base = 256; SY.count = 256;
    gemm_phase<SchedP3Y, EpiBf16, false>(lds, 256, 1024, 4, 4, SY, E);
    asm volatile("s_waitcnt vmcnt(0)" ::: "memory"); __syncthreads(); }
  if (wg < 256) { const int unit = wg;
    const int bh = unit >> 5, ci = unit & 31, b = bh >> 2, h = bh & 3, tok0 = b * SEQ + ci * 256;
    { SchedOne S; S.has = true; S.u.A0 = S.u.A1 = D0 + (size_t)unit * 131072; S.u.B0 = S.u.B1 = D1 + (size_t)unit * 131072; S.u.out = W1 + (size_t)unit * 131072; S.u.bias = nullptr; S.u.ldc = 256; S.u.sub = 0;
      S.u.row0 = tok0; S.u.col0 = 0; S.u.aux0 = h; S.u.aux1 = unit;
      EpiBf16 E; E.m_Av = Av; E.m_Mt = Mt;
      gemm_phase<SchedOne, EpiBf16, false>(lds, 256, 256, 4, 4, S, E); }
    { SchedOne S; S.has = true; const size_t to = ((size_t)tok0 * 1024 + h * 256) * 2;
      S.u.A0 = S.u.A1 = W3 + to; S.u.B0 = S.u.B1 = W4 + to; S.u.out = W0 + to; S.u.bias = nullptr; S.u.ldc = 1024; S.u.sub = 0; S.u.row0 = tok0; S.u.col0 = 0; S.u.aux0 = h; S.u.aux1 = unit;
      EpiU1 E; E.m_Av = Av; E.m_Mt = Mt; E.m_denp = denp;
      gemm_phase<SchedOne, EpiU1, false>(lds, 1024, 1024, 4, 4, S, E); }
    { const float mprev = ci == 0 ? 0.f : Mt[(size_t)(tok0 - 1) * 4 + h];
      const int r = tid >> 1, hf = tid & 1;
      const float sc = __expf(mprev - Mt[(size_t)(tok0 + r) * 4 + h]);
      u32x4* qp = (u32x4*)((bf16_t*)W3 + (size_t)(tok0 + r) * 1024 + h * 256 + hf * 128);
      u32x4 v[16];
#pragma unroll
      for (int i = 0; i < 16; ++i) v[i] = qp[i];
#pragma unroll
      for (int i = 0; i < 16; ++i) { u32x4 o;
        o.x = pk2(bf_lo(v[i].x) * sc, bf_hi(v[i].x) * sc); o.y = pk2(bf_lo(v[i].y) * sc, bf_hi(v[i].y) * sc); o.z = pk2(bf_lo(v[i].z) * sc, bf_hi(v[i].z) * sc); o.w = pk2(bf_lo(v[i].w) * sc, bf_hi(v[i].w) * sc); qp[i] = o; } }
    { const float me = Mt[(size_t)(tok0 + 255) * 4 + h];
      if (tid < 256) xW[tid] = __expf(Av[(size_t)(tok0 + tid) * 4 + h] - me);
      __syncthreads();
      const int cg8 = tid & 31, sg = tid >> 5;
      const bf16_t* kp = (const bf16_t*)W4 + (size_t)(tok0 + sg * 16) * 1024 + h * 256 + cg8 * 8;
      u32x4 v[16];
#pragma unroll
      for (int i = 0; i < 16; ++i) v[i] = *(const u32x4*)(kp + (size_t)i * 1024);
      float a[8];
#pragma unroll
      for (int j = 0; j < 8; ++j) a[j] = 0.f;
#pragma unroll
      for (int i = 0; i < 16; ++i) { const float w = xW[sg * 16 + i];
        a[0] += w * bf_lo(v[i].x); a[1] += w * bf_hi(v[i].x); a[2] += w * bf_lo(v[i].y); a[3] += w * bf_hi(v[i].y); a[4] += w * bf_lo(v[i].z); a[5] += w * bf_hi(v[i].z); a[6] += w * bf_lo(v[i].w); a[7] += w * bf_hi(v[i].w); }
#pragma unroll
      for (int j = 0; j < 8; ++j) ldsf[sg * 256 + cg8 * 8 + j] = a[j];
      __syncthreads();
      if (tid < 256) { float s = 0.f;
#pragma unroll
        for (int g2 = 0; g2 < 16; ++g2) s += ldsf[g2 * 256 + tid];
        nkloc[(size_t)unit * 256 + tid] = s; }
      __syncthreads(); }
  }
  }
  if constexpr (MASK == ALLPH) xcd_barrier(xb);

  if constexpr ((MASK >> 6) & 1) {
  int tid = threadIdx.x; asm volatile("" : "+v"(tid)); const int lane = tid & 63, wid = tid >> 6, gw = wg * 8 + wid, gtid = wg * 512 + tid; (void)lane; (void)gw; (void)gtid;
  {
    for (int g = gtid; g < 131072; g += GT) {
      const int bh = (int)(g >> 14), e4 = (int)(g & 16383), b = bh >> 2, h = bh & 3;
      u32x2* base = (u32x2*)((bf16_t*)W1 + (size_t)bh * 32 * 65536 + (size_t)e4 * 4);
      u32x2 kv[32]; float me[32];
#pragma unroll
      for (int c = 0; c < 32; ++c) { kv[c] = base[(size_t)c * 16384]; me[c] = Mt[(size_t)(b * SEQ + c * 256 + 255) * 4 + h]; }
      float C0 = 0.f, C1 = 0.f, C2 = 0.f, C3 = 0.f; float mprev = 0.f;
#pragma unroll
      for (int c = 0; c < 32; ++c) {
        const float dec = __expf(mprev - me[c]); mprev = me[c];
        u32x2 w; w.x = pk2(C0, C1); w.y = pk2(C2, C3); base[(size_t)c * 16384] = w;
        C0 = dec * C0 + bf_lo(kv[c].x); C1 = dec * C1 + bf_hi(kv[c].x); C2 = dec * C2 + bf_lo(kv[c].y); C3 = dec * C3 + bf_hi(kv[c].y);
      }
    }
    for (int g = gtid; g < 2048; g += GT) {
      const int bh = (int)(g >> 8), col = (int)(g & 255), b = bh >> 2, h = bh & 3;
      float nk[32], me[32];
#pragma unroll
      for (int c = 0; c < 32; ++c) { nk[c] = nkloc[(size_t)(bh * 32 + c) * 256 + col]; me[c] = Mt[(size_t)(b * SEQ + c * 256 + 255) * 4 + h]; }
      float n = 0.f, mprev = 0.f;
#pragma unroll
      for (int c = 0; c < 32; ++c) { const float dec = __expf(mprev - me[c]); mprev = me[c]; nprev[(size_t)(bh * 32 + c) * 256 + col] = n; n = dec * n + nk[c]; }
    }
    for (int row = gw * 4; row < T; row += NW * 4) rmsnorm_rows_bf16<4>(x + (size_t)row * 1024, p.in[2], (bf16_t*)W4 + (size_t)row * 1024, lane);
  }
  }
  if constexpr (MASK == ALLPH) xcd_barrier(xb);

  if constexpr ((MASK >> 7) & 1) {
  int tid = threadIdx.x; asm volatile("" : "+v"(tid)); const int lane = tid & 63, wid = tid >> 6, gw = wg * 8 + wid, gtid = wg * 512 + tid; (void)lane; (void)gw; (void)gtid;
  if (wg < 256) { const int unit = wg;
    const int bh = unit >> 5, ci = unit & 31, b = bh >> 2, h = bh & 3, tok0 = b * SEQ + ci * 256;
    { if (tid < 256) xW[tid] = nprev[(size_t)unit * 256 + tid];
      __syncthreads();
      const int r = tid >> 1, hf = tid & 1;
      const u32x4* qp = (const u32x4*)((const bf16_t*)W3 + (size_t)(tok0 + r) * 1024 + h * 256 + hf * 128);
      u32x4 v[16];
#pragma unroll
      for (int i = 0; i < 16; ++i) v[i] = qp[i];
      float s = 0.f;
#pragma unroll
      for (int i = 0; i < 16; ++i) { const LAS float* nv = xW + hf * 128 + i * 8;
        const f32x4 n0 = *(const LAS f32x4*)nv, n1 = *(const LAS f32x4*)(nv + 4);
        s += bf_lo(v[i].x) * n0.x + bf_hi(v[i].x) * n0.y + bf_lo(v[i].y) * n0.z + bf_hi(v[i].y) * n0.w + bf_lo(v[i].z) * n1.x + bf_hi(v[i].z) * n1.y + bf_lo(v[i].w) * n1.z + bf_hi(v[i].w) * n1.w; }
      s += __shfl_xor(s, 1);
      if (hf == 0) xD[r] = s;
      __syncthreads(); }
    SchedOne S; S.has = true; const size_t to = ((size_t)tok0 * 1024 + h * 256) * 2;
    S.u.A0 = W0 + to; S.u.A1 = W3 + to; S.u.B0 = D0 + (size_t)unit * 131072; S.u.B1 = W1 + (size_t)unit * 131072;
    S.u.out = nullptr; S.u.bias = nullptr; S.u.ldc = 1024; S.u.sub = 0; S.u.row0 = tok0; S.u.col0 = 0; S.u.aux0 = h; S.u.aux1 = unit;
    EpiU2 E; E.P = xP; E.deni = xD; E.m_denp = denp; E.m_Bc = Bc; E.m_Mt = Mt; E.og = (const bf16_t*)W5; E.norm_g = p.in[21]; E.skip = p.in[22]; E.xc = (bf16_t*)W2;
    gemm_phase<SchedOne, EpiU2, true>(lds, 1024, 256, 8, 4, S, E);
    __syncthreads();
  }
  }
  if constexpr (MASK == ALLPH) xcd_barrier(xb);

  if constexpr ((MASK >> 8) & 1) {
  int tid = threadIdx.x; asm volatile("" : "+v"(tid)); const int lane = tid & 63, wid = tid >> 6, gw = wg * 8 + wid, gtid = wg * 512 + tid; (void)lane; (void)gw; (void)gtid;
  {
    SchedTiles S; S.A = W4; S.Bt = WinT + (size_t)1024 * 1024 * 2; S.out0 = W0; S.out1 = W1; S.bias = binR + 1024; S.nN = 8; S.G = G; S.c = wg;
    EpiBf16 E; E.m_Av = Av; E.m_Mt = Mt;
    gemm_phase<SchedTiles, EpiBf16, false>(lds, 1024, 1024, 16, 16, S, E);
  }
  }
  if constexpr (MASK == ALLPH) xcd_barrier(xb);

  if constexpr ((MASK >> 9) & 1) {
  int tid = threadIdx.x; asm volatile("" : "+v"(tid)); const int lane = tid & 63, wid = tid >> 6, gw = wg * 8 + wid, gtid = wg * 512 + tid; (void)lane; (void)gw; (void)gtid;
  {
    conv_stream<false>((const bf16_t*)W0, (bf16_t*)W3, p.in[5], p.in[6], gtid, GT);
    if (wg < 256) { const int L = wg;
      const int pm = L >> 2, h = L & 3, b = pm >> 5;
      { SchedOne S; S.has = true;
        S.u.A0 = S.u.A1 = W1 + ((size_t)pm * 256 * 1024 + h * 256) * 2; S.u.B0 = S.u.B1 = Kmem + ((size_t)b * 256 * 1024 + h * 256) * 2; S.u.out = W5 + (size_t)L * 131072; S.u.bias = nullptr; S.u.ldc = 256; S.u.sub = 0;
        S.u.row0 = 0; S.u.col0 = 0; S.u.aux0 = 0; S.u.aux1 = 0;
        EpiSoftmax E; E.P = xP;
        gemm_phase<SchedOne, EpiSoftmax, true>(lds, 1024, 1024, 4, 4, S, E); }
      asm volatile("s_waitcnt vmcnt(0)" ::: "memory"); __syncthreads();
      { SchedOne S; S.has = true;
        S.u.A0 = S.u.A1 = W5 + (size_t)L * 131072; S.u.B0 = S.u.B1 = VmemT + (size_t)(b * 1024 + h * 256) * 256 * 2; S.u.out = D0 + ((size_t)pm * 256 * 1024 + h * 256) * 2; S.u.bias = nullptr; S.u.ldc = 1024; S.u.sub = 0;
        S.u.row0 = 0; S.u.col0 = 0; S.u.aux0 = 0; S.u.aux1 = 0;
        EpiBf16 E; E.m_Av = Av; E.m_Mt = Mt;
        gemm_phase<SchedOne, EpiBf16, false>(lds, 256, 256, 4, 4, S, E); }
      __syncthreads();
    }
  }
  }
  if constexpr (MASK == ALLPH) xcd_barrier(xb);

  if constexpr ((MASK >> 10) & 1) {
  int tid = threadIdx.x; asm volatile("" : "+v"(tid)); const int lane = tid & 63, wid = tid >> 6, gw = wg * 8 + wid, gtid = wg * 512 + tid; (void)lane; (void)gw; (void)gtid;
  {
    SchedLru S; S.u_ = W3; S.wl = WlruT; S.G = G; S.c = wg;
    EpiLru E; E.b_a = p.in[8]; E.b_x = p.in[10]; E.lam = p.in[11]; E.u = (const bf16_t*)W3; E.loga = (bf16_t*)W0; E.bb = (bf16_t*)W1;
    gemm_phase<SchedLru, EpiLru, false>(lds, 1024, 256, 4, 4, S, E);
    asm volatile("s_waitcnt vmcnt(0)" ::: "memory"); __syncthreads();
#pragma unroll 1
    for (int i = 0; i < 2; ++i) { const int L = i * G + wg; if (L < 512) {
      const int pm = (L & 7) * 8 + (L >> 6), pn = (L >> 3) & 7;
      const int ch = (pn >> 1) * 256 + (pn & 1) * 128 + (tid & 127), j = pm * 4 + (tid >> 7);
      const bf16_t* la = (const bf16_t*)W0 + (size_t)j * 64 * 1024 + ch; const bf16_t* bp = (const bf16_t*)W1 + (size_t)j * 64 * 1024 + ch;
      float h = 0.f, s = 0.f;
#pragma unroll 16
      for (int t = 0; t < 64; ++t) { const float l = bf2f(la[(size_t)t * 1024]); h = __expf(l) * h + bf2f(bp[(size_t)t * 1024]); s += l; }
      hend[(size_t)j * 1024 + ch] = h; slog[(size_t)j * 1024 + ch] = s; } }
  }
  }
  if constexpr (MASK == ALLPH) xcd_barrier(xb);

  if constexpr ((MASK >> 11) & 1) {
  int tid = threadIdx.x; asm volatile("" : "+v"(tid)); const int lane = tid & 63, wid = tid >> 6, gw = wg * 8 + wid, gtid = wg * 512 + tid; (void)lane; (void)gw; (void)gtid;
  }

  if constexpr ((MASK >> 12) & 1) {
  int tid = threadIdx.x; asm volatile("" : "+v"(tid)); const int lane = tid & 63, wid = tid >> 6, gw = wg * 8 + wid, gtid = wg * 512 + tid; (void)lane; (void)gw; (void)gtid;
  }

  if constexpr ((MASK >> 13) & 1) {
  int tid = threadIdx.x; asm volatile("" : "+v"(tid)); const int lane = tid & 63, wid = tid >> 6, gw = wg * 8 + wid, gtid = wg * 512 + tid; (void)lane; (void)gw; (void)gtid;
  for (int g = gtid; g < 131072; g += GT) {
    const int cp = (int)(g & 511), j = (int)(g >> 9);
    const unsigned* la = (const unsigned*)((const bf16_t*)W0 + (size_t)j * 64 * 1024 + cp * 2);
    const unsigned* bp = (const unsigned*)((const bf16_t*)W1 + (size_t)j * 64 * 1024 + cp * 2);
    unsigned* yo = (unsigned*)((bf16_t*)W3 + (size_t)j * 64 * 1024 + cp * 2);
    float h0 = 0.f, h1 = 0.f;
    { const int jb = (j >> 7) * 128, jl = j & 127;
#pragma unroll 8
      for (int jj = 0; jj < jl; ++jj) { const size_t o = (size_t)(jb + jj) * 1024 + cp * 2;
        const float sx = slog[o], sy = slog[o + 1], ex = hend[o], ey = hend[o + 1];
        h0 = __expf(sx) * h0 + ex; h1 = __expf(sy) * h1 + ey; } }
#pragma unroll 1
    for (int tb = 0; tb < 64; tb += 16) {
      unsigned av[16], bw[16];
#pragma unroll
      for (int t = 0; t < 16; ++t) { av[t] = la[(size_t)(tb + t) * 512]; bw[t] = bp[(size_t)(tb + t) * 512]; }
#pragma unroll
      for (int t = 0; t < 16; ++t) { h0 = __expf(bf_lo(av[t])) * h0 + bf_lo(bw[t]); h1 = __expf(bf_hi(av[t])) * h1 + bf_hi(bw[t]); yo[(size_t)(tb + t) * 512] = pk2(h0, h1); }
    }
  }
  }
  if constexpr (MASK == ALLPH) xcd_barrier(xb);

  if constexpr ((MASK >> 14) & 1) {
  int tid = threadIdx.x; asm volatile("" : "+v"(tid)); const int lane = tid & 63, wid = tid >> 6, gw = wg * 8 + wid, gtid = wg * 512 + tid; (void)lane; (void)gw; (void)gtid;
  {
    SchedZ S; S.hn = W4; S.wint = WinT; S.y0 = W3; S.y1 = W2; S.y2 = D0; S.binr = binR; S.G = G; S.c = wg;
    EpiZ E;
    gemm_phase<SchedZ, EpiZ, false>(lds, 1024, 1024, 16, 16, S, E);
  }
  }
  if constexpr (MASK == ALLPH) xcd_barrier(xb);

  if constexpr ((MASK >> 15) & 1) {
  int tid = threadIdx.x; asm volatile("" : "+v"(tid)); const int lane = tid & 63, wid = tid >> 6, gw = wg * 8 + wid, gtid = wg * 512 + tid; (void)lane; (void)gw; (void)gtid;
  {
    SchedMerge S; S.hn = W4; S.wint = WinT; S.wbt = WbT; S.y0 = W3; S.y1 = W2; S.y2 = D0; S.binr = binR; S.G = G; S.c = wg;
    EpiMerge E; E.gsc = (bf16_t*)D1; E.macc = (float*)W0; E.merged = (bf16_t*)W5;
    gemm_phase<SchedMerge, EpiMerge, false>(lds, 1024, 1024, 16, 16, S, E);
  }
  }
  if constexpr (MASK == ALLPH) xcd_barrier(xb);

  if constexpr ((MASK >> 16) & 1) {
  int tid = threadIdx.x; asm volatile("" : "+v"(tid)); const int lane = tid & 63, wid = tid >> 6, gw = wg * 8 + wid, gtid = wg * 512 + tid; (void)lane; (void)gw; (void)gtid;
  {
    int pm, pn; SchedOne S; S.has = static_tile((long)wg, 64, 4, pm, pn);
    S.u.A0 = S.u.A1 = W5 + (size_t)pm * 256 * 1024 * 2; S.u.B0 = S.u.B1 = WoutT + (size_t)pn * 256 * 1024 * 2; S.u.out = nullptr; S.u.bias = nullptr; S.u.ldc = 1024; S.u.sub = 0;
    S.u.row0 = pm * 256; S.u.col0 = pn * 256; S.u.aux0 = pm; S.u.aux1 = pn;
    EpiOutNorm E; E.x = x; E.out = p.out; E.g = p.in[27]; E.P = xP; E.xch = (float*)(p.ws + O_XCH); E.cnt = (unsigned*)(p.ws + O_CNT);
    gemm_phase<SchedOne, EpiOutNorm, true>(lds, 1024, 1024, 16, 16, S, E);
  }
  }


  if constexpr ((MASK >> 17) & 1) {
  int tid = threadIdx.x; asm volatile("" : "+v"(tid)); const int lane = tid & 63, wid = tid >> 6, gw = wg * 8 + wid, gtid = wg * 512 + tid; (void)lane; (void)gw; (void)gtid;
  }
}

#ifndef MK_SINGLE
#define MK_SINGLE 1
#endif
template <unsigned MASK>
static void launch_phase(const Params& p, int grid, size_t lds, hipStream_t stream) {
  static bool attr = false;
  if (!attr) { (void)hipFuncSetAttribute((const void*)mk_fwd<MASK>, hipFuncAttributeMaxDynamicSharedMemorySize, (int)lds); attr = true; }
  hipLaunchKernelGGL(mk_fwd<MASK>, dim3(grid), dim3(512), lds, stream, p);
}
extern "C" void kernel_launch(void* const* d_in, const int* in_sizes, int n_in, void* d_out, int out_size, void* d_ws, size_t ws_size, hipStream_t stream) {
  constexpr size_t kDynLds = STAGE_BYTES + 16384;
  static int grid_blocks = 0;
  if (!grid_blocks) {
    int dev = 0, cus = 0, per_cu = 0;
    (void)hipGetDevice(&dev);
    (void)hipDeviceGetAttribute(&cus, hipDeviceAttributeMultiprocessorCount, dev);
#if MK_SINGLE
    (void)hipFuncSetAttribute((const void*)mk_fwd<ALLPH>, hipFuncAttributeMaxDynamicSharedMemorySize, (int)kDynLds);
    (void)hipOccupancyMaxActiveBlocksPerMultiprocessor(&per_cu, (const void*)mk_fwd<ALLPH>, 512, kDynLds);
    if (per_cu < 1) fprintf(stderr, "occupancy query says %d blocks/CU\n", per_cu);
#endif
    if (ws_size < WS_NEED) fprintf(stderr, "workspace too small: %zu < %zu\n", ws_size, (size_t)WS_NEED);
    grid_blocks = 256; if (cus < 256) fprintf(stderr, "this kernel needs 256 CUs, device has %d\n", cus);
  }
  Params p{};
  for (int i = 0; i < 28; ++i) p.in[i] = (const float*)d_in[i];
  p.out = (float*)d_out; p.ws = (unsigned char*)d_ws;
#if MK_SINGLE
  (void)hipMemsetAsync((unsigned char*)d_ws + O_BAR, 0, 32768, stream);
  void* args[] = {&p};
  hipError_t e = hipLaunchCooperativeKernel((void*)mk_fwd<ALLPH>, dim3(grid_blocks), dim3(512), args, kDynLds, stream);
  if (e != hipSuccess) fprintf(stderr, "cooperative launch failed: %s (grid %d)\n", hipGetErrorString(e), grid_blocks);
#else
  const int g = grid_blocks;
  launch_phase<1u << 0>(p, g, kDynLds, stream); launch_phase<1u << 1>(p, g, kDynLds, stream); launch_phase<1u << 2>(p, g, kDynLds, stream); launch_phase<1u << 3>(p, g, kDynLds, stream);
  launch_phase<1u << 4>(p, g, kDynLds, stream); launch_phase<1u << 5>(p, g, kDynLds, stream); launch_phase<1u << 6>(p, g, kDynLds, stream); launch_phase<1u << 7>(p, g, kDynLds, stream);
  launch_phase<1u << 8>(p, g, kDynLds, stream); launch_phase<1u << 9>(p, g, kDynLds, stream); launch_phase<1u << 10>(p, g, kDynLds, stream); launch_phase<1u << 11>(p, g, kDynLds, stream);
  launch_phase<1u << 12>(p, g, kDynLds, stream); launch_phase<1u << 13>(p, g, kDynLds, stream); launch_phase<1u << 14>(p, g, kDynLds, stream); launch_phase<1u << 15>(p, g, kDynLds, stream);
  launch_phase<1u << 16>(p, g, kDynLds, stream); launch_phase<1u << 17>(p, g, kDynLds, stream);
#endif
}
```

```cpp
#include <hip/hip_runtime.h>
#include <hip/hip_cooperative_groups.h>
#include <cstdio>
namespace cg = cooperative_groups;

#define LAS __attribute__((address_space(3)))
typedef unsigned short bf16_t;
typedef short bf16x8 __attribute__((ext_vector_type(8)));
typedef float f32x4 __attribute__((ext_vector_type(4)));
typedef unsigned u32x4 __attribute__((ext_vector_type(4)));
typedef unsigned u32x2 __attribute__((ext_vector_type(2)));

constexpr int T = 16384, DM = 1024, SEQ = 8192;
constexpr size_t SLOT = (size_t)T * DM * 2;

constexpr size_t O_WINT = 0;
constexpr size_t O_WBT = O_WINT + (size_t)9216 * 1024 * 2;
constexpr size_t O_WOUTT = O_WBT + (size_t)3 * 1024 * 1024 * 2;
constexpr size_t O_WKVT = O_WOUTT + (size_t)1024 * 1024 * 2;
constexpr size_t O_WQT = O_WKVT + (size_t)2048 * 1024 * 2;
constexpr size_t O_WKT = O_WQT + 524288;
constexpr size_t O_WVT = O_WKT + 524288;
constexpr size_t O_WOT = O_WVT + 524288;
constexpr size_t O_WLRUT = O_WOT + 524288;
constexpr size_t O_BINR = O_WLRUT + 1048576;
constexpr size_t O_WXC = O_BINR + 36864;
constexpr size_t O_WXM = O_WXC + 32768;
constexpr size_t O_GATES = O_WXM + 32768;
constexpr size_t O_BC = O_GATES + (size_t)T * 32 * 4;
constexpr size_t O_AV = O_BC + (size_t)T * 4 * 4;
constexpr size_t O_MT = O_AV + (size_t)T * 4 * 4;
constexpr size_t O_DENP = O_MT + (size_t)T * 4 * 4;
constexpr size_t O_NKLOC = O_DENP + 1048576;
constexpr size_t O_NPREV = O_NKLOC + 262144;
constexpr size_t O_KMEM = O_NPREV + 262144;
constexpr size_t O_VMEMT = O_KMEM + 1048576;
constexpr size_t O_MEMN = O_VMEMT + 1048576;
constexpr size_t O_HEND = O_MEMN + 1048576;
constexpr size_t O_SLOG = O_HEND + 1048576;
constexpr size_t O_CARRY = O_SLOG + 1048576;
constexpr size_t O_BAR = O_CARRY + 1048576;
constexpr size_t O_CNT = O_BAR + 16384;
constexpr size_t O_XCH = O_CNT + 16384;
constexpr size_t O_WGT = O_XCH + 262144;
constexpr size_t O_SMALL_END = O_WGT + 65536;
constexpr size_t O_SLOTS = (size_t)46 * 1024 * 1024;
static_assert(O_SMALL_END <= O_SLOTS, "small region overflow");
constexpr size_t WS_NEED = O_SLOTS + 6 * SLOT;

struct Params { const float* in[28]; float* out; unsigned char* ws; };

__device__ __forceinline__ unsigned pk2(float lo, float hi) { unsigned r; asm volatile("v_cvt_pk_bf16_f32 %0, %1, %2" : "=v"(r) : "v"(lo), "v"(hi)); return r; }
__device__ __forceinline__ float bf_lo(unsigned w) { return __uint_as_float(w << 16); }
__device__ __forceinline__ float bf_hi(unsigned w) { return __uint_as_float(w & 0xffff0000u); }
__device__ __forceinline__ float bf2f(bf16_t b) { return __uint_as_float(((unsigned)b) << 16); }
__device__ __forceinline__ float sigm(float x) { return 1.0f / (1.0f + __expf(-x)); }
__device__ __forceinline__ float logsigm(float x) { return fminf(x, 0.f) - log1pf(expf(-fabsf(x))); }
__device__ __forceinline__ float wave_sum(float v) {
#pragma unroll
  for (int o = 1; o < 64; o <<= 1) v += __shfl_xor(v, o);
  return v;
}

constexpr int BM = 256, BK = 64, HALF = 128, HTB = HALF * BK * 2, STAGE_BYTES = 8 * HTB;
__device__ __forceinline__ int lds_byte(int r, int c) { const int st = (r >> 4) * 2 + (c >> 5), rr = r & 15, cc = c & 31, ob = rr * 64 + cc * 2; return st * 1024 + (ob ^ (((ob >> 9) & 1) << 5)); }
__device__ __forceinline__ void stage_rc(int b, int& R, int& C) { const int st = b / 1024, sb = b % 1024, swz = sb ^ (((sb >> 9) & 1) << 5); R = (st >> 1) * 16 + swz / 64; C = (st & 1) * 32 + (swz % 64) / 2; }

__device__ __forceinline__ int perm32(int rho) { const int n = rho >> 4, i = rho & 15; return 8 * (i >> 2) + 4 * n + (i & 3); }
struct UnitD { const char* A0; const char* A1; const char* B0; const char* B1; char* out; const float* bias; int ldc, sub, row0, col0, aux0, aux1; };

__device__ __forceinline__ bool static_tile(long L, int nM, int nN, int& pm, int& pn) {
  const int nwg = nM * nN; if (L >= nwg) return false;
  int wgid = (int)L; { const int q = nwg / 8, r = nwg % 8, xcd = wgid % 8, off = wgid / 8; wgid = (xcd < r ? xcd * (q + 1) : r * (q + 1) + (xcd - r) * q) + off; }
  const int nig = 8 * nN, gid = wgid / nig, fm = gid * 8, gsz = (nM - fm) < 8 ? (nM - fm) : 8;
  pm = fm + ((wgid % nig) % gsz); pn = (wgid % nig) / gsz; return true;
}

#define ROWOF(ai, m) (128 * (ai) + 64 * wr + 16 * (m) + fr)
#define COLOF(bj, n) (128 * (bj) + 32 * wc + 8 * fq + 4 * (n))
#define UNR _Pragma("unroll")

#ifndef GP_SP2
#define GP_SP2 0
#endif
#ifndef GP_ALIGN
#define GP_ALIGN 1
#endif
template <class Sched, class Epi, bool DRAIN>
__device__ __forceinline__ void gemm_phase(LAS unsigned char* lds, const int lda, const int ldb, const int nt, const int nt0, const Sched& S, const Epi& E) {
  int tid = threadIdx.x; asm volatile("" : "+v"(tid));
  const int wid = __builtin_amdgcn_readfirstlane(tid >> 6), lane = tid & 63, wr = wid >> 2, wc = wid & 3, fr = lane & 15, fq = lane >> 4;
  unsigned voffA, voffB;
  { int R, C; stage_rc(tid * 16, R, C); const int Rb = (R & ~31) + perm32(R & 31); voffA = (unsigned)(R * lda + C) * 2u; voffB = (unsigned)(Rb * ldb + C) * 2u; }
  const size_t qstepA = (size_t)64 * lda * 2, qstepB = (size_t)64 * ldb * 2;
  const size_t kstep = (size_t)(BK * 2);
  const size_t hstepA = (size_t)HALF * lda * 2, hstepB = (size_t)HALF * ldb * 2;
  const unsigned ldsw = (unsigned)wid * 1024u;
  const int aoff = lds_byte(wr * 64 + fr, fq * 8), boff = lds_byte(wc * 32 + fr, fq * 8);
#define G_SA(b, h) (((b) * 2 + (h)) * HTB)
#define G_SB(b, h) ((4 + (b) * 2 + (h)) * HTB)
#define qoffA qstepA
#define qoffB qstepB
#define voffA_ voffA
#define G_STAGE(bufoff, gbase, voff) do { _Pragma("unroll") for (int _i = 0; _i < 2; ++_i) \
    __builtin_amdgcn_global_load_lds((const unsigned*)((const char*)(gbase) + (size_t)_i * q##voff + v##voff), (LAS unsigned*)(lds + (bufoff) + ldsw + _i * 8192), 16, 0, 0); } while (0)
#define G_LDA(dst, b, h) do { _Pragma("unroll") for (int m = 0; m < 4; ++m) _Pragma("unroll") for (int k = 0; k < 2; ++k) dst[m][k] = *(const LAS bf16x8*)(lds + G_SA(b, h) + aoff + m * 2048 + k * 1024); } while (0)
#define G_LDB(dst, b, h) do { _Pragma("unroll") for (int n = 0; n < 2; ++n) _Pragma("unroll") for (int k = 0; k < 2; ++k) dst[n][k] = *(const LAS bf16x8*)(lds + G_SB(b, h) + boff + n * 2048 + k * 1024); } while (0)
#define G_MMA(ai, bj, At, Bt) do { __builtin_amdgcn_s_setprio(1); _Pragma("unroll") for (int m = 0; m < 4; ++m) _Pragma("unroll") for (int n = 0; n < 2; ++n) _Pragma("unroll") for (int k = 0; k < 2; ++k) \
    acc[ai][bj][m][n] = __builtin_amdgcn_mfma_f32_16x16x32_bf16(Bt[n][k], At[m][k], acc[ai][bj][m][n], 0, 0, 0); __builtin_amdgcn_s_setprio(0); } while (0)
#define G_WAIT_V(n) asm volatile("s_waitcnt vmcnt(" #n ")" ::: "memory")
#define G_WAIT_L(n) asm volatile("s_waitcnt lgkmcnt(" #n ")" ::: "memory")
#define G_BAR __builtin_amdgcn_s_barrier()
#define G_SCHED __builtin_amdgcn_sched_barrier(0)
  UnitD cur, nxt; int ui = 0;
  if (!S.next(0, cur)) return;
  f32x4 acc[2][2][4][2];
#pragma unroll
  for (int a = 0; a < 2; ++a)
#pragma unroll
    for (int b = 0; b < 2; ++b)
#pragma unroll
      for (int m = 0; m < 4; ++m)
#pragma unroll
        for (int n = 0; n < 2; ++n) acc[a][b][m][n] = (f32x4){0.f, 0.f, 0.f, 0.f};
  bf16x8 At[4][2], B0[2][2], B1[2][2];
  {
    const char* cA = cur.A0; const char* cB = cur.B0;
#if GP_SP2
    G_STAGE(G_SB(0, 0), cB, offB); G_STAGE(G_SB(0, 1), cB + hstepB, offB); G_STAGE(G_SA(0, 0), cA, offA); G_STAGE(G_SA(0, 1), cA + hstepA, offA);
    if (wr == 1) G_BAR;
    G_WAIT_V(2); G_BAR;
    G_STAGE(G_SB(1, 0), cB + kstep, offB); G_STAGE(G_SA(1, 0), cA + kstep, offA); G_STAGE(G_SB(1, 1), cB + hstepB + kstep, offB);
    G_WAIT_V(6); G_BAR;
#else
    G_STAGE(G_SB(0, 0), cB, offB); G_STAGE(G_SA(0, 0), cA, offA); G_STAGE(G_SB(0, 1), cB + hstepB, offB); G_STAGE(G_SA(0, 1), cA + hstepA, offA);
    if (wr == 1) G_BAR;
    G_WAIT_V(4); G_BAR;
    G_STAGE(G_SB(1, 0), cB + kstep, offB); G_STAGE(G_SA(1, 0), cA + kstep, offA); G_STAGE(G_SB(1, 1), cB + hstepB + kstep, offB);
    G_WAIT_V(6); G_BAR;
#endif
  }
  for (;;) {
    const bool has_next = S.next(ui + 1, nxt);
    const char* nA = has_next ? nxt.A0 : cur.A0; const char* nB = has_next ? nxt.B0 : cur.B0;
    for (int t = 0; t < nt; t += 2) {
      const bool last = (t == nt - 2);
      const char* a1 = (t + 1 < nt0) ? cur.A0 + (size_t)(t + 1) * kstep : cur.A1 + (size_t)(t + 1 - nt0) * kstep;
      const char* a2; const char* b2;
      if (last) { a2 = nA; b2 = nB; }
      else if (t + 2 < nt0) { a2 = cur.A0 + (size_t)(t + 2) * kstep; b2 = cur.B0 + (size_t)(t + 2) * kstep; }
      else { a2 = cur.A1 + (size_t)(t + 2 - nt0) * kstep; b2 = cur.B1 + (size_t)(t + 2 - nt0) * kstep; }
      const char* a3 = a2 + kstep; const char* b3 = b2 + kstep;
#if GP_SP2
      G_LDB(B0, 0, 0); G_LDB(B1, 0, 1); G_SCHED; G_LDA(At, 0, 0); G_STAGE(G_SA(1, 1), a1 + hstepA, offA);
      G_WAIT_V(8); G_WAIT_L(0); G_BAR; G_MMA(0, 0, At, B0); G_MMA(0, 1, At, B1); G_BAR; G_SCHED;
      G_LDA(At, 0, 1); G_STAGE(G_SB(0, 0), b2, offB); G_STAGE(G_SB(0, 1), b2 + hstepB, offB); G_STAGE(G_SA(0, 0), a2, offA);
      G_WAIT_V(8); G_WAIT_L(0); G_BAR; G_MMA(1, 0, At, B0); G_MMA(1, 1, At, B1); G_BAR; G_SCHED;
      G_LDB(B0, 1, 0); G_LDB(B1, 1, 1); G_SCHED; G_LDA(At, 1, 0); G_STAGE(G_SA(0, 1), a2 + hstepA, offA);
      G_WAIT_V(8); G_WAIT_L(0); G_BAR; G_MMA(0, 0, At, B0); G_MMA(0, 1, At, B1); G_BAR; G_SCHED;
      G_LDA(At, 1, 1); G_STAGE(G_SB(1, 0), b3, offB); G_STAGE(G_SB(1, 1), b3 + hstepB, offB); G_STAGE(G_SA(1, 0), a3, offA);
      G_WAIT_V(8); G_WAIT_L(0); G_BAR; G_MMA(1, 0, At, B0); G_MMA(1, 1, At, B1); G_BAR; G_SCHED;
#else
      G_LDB(B0, 0, 0); G_SCHED; G_LDA(At, 0, 0); G_STAGE(G_SA(1, 1), a1 + hstepA, offA);
      G_WAIT_L(8); G_BAR; G_WAIT_L(0); G_MMA(0, 0, At, B0); G_BAR; G_SCHED;
      G_LDB(B1, 0, 1); G_STAGE(G_SB(0, 0), b2, offB);
      G_BAR; G_WAIT_L(0); G_MMA(0, 1, At, B1); G_BAR;
      G_LDA(At, 0, 1); G_STAGE(G_SA(0, 0), a2, offA);
      G_BAR; G_WAIT_L(0); G_MMA(1, 0, At, B0); G_BAR; G_SCHED;
      G_STAGE(G_SB(0, 1), b2 + hstepB, offB);
      G_WAIT_V(6); G_BAR; G_MMA(1, 1, At, B1); G_BAR;
      G_LDB(B0, 1, 0); G_SCHED; G_LDA(At, 1, 0); G_STAGE(G_SA(0, 1), a2 + hstepA, offA);
      G_WAIT_L(8); G_BAR; G_WAIT_L(0); G_MMA(0, 0, At, B0); G_BAR; G_SCHED;
      G_LDB(B1, 1, 1); G_STAGE(G_SB(1, 0), b3, offB);
      G_BAR; G_WAIT_L(0); G_MMA(0, 1, At, B1); G_BAR;
      G_LDA(At, 1, 1); G_STAGE(G_SA(1, 0), a3, offA);
      G_BAR; G_WAIT_L(0); G_MMA(1, 0, At, B0); G_BAR; G_SCHED;
      G_STAGE(G_SB(1, 1), b3 + hstepB, offB);
      G_WAIT_V(6); G_BAR; G_MMA(1, 1, At, B1); G_BAR;
#endif
    }
#if GP_ALIGN
    if (wr == 0) G_BAR;
#endif
    if constexpr (!DRAIN) { int fr2 = fr, fq2 = fq; asm volatile("" : "+v"(fr2), "+v"(fq2)); E.run(acc, cur, wr, wc, fr2, fq2); }
    if (!has_next) break;
#pragma unroll
    for (int a = 0; a < 2; ++a)
#pragma unroll
      for (int b = 0; b < 2; ++b)
#pragma unroll
        for (int m = 0; m < 4; ++m)
#pragma unroll
          for (int n = 0; n < 2; ++n) acc[a][b][m][n] = (f32x4){0.f, 0.f, 0.f, 0.f};
    cur = nxt; ++ui;
#if GP_ALIGN
    if (wr == 1) G_BAR;
#endif
  }
  G_WAIT_V(0);
#if !GP_ALIGN
  if (wr == 0) G_BAR;
#endif
  G_BAR;
  if constexpr (DRAIN) { int fr2 = fr, fq2 = fq; asm volatile("" : "+v"(fr2), "+v"(fq2)); E.run(acc, cur, wr, wc, fr2, fq2); }
#undef G_SA
#undef G_SB
#undef G_STAGE
#undef G_LDA
#undef G_LDB
#undef G_MMA
#undef G_WAIT_V
#undef G_WAIT_L
#undef G_BAR
#undef G_SCHED
}

typedef f32x4 Acc[2][2][4][2];

template <bool MAX>
__device__ __forceinline__ void row_allreduce(float (&v)[2][4], LAS float* P, int wr, int wc, int fr, int fq) {
  UNR for (int ai = 0; ai < 2; ++ai) UNR for (int m = 0; m < 4; ++m) {
    float x = v[ai][m];
    float y = __shfl_xor(x, 16); x = MAX ? fmaxf(x, y) : x + y;
    y = __shfl_xor(x, 32); x = MAX ? fmaxf(x, y) : x + y;
    if (fq == 0) P[ROWOF(ai, m) * 4 + wc] = x;
  }
  __syncthreads();
  UNR for (int ai = 0; ai < 2; ++ai) UNR for (int m = 0; m < 4; ++m) {
    const f32x4 q = *(const LAS f32x4*)(P + ROWOF(ai, m) * 4);
    v[ai][m] = MAX ? fmaxf(fmaxf(q.x, q.y), fmaxf(q.z, q.w)) : (q.x + q.y) + (q.z + q.w);
  }
  __syncthreads();
}

struct EpiBf16 {
  const float* m_Av; const float* m_Mt;
  __device__ __forceinline__ void run(Acc& acc, const UnitD& u, int wr, int wc, int fr, int fq) const {
    bf16_t* base = (bf16_t*)u.out + (size_t)(64 * wr + fr) * u.ldc + 32 * wc + 8 * fq;
    UNR for (int bj = 0; bj < 2; ++bj) {
      f32x4 b0 = u.bias ? *(const f32x4*)(u.bias + COLOF(bj, 0)) : (f32x4){0.f, 0.f, 0.f, 0.f};
      f32x4 b1 = u.bias ? *(const f32x4*)(u.bias + COLOF(bj, 1)) : (f32x4){0.f, 0.f, 0.f, 0.f};
      if (u.sub == 2) { const float me = m_Mt[(size_t)(u.row0 + 255) * 4 + u.aux0];
        UNR for (int j = 0; j < 4; ++j) { b0[j] = __expf(m_Av[(size_t)(u.row0 + COLOF(bj, 0) + j) * 4 + u.aux0] - me); b1[j] = __expf(m_Av[(size_t)(u.row0 + COLOF(bj, 1) + j) * 4 + u.aux0] - me); } }
      UNR for (int ai = 0; ai < 2; ++ai) UNR for (int m = 0; m < 4; ++m) {
        f32x4 v0 = acc[ai][bj][m][0], v1 = acc[ai][bj][m][1];
        if (u.sub == 2) { v0 = v0 * b0; v1 = v1 * b1; } else { v0 = v0 + b0; v1 = v1 + b1; }
        if (u.sub == 1) { v0.x = sigm(v0.x); v0.y = sigm(v0.y); v0.z = sigm(v0.z); v0.w = sigm(v0.w); v1.x = sigm(v1.x); v1.y = sigm(v1.y); v1.z = sigm(v1.z); v1.w = sigm(v1.w); }
        u32x4 w; w.x = pk2(v0.x, v0.y); w.y = pk2(v0.z, v0.w); w.z = pk2(v1.x, v1.y); w.w = pk2(v1.z, v1.w);
        *(u32x4*)(base + (size_t)(128 * ai + 16 * m) * u.ldc + 128 * bj) = w;
      }
      asm volatile("" ::: "memory");
    }
  }
};
struct EpiU1 {
  const float* m_Av; const float* m_Mt; float* m_denp;
  __device__ __forceinline__ void run(Acc& acc, const UnitD& u, int wr, int wc, int fr, int fq) const {
    const int h = u.aux0, unit = u.aux1, tok0 = u.row0;
    float av[2][8];
    UNR for (int bj = 0; bj < 2; ++bj) UNR for (int j = 0; j < 8; ++j) av[bj][j] = m_Av[(size_t)(tok0 + COLOF(bj, 0) + j) * 4 + h];
    float mtv[2][4];
    UNR for (int ai = 0; ai < 2; ++ai) UNR for (int m = 0; m < 4; ++m) mtv[ai][m] = m_Mt[(size_t)(tok0 + ROWOF(ai, m)) * 4 + h];
    UNR for (int ai = 0; ai < 2; ++ai) UNR for (int m = 0; m < 4; ++m) {
      const int r = ROWOF(ai, m);
      const float mt = mtv[ai][m];
      bf16_t* rowp = (bf16_t*)u.out + (size_t)r * u.ldc;
      float rs = 0.f;
      UNR for (int bj = 0; bj < 2; ++bj) {
        float v[8];
        UNR for (int j = 0; j < 8; ++j) { const int c = COLOF(bj, 0) + j; const float w = (c <= r) ? __expf(av[bj][j] - mt) : 0.f; v[j] = acc[ai][bj][m][j >> 2][j & 3] * w; rs += v[j]; }
        u32x4 w2; w2.x = pk2(v[0], v[1]); w2.y = pk2(v[2], v[3]); w2.z = pk2(v[4], v[5]); w2.w = pk2(v[6], v[7]);
        *(u32x4*)(rowp + COLOF(bj, 0)) = w2;
      }
      rs += __shfl_xor(rs, 16); rs += __shfl_xor(rs, 32);
      if (fq == 0) m_denp[((size_t)unit * 256 + r) * 4 + wc] = rs;
      asm volatile("" ::: "memory");
    }
  }
};
struct EpiLru {
  const float* b_a; const float* b_x; const float* lam; const bf16_t* u; bf16_t* loga; bf16_t* bb;
  __device__ __forceinline__ void run(Acc& acc, const UnitD& ud, int wr, int wc, int fr, int fq) const {
    const int chb = ud.col0;
    UNR for (int bj = 0; bj < 2; ++bj) {
      const int ch = chb + 64 * bj + 16 * wc + 4 * fq;
      const f32x4 ba = *(const f32x4*)(b_a + ch), bx = *(const f32x4*)(b_x + ch), l = *(const f32x4*)(lam + ch);
      f32x4 ls;
      UNR for (int j = 0; j < 4; ++j) ls[j] = 8.0f * logsigm(l[j]);
      const size_t o0 = ((size_t)ud.row0 + 64 * wr + fr) * 1024 + ch;
      UNR for (int ai = 0; ai < 2; ++ai) { u32x2 uq[4];
      UNR for (int m = 0; m < 4; ++m) uq[m] = *(const u32x2*)(u + o0 + (size_t)(128 * ai + 16 * m) * 1024);
      UNR for (int m = 0; m < 4; ++m) {
        const size_t o = o0 + (size_t)(128 * ai + 16 * m) * 1024;
        const u32x2 uw = uq[m];
        const float uu[4] = {bf_lo(uw.x), bf_hi(uw.x), bf_lo(uw.y), bf_hi(uw.y)};
        float la[4], bv[4];
        UNR for (int j = 0; j < 4; ++j) {
          const float rg = sigm(acc[ai][bj][m][0][j] + ba[j]);
          const float ig = sigm(acc[ai][bj][m][1][j] + bx[j]);
          la[j] = rg * ls[j];
          const float x2 = 2.0f * la[j];
          const float om = (x2 > -0.02f) ? -(x2 * (1.0f + x2 * (0.5f + x2 * (1.0f / 6.0f)))) : 1.0f - __expf(x2);
          bv[j] = sqrtf(fmaxf(om, 0.f)) * ig * uu[j];
        }
        u32x2 w1; w1.x = pk2(la[0], la[1]); w1.y = pk2(la[2], la[3]);
        u32x2 w2; w2.x = pk2(bv[0], bv[1]); w2.y = pk2(bv[2], bv[3]);
        *(u32x2*)(loga + o) = w1; *(u32x2*)(bb + o) = w2;
      }
      asm volatile("" ::: "memory"); }
    }
  }
};
struct EpiZ {
  __device__ __forceinline__ void run(Acc& acc, const UnitD& u, int wr, int wc, int fr, int fq) const {
    bf16_t* base = (bf16_t*)u.out + (size_t)(64 * wr + fr) * u.ldc + 32 * wc + 8 * fq;
    UNR for (int bj = 0; bj < 2; ++bj) {
      const f32x4 b0 = *(const f32x4*)(u.bias + COLOF(bj, 0)), b1 = *(const f32x4*)(u.bias + COLOF(bj, 1));
      u32x4 o[2][4];
      UNR for (int ai = 0; ai < 2; ++ai) UNR for (int m = 0; m < 4; ++m) o[ai][m] = *(const u32x4*)(base + (size_t)(128 * ai + 16 * m) * u.ldc + 128 * bj);
      UNR for (int ai = 0; ai < 2; ++ai) UNR for (int m = 0; m < 4; ++m) {
        const f32x4 z0 = acc[ai][bj][m][0] + b0, z1 = acc[ai][bj][m][1] + b1; const u32x4 ov = o[ai][m];
        u32x4 w; w.x = pk2(bf_lo(ov.x) * z0.x * sigm(z0.x), bf_hi(ov.x) * z0.y * sigm(z0.y)); w.y = pk2(bf_lo(ov.y) * z0.z * sigm(z0.z), bf_hi(ov.y) * z0.w * sigm(z0.w));
        w.z = pk2(bf_lo(ov.z) * z1.x * sigm(z1.x), bf_hi(ov.z) * z1.y * sigm(z1.y)); w.w = pk2(bf_lo(ov.w) * z1.z * sigm(z1.z), bf_hi(ov.w) * z1.w * sigm(z1.w));
        *(u32x4*)(base + (size_t)(128 * ai + 16 * m) * u.ldc + 128 * bj) = w;
      }
      asm volatile("" ::: "memory");
    }
  }
};
struct EpiMerge {
  bf16_t* gsc; float* macc; bf16_t* merged;
  __device__ __forceinline__ void run(Acc& acc, const UnitD& u, int wr, int wc, int fr, int fq) const {
    const size_t org = (size_t)(u.row0 + 64 * wr + fr) * 1024 + u.col0 + 32 * wc + 8 * fq;
    if ((u.sub & 1) == 0) {
      UNR for (int bj = 0; bj < 2; ++bj) {
        const f32x4 b0 = *(const f32x4*)(u.bias + COLOF(bj, 0)), b1 = *(const f32x4*)(u.bias + COLOF(bj, 1));
        UNR for (int ai = 0; ai < 2; ++ai) UNR for (int m = 0; m < 4; ++m) {
          const f32x4 v0 = acc[ai][bj][m][0] + b0, v1 = acc[ai][bj][m][1] + b1;
          u32x4 w; w.x = pk2(sigm(v0.x), sigm(v0.y)); w.y = pk2(sigm(v0.z), sigm(v0.w)); w.z = pk2(sigm(v1.x), sigm(v1.y)); w.w = pk2(sigm(v1.z), sigm(v1.w));
          *(u32x4*)(gsc + org + (size_t)(128 * ai + 16 * m) * 1024 + 128 * bj) = w;
        }
      }
    } else {
      UNR for (int bj = 0; bj < 2; ++bj) {
        u32x4 g[2][4], a[2][4];
        UNR for (int ai = 0; ai < 2; ++ai) UNR for (int m = 0; m < 4; ++m) { const size_t o = org + (size_t)(128 * ai + 16 * m) * 1024 + 128 * bj; g[ai][m] = *(const u32x4*)(gsc + o); if (u.sub != 1) a[ai][m] = *(const u32x4*)(merged + o); }
        UNR for (int ai = 0; ai < 2; ++ai) UNR for (int m = 0; m < 4; ++m) {
          const size_t o = org + (size_t)(128 * ai + 16 * m) * 1024 + 128 * bj;
          const u32x4 gg = g[ai][m];
          f32x4 v0 = acc[ai][bj][m][0], v1 = acc[ai][bj][m][1];
          v0.x *= bf_lo(gg.x); v0.y *= bf_hi(gg.x); v0.z *= bf_lo(gg.y); v0.w *= bf_hi(gg.y); v1.x *= bf_lo(gg.z); v1.y *= bf_hi(gg.z); v1.z *= bf_lo(gg.w); v1.w *= bf_hi(gg.w);
          if (u.sub != 1) { const u32x4 aa = a[ai][m]; v0.x += bf_lo(aa.x); v0.y += bf_hi(aa.x); v0.z += bf_lo(aa.y); v0.w += bf_hi(aa.y); v1.x += bf_lo(aa.z); v1.y += bf_hi(aa.z); v1.z += bf_lo(aa.w); v1.w += bf_hi(aa.w); }
          u32x4 w; w.x = pk2(v0.x, v0.y); w.y = pk2(v0.z, v0.w); w.z = pk2(v1.x, v1.y); w.w = pk2(v1.z, v1.w); *(u32x4*)(merged + o) = w;
        }
        asm volatile("" ::: "memory");
      }
    }
  }
};
struct EpiOut {
  const float* x; float* out;
  __device__ __forceinline__ void run(Acc& acc, const UnitD& u, int wr, int wc, int fr, int fq) const {
    const size_t org = (size_t)(u.row0 + 64 * wr + fr) * 1024 + u.col0 + 32 * wc + 8 * fq;
    UNR for (int bj = 0; bj < 2; ++bj) {
      f32x4 xv[2][4][2];
      UNR for (int ai = 0; ai < 2; ++ai) UNR for (int m = 0; m < 4; ++m) { const size_t o = org + (size_t)(128 * ai + 16 * m) * 1024 + 128 * bj; xv[ai][m][0] = *(const f32x4*)(x + o); xv[ai][m][1] = *(const f32x4*)(x + o + 4); }
      UNR for (int ai = 0; ai < 2; ++ai) UNR for (int m = 0; m < 4; ++m) { const size_t o = org + (size_t)(128 * ai + 16 * m) * 1024 + 128 * bj;
        *(f32x4*)(out + o) = xv[ai][m][0] + acc[ai][bj][m][0]; *(f32x4*)(out + o + 4) = xv[ai][m][1] + acc[ai][bj][m][1]; }
      asm volatile("" ::: "memory");
    }
  }
};
struct EpiSoftmax {
  LAS float* P;
  __device__ __forceinline__ void run(Acc& acc, const UnitD& u, int wr, int wc, int fr, int fq) const {
    float mx[2][4], sm[2][4];
    UNR for (int ai = 0; ai < 2; ++ai) UNR for (int m = 0; m < 4; ++m) { float x = -3.0e38f;
      UNR for (int bj = 0; bj < 2; ++bj) UNR for (int n = 0; n < 2; ++n) UNR for (int j = 0; j < 4; ++j) { acc[ai][bj][m][n][j] *= 0.0625f; x = fmaxf(x, acc[ai][bj][m][n][j]); }
      mx[ai][m] = x; }
    row_allreduce<true>(mx, P, wr, wc, fr, fq);
    UNR for (int ai = 0; ai < 2; ++ai) UNR for (int m = 0; m < 4; ++m) { float s = 0.f;
      UNR for (int bj = 0; bj < 2; ++bj) UNR for (int n = 0; n < 2; ++n) UNR for (int j = 0; j < 4; ++j) { const float e = __expf(acc[ai][bj][m][n][j] - mx[ai][m]); acc[ai][bj][m][n][j] = e; s += e; }
      sm[ai][m] = s; }
    row_allreduce<false>(sm, P, wr, wc, fr, fq);
    UNR for (int ai = 0; ai < 2; ++ai) UNR for (int m = 0; m < 4; ++m) {
      const float inv = 1.0f / sm[ai][m];
      bf16_t* rowp = (bf16_t*)u.out + (size_t)ROWOF(ai, m) * u.ldc;
      UNR for (int bj = 0; bj < 2; ++bj) { const f32x4 v0 = acc[ai][bj][m][0] * inv, v1 = acc[ai][bj][m][1] * inv;
        u32x4 w; w.x = pk2(v0.x, v0.y); w.y = pk2(v0.z, v0.w); w.z = pk2(v1.x, v1.y); w.w = pk2(v1.z, v1.w); *(u32x4*)(rowp + COLOF(bj, 0)) = w; }
    }
  }
};
struct EpiU2 {
  LAS float* P; LAS float* deni; const float* m_denp; const float* m_Bc; const float* m_Mt; const bf16_t* og; const float* norm_g; const float* skip; bf16_t* xc;
  __device__ __forceinline__ void run(Acc& acc, const UnitD& u, int wr, int wc, int fr, int fq) const {
    const int h = u.aux0, unit = u.aux1, tok0 = u.row0;
    float s1[2][4], s2[2][4];
    UNR for (int ai = 0; ai < 2; ++ai) UNR for (int m = 0; m < 4; ++m) {
      const int r = ROWOF(ai, m); const size_t tok = (size_t)tok0 + r;
      const f32x4 dp = *(const f32x4*)(m_denp + ((size_t)unit * 256 + r) * 4);
      const float den = (dp.x + dp.y) + (dp.z + dp.w) + deni[r];
      const float mt = m_Bc[tok * 4 + h];
      const float inv = 1.0f / fmaxf(fabsf(den), __expf(-mt));
      float s = 0.f;
      const bf16_t* ogp = og + tok * 1024 + h * 256 + 32 * wc + 8 * fq;
      UNR for (int bj = 0; bj < 2; ++bj) {
        const u32x4 o = *(const u32x4*)(ogp + 128 * bj);
        f32x4 v0 = acc[ai][bj][m][0] * inv, v1 = acc[ai][bj][m][1] * inv;
        v0.x *= bf_lo(o.x); v0.y *= bf_hi(o.x); v0.z *= bf_lo(o.y); v0.w *= bf_hi(o.y); v1.x *= bf_lo(o.z); v1.y *= bf_hi(o.z); v1.z *= bf_lo(o.w); v1.w *= bf_hi(o.w);
        acc[ai][bj][m][0] = v0; acc[ai][bj][m][1] = v1; s += ((v0.x + v0.y) + (v0.z + v0.w)) + ((v1.x + v1.y) + (v1.z + v1.w));
      }
      s1[ai][m] = s;
      if (m == 3) asm volatile("" ::: "memory");
    }
    row_allreduce<false>(s1, P, wr, wc, fr, fq);
    UNR for (int ai = 0; ai < 2; ++ai) UNR for (int m = 0; m < 4; ++m) { const float mu = s1[ai][m] * (1.0f / 256.0f); float s = 0.f;
      UNR for (int bj = 0; bj < 2; ++bj) UNR for (int n = 0; n < 2; ++n) { f32x4 v = acc[ai][bj][m][n] - mu; acc[ai][bj][m][n] = v; s += (v.x * v.x + v.y * v.y) + (v.z * v.z + v.w * v.w); }
      s2[ai][m] = s; }
    row_allreduce<false>(s2, P, wr, wc, fr, fq);
    UNR for (int ai = 0; ai < 2; ++ai) UNR for (int m = 0; m < 4; ++m) s2[ai][m] = 1.0f / sqrtf(s2[ai][m] * (1.0f / 256.0f) + 1e-6f);
    bf16_t* xb = xc + (size_t)(tok0 + 64 * wr + fr) * 1024 + h * 256 + 32 * wc + 8 * fq;
    UNR for (int bj = 0; bj < 2; ++bj) {
      const int ch = h * 256 + COLOF(bj, 0);
      const f32x4 g0 = *(const f32x4*)(norm_g + ch), g1 = *(const f32x4*)(norm_g + ch + 4), k0 = *(const f32x4*)(skip + ch), k1 = *(const f32x4*)(skip + ch + 4);
      UNR for (int ai = 0; ai < 2; ++ai) {
        u32x4 xq[4];
        UNR for (int m = 0; m < 4; ++m) xq[m] = *(const u32x4*)(xb + (size_t)(128 * ai + 16 * m) * 1024 + 128 * bj);
        UNR for (int m = 0; m < 4; ++m) {
          const u32x4 xv = xq[m];
          const f32x4 v0 = acc[ai][bj][m][0] * s2[ai][m], v1 = acc[ai][bj][m][1] * s2[ai][m];
          u32x4 w; w.x = pk2(v0.x * g0.x + k0.x * bf_lo(xv.x), v0.y * g0.y + k0.y * bf_hi(xv.x)); w.y = pk2(v0.z * g0.z + k0.z * bf_lo(xv.y), v0.w * g0.w + k0.w * bf_hi(xv.y));
          w.z = pk2(v1.x * g1.x + k1.x * bf_lo(xv.z), v1.y * g1.y + k1.y * bf_hi(xv.z)); w.w = pk2(v1.z * g1.z + k1.z * bf_lo(xv.w), v1.w * g1.w + k1.w * bf_hi(xv.w));
          *(u32x4*)(xb + (size_t)(128 * ai + 16 * m) * 1024 + 128 * bj) = w;
        }
        asm volatile("" ::: "memory");
      }
    }
  }
};

struct EpiOutNorm {
  const float* x; float* out; const float* g; LAS float* P; float* xch; unsigned* cnt;
  __device__ __forceinline__ void run(Acc& acc, const UnitD& u, int wr, int wc, int fr, int fq) const {
    const int pm = u.aux0, pn = u.aux1;
    const size_t org = (size_t)(u.row0 + 64 * wr + fr) * 1024 + u.col0 + 32 * wc + 8 * fq;
    UNR for (int bj = 0; bj < 2; ++bj) UNR for (int ai = 0; ai < 2; ++ai) {
      f32x4 xv[4][2];
      UNR for (int m = 0; m < 4; ++m) { const size_t o = org + (size_t)(128 * ai + 16 * m) * 1024 + 128 * bj; xv[m][0] = *(const f32x4*)(x + o); xv[m][1] = *(const f32x4*)(x + o + 4); }
      UNR for (int m = 0; m < 4; ++m) { acc[ai][bj][m][0] += xv[m][0]; acc[ai][bj][m][1] += xv[m][1]; }
      asm volatile("" ::: "memory");
    }
    float ss[2][4];
    UNR for (int ai = 0; ai < 2; ++ai) UNR for (int m = 0; m < 4; ++m) { float s = 0.f;
      UNR for (int bj = 0; bj < 2; ++bj) UNR for (int n = 0; n < 2; ++n) { const f32x4 v = acc[ai][bj][m][n]; s += (v.x * v.x + v.y * v.y) + (v.z * v.z + v.w * v.w); }
      ss[ai][m] = s; }
    row_allreduce<false>(ss, P, wr, wc, fr, fq);
    if (wc == 0 && fq == 0) {
      UNR for (int ai = 0; ai < 2; ++ai) UNR for (int m = 0; m < 4; ++m)
        __hip_atomic_store(xch + ((size_t)(pm * 256 + ROWOF(ai, m))) * 4 + pn, ss[ai][m], __ATOMIC_RELAXED, __HIP_MEMORY_SCOPE_AGENT);
    }
    asm volatile("s_waitcnt vmcnt(0)" ::: "memory");
    __syncthreads();
    if (threadIdx.x == 0) {
      unsigned* c = cnt + 64 * pm;
      __hip_atomic_fetch_add(c, 1u, __ATOMIC_RELAXED, __HIP_MEMORY_SCOPE_AGENT);
      unsigned sp = 0;
      while (__hip_atomic_load(c, __ATOMIC_RELAXED, __HIP_MEMORY_SCOPE_AGENT) < 4u) { __builtin_amdgcn_s_sleep(1); if (++sp > (1u << 22)) break; }
      __builtin_amdgcn_fence(__ATOMIC_ACQUIRE, "agent");
      asm volatile("s_waitcnt vmcnt(0)" ::: "memory");
    }
    __syncthreads();
    UNR for (int ai = 0; ai < 2; ++ai) UNR for (int m = 0; m < 4; ++m) {
      const float* sl = xch + ((size_t)(pm * 256 + ROWOF(ai, m))) * 4;
      const float t = (__hip_atomic_load(sl, __ATOMIC_RELAXED, __HIP_MEMORY_SCOPE_AGENT) + __hip_atomic_load(sl + 1, __ATOMIC_RELAXED, __HIP_MEMORY_SCOPE_AGENT))
                    + (__hip_atomic_load(sl + 2, __ATOMIC_RELAXED, __HIP_MEMORY_SCOPE_AGENT) + __hip_atomic_load(sl + 3, __ATOMIC_RELAXED, __HIP_MEMORY_SCOPE_AGENT));
      ss[ai][m] = 1.0f / sqrtf(t * (1.0f / 1024.0f) + 1e-6f);
    }
    int fr3 = fr, fq3 = fq; asm volatile("" : "+v"(fr3), "+v"(fq3));
    const size_t org2 = (size_t)(u.row0 + 64 * wr + fr3) * 1024 + u.col0 + 32 * wc + 8 * fq3;
    UNR for (int bj = 0; bj < 2; ++bj) {
      const f32x4 g0 = *(const f32x4*)(g + u.col0 + COLOF(bj, 0)), g1 = *(const f32x4*)(g + u.col0 + COLOF(bj, 1));
      UNR for (int ai = 0; ai < 2; ++ai) UNR for (int m = 0; m < 4; ++m) { const size_t o = org2 + (size_t)(128 * ai + 16 * m) * 1024 + 128 * bj;
        *(f32x4*)(out + o) = acc[ai][bj][m][0] * ss[ai][m] * g0; *(f32x4*)(out + o + 4) = acc[ai][bj][m][1] * ss[ai][m] * g1; }
    }
  }
};

struct SchedTiles {
  const char* A; const char* Bt; char* out0; char* out1; const float* bias; int nN, G, c;
  __device__ __forceinline__ bool next(int i, UnitD& u) const {
    int pm, pn; if (!static_tile((long)i * G + c, 64, nN, pm, pn)) return false;
    u.A0 = u.A1 = A + (size_t)pm * 256 * 1024 * 2; u.B0 = u.B1 = Bt + (size_t)pn * 256 * 1024 * 2;
    u.out = ((pn >> 2) ? out1 : out0) + ((size_t)pm * 256 * 1024 + (pn & 3) * 256) * 2; u.bias = bias ? bias + pn * 256 : nullptr; u.ldc = 1024; u.sub = 0;
    u.row0 = pm * 256; u.col0 = (pn & 3) * 256; u.aux0 = 0; u.aux1 = 0; return true;
  }
};
struct SchedOne { UnitD u; bool has; __device__ __forceinline__ bool next(int i, UnitD& o) const { if (i != 0 || !has) return false; o = u; return true; } };
struct SchedP3X {
  const char* xc; const char* mx; const char* wq; const char* wk; const char* wo; char* q; char* k; char* og; const float* b_o; int G, c;
  __device__ __forceinline__ bool next(int i, UnitD& u) const {
    const int L = i * G + c; if (L >= 768) return false;
    const int kind = L >> 8, idx = L & 255, pm = idx >> 2, h = idx & 3;
    const size_t to = ((size_t)pm * 256 * 1024 + h * 256) * 2;
    u.A0 = u.A1 = (kind == 2 ? mx : xc) + to; u.B0 = u.B1 = wq + (size_t)(kind == 0 ? 0 : kind == 1 ? 524288 : 1572864) + (size_t)h * 131072;
    u.out = q + (size_t)kind * SLOT + to; u.bias = kind == 2 ? b_o + h * 256 : nullptr; u.ldc = 1024; u.sub = kind == 2 ? 1 : 0;
    u.row0 = pm * 256; u.col0 = h * 256; u.aux0 = h; u.aux1 = 0; return true;
  }
};
struct SchedP3Y {
  const char* xc; const char* mx; const char* wk; const char* wv; char* vt; char* ktw; int G, c, base, count;
  __device__ __forceinline__ bool next(int i, UnitD& u) const {
    const int Lr = i * G + c; if (Lr >= count) return false;
    const int L = base + Lr;
    const int kind = L >> 8, unit = L & 255, bh = unit >> 5, ci = unit & 31, b = bh >> 2, h = bh & 3, tok0 = b * SEQ + ci * 256;
    u.A0 = u.A1 = (kind ? wk : wv) + (size_t)h * 131072; u.B0 = u.B1 = (kind ? xc : mx) + ((size_t)tok0 * 1024 + h * 256) * 2;
    u.out = (kind ? ktw : vt) + (size_t)unit * 131072; u.bias = nullptr; u.ldc = 256; u.sub = kind ? 2 : 0; u.row0 = tok0; u.col0 = 0; u.aux0 = h; u.aux1 = unit; return true;
  }
};
struct SchedZ {
  const char* hn; const char* wint; char* y0; char* y1; char* y2; const float* binr; int G, c;
  __device__ __forceinline__ bool next(int i, UnitD& u) const {
    const int L = i * G + c; if (L >= 768) return false;
    const int br = L >> 8, r = L & 255, pm = (r & 7) * 8 + (r >> 5), pn = (r >> 3) & 3;
    u.A0 = u.A1 = hn + (size_t)pm * 256 * 1024 * 2; u.B0 = u.B1 = wint + (size_t)(3072 + br * 1024 + pn * 256) * 1024 * 2;
    u.out = (char*)((size_t)y0 * (size_t)(br == 0) + (size_t)y1 * (size_t)(br == 1) + (size_t)y2 * (size_t)(br == 2)) + ((size_t)pm * 256 * 1024 + pn * 256) * 2; u.bias = binr + 3072 + br * 1024 + pn * 256; u.ldc = 1024; u.sub = 0; u.row0 = pm * 256; u.col0 = pn * 256; u.aux0 = 0; u.aux1 = 0; return true;
  }
};
struct SchedMerge {
  const char* hn; const char* wint; const char* wbt; const char* y0; const char* y1; const char* y2; const float* binr; int G, c;
  __device__ __forceinline__ bool next(int i, UnitD& u) const {
    const int tile = (i / 6) * G + c; if (tile >= 256) return false;
    const int kind = i % 6, n = kind >> 1, pm = (tile & 7) * 8 + (tile >> 5), pn = (tile >> 3) & 3;
    if ((kind & 1) == 0) { u.A0 = u.A1 = hn + (size_t)pm * 256 * 1024 * 2; u.B0 = u.B1 = wint + (size_t)(6144 + n * 1024 + pn * 256) * 1024 * 2; u.bias = binr + 6144 + n * 1024 + pn * 256; }
    else { u.A0 = u.A1 = (const char*)((size_t)y0 * (size_t)(n == 0) + (size_t)y1 * (size_t)(n == 1) + (size_t)y2 * (size_t)(n == 2)) + (size_t)pm * 256 * 1024 * 2; u.B0 = u.B1 = wbt + (size_t)(n * 1024 + pn * 256) * 1024 * 2; u.bias = nullptr; }
    u.out = nullptr; u.ldc = 1024; u.sub = kind; u.row0 = pm * 256; u.col0 = pn * 256; u.aux0 = 0; u.aux1 = 0; return true;
  }
};
struct SchedLru {
  const char* u_; const char* wl; int G, c;
  __device__ __forceinline__ bool next(int i, UnitD& u) const {
    const int L = i * G + c; if (L >= 512) return false;
    const int pm = (L & 7) * 8 + (L >> 6), pn = (L >> 3) & 7;
    u.A0 = u.A1 = u_ + ((size_t)pm * 256 * 1024 + (pn >> 1) * 256) * 2; u.B0 = u.B1 = wl + (size_t)pn * 131072;
    u.out = nullptr; u.bias = nullptr; u.ldc = 1024; u.sub = 0; u.row0 = pm * 256; u.col0 = (pn >> 1) * 256 + (pn & 1) * 128; u.aux0 = 0; u.aux1 = 0; return true;
  }
};

template <int NR>
__device__ __forceinline__ void rmsnorm_rows_bf16(const float* xr, const float* g, bf16_t* o, int lane) {
  f32x4 v[NR][4]; float s[NR];
#pragma unroll
  for (int r = 0; r < NR; ++r)
#pragma unroll
    for (int j = 0; j < 4; ++j) v[r][j] = ((const f32x4*)(xr + (size_t)r * 1024))[lane + 64 * j];
#pragma unroll
  for (int r = 0; r < NR; ++r) { float t = 0.f;
#pragma unroll
    for (int j = 0; j < 4; ++j) t += (v[r][j].x * v[r][j].x + v[r][j].y * v[r][j].y) + (v[r][j].z * v[r][j].z + v[r][j].w * v[r][j].w);
    s[r] = 1.0f / sqrtf(wave_sum(t) * (1.0f / 1024.0f) + 1e-6f); }
#pragma unroll
  for (int j = 0; j < 4; ++j) { const f32x4 gg = ((const f32x4*)g)[lane + 64 * j];
#pragma unroll
    for (int r = 0; r < NR; ++r) { u32x2 w; w.x = pk2(v[r][j].x * s[r] * gg.x, v[r][j].y * s[r] * gg.y); w.y = pk2(v[r][j].z * s[r] * gg.z, v[r][j].w * s[r] * gg.w); ((u32x2*)(o + (size_t)r * 1024))[lane + 64 * j] = w; } }
}
__device__ __forceinline__ void rmsnorm_row_bf16(const float* xr, const float* g, bf16_t* o, int lane) { rmsnorm_rows_bf16<1>(xr, g, o, lane); }

template <class RowMap>
__device__ __forceinline__ void transpose_tile(const float* __restrict__ src, int N, int K, int k0, int n0, bf16_t* dst, RowMap rm, float scale, LAS float* scr) {
  const int tid = threadIdx.x;
  { const int n4 = tid & 15, kk = tid >> 4;
    f32x4 a[4], b[4];
#pragma unroll
    for (int cb = 0; cb < 4; ++cb) { a[cb] = *(const f32x4*)(src + (size_t)(k0 + kk) * N + n0 + cb * 64 + 4 * n4); b[cb] = *(const f32x4*)(src + (size_t)(k0 + kk + 32) * N + n0 + cb * 64 + 4 * n4); }
#pragma unroll
    for (int cb = 0; cb < 4; ++cb) { LAS float* s0 = scr + kk * 261 + cb * 64 + 4 * n4; LAS float* s1 = s0 + 32 * 261;
      s0[0] = a[cb].x; s0[1] = a[cb].y; s0[2] = a[cb].z; s0[3] = a[cb].w; s1[0] = b[cb].x; s1[1] = b[cb].y; s1[2] = b[cb].z; s1[3] = b[cb].w; } }
  __syncthreads();
#pragma unroll
  for (int cb = 0; cb < 4; ++cb) { const int nn = cb * 64 + (tid >> 3), kc = tid & 7; const LAS float* s = scr + (kc * 8) * 261 + nn;
    u32x4 o; o.x = pk2(s[0] * scale, s[261] * scale); o.y = pk2(s[522] * scale, s[783] * scale); o.z = pk2(s[1044] * scale, s[1305] * scale); o.w = pk2(s[1566] * scale, s[1827] * scale);
    *(u32x4*)(dst + (size_t)rm(n0 + nn) * K + k0 + kc * 8) = o; }
  __syncthreads();
}
struct RmId { __device__ __forceinline__ int operator()(int n) const { return n; } };
struct RmWin { __device__ __forceinline__ int operator()(int n) const { const int b = n >> 10; const int mb = b == 0 ? 1 : b == 1 ? 3 : b == 2 ? 0 : b == 3 ? 4 : b == 4 ? 2 : b; return mb * 1024 + (n & 1023); } };
struct RmLru { int mat; __device__ __forceinline__ int operator()(int o) const { const int pnl = o >> 7, cl = o & 127; return pnl * 256 + 128 * (cl >> 6) + 32 * ((cl >> 4) & 3) + 8 * ((cl >> 2) & 3) + 4 * mat + (cl & 3); } };

template <bool MAX>
__device__ __forceinline__ float block_excl_scan(float v, LAS float* tmp) {
  const int lane = threadIdx.x & 63, wid = threadIdx.x >> 6;
  const float ident = MAX ? -3.0e38f : 0.f;
  float inc = v;
#pragma unroll
  for (int o = 1; o < 64; o <<= 1) { const float y = __shfl_up(inc, o); if (lane >= o) inc = MAX ? fmaxf(inc, y) : inc + y; }
  if (lane == 63) tmp[wid] = inc;
  __syncthreads();
  float base = ident;
  for (int w = 0; w < wid; ++w) base = MAX ? fmaxf(base, tmp[w]) : base + tmp[w];
  float ex = __shfl_up(inc, 1); if (lane == 0) ex = ident;
  __syncthreads();
  return MAX ? fmaxf(base, ex) : base + ex;
}

template <bool MLSTM>
__device__ __forceinline__ void conv_rows(const Params& p, const bf16_t* src, bf16_t* dst, const float* cw, const float* cb, float* gates, const float* b_if, LAS float* wxc, LAS float* wxm, int gw, int NW, int lane) {
  for (int t = gw; t < T; t += NW) {
    const int tl = t & (SEQ - 1);
    float g[8];
#pragma unroll
    for (int j = 0; j < 8; ++j) g[j] = 0.f;
#pragma unroll
    for (int i = 0; i < 2; ++i) { const int c0 = i * 512 + lane * 8;
      float o[8], xm[8];
      { const f32x4 a = *(const f32x4*)(cb + c0), b = *(const f32x4*)(cb + c0 + 4);
        o[0] = a.x; o[1] = a.y; o[2] = a.z; o[3] = a.w; o[4] = b.x; o[5] = b.y; o[6] = b.z; o[7] = b.w; }
#pragma unroll
      for (int e = 0; e < 8; ++e) xm[e] = 0.f;
#pragma unroll
      for (int k = 0; k < 4; ++k) {
        if (tl - 3 + k >= 0) {
          const u32x4 v = *(const u32x4*)(src + (size_t)(t - 3 + k) * 1024 + c0);
          const f32x4 wa = *(const f32x4*)(cw + k * 1024 + c0), wb = *(const f32x4*)(cw + k * 1024 + c0 + 4);
          const float xv[8] = {bf_lo(v.x), bf_hi(v.x), bf_lo(v.y), bf_hi(v.y), bf_lo(v.z), bf_hi(v.z), bf_lo(v.w), bf_hi(v.w)};
          const float wv[8] = {wa.x, wa.y, wa.z, wa.w, wb.x, wb.y, wb.z, wb.w};
#pragma unroll
          for (int e = 0; e < 8; ++e) { o[e] += wv[e] * xv[e]; if (k == 3) xm[e] = xv[e]; }
        }
      }
      if (MLSTM) {
#pragma unroll
        for (int e = 0; e < 8; ++e) o[e] = o[e] * sigm(o[e]);
#pragma unroll
        for (int e = 0; e < 8; ++e) { const int c = c0 + e;
          const f32x4 a0 = *(const LAS f32x4*)(wxc + c * 8), a1 = *(const LAS f32x4*)(wxc + c * 8 + 4), m0 = *(const LAS f32x4*)(wxm + c * 8), m1 = *(const LAS f32x4*)(wxm + c * 8 + 4);
          g[0] += o[e] * a0.x + xm[e] * m0.x; g[1] += o[e] * a0.y + xm[e] * m0.y; g[2] += o[e] * a0.z + xm[e] * m0.z; g[3] += o[e] * a0.w + xm[e] * m0.w;
          g[4] += o[e] * a1.x + xm[e] * m1.x; g[5] += o[e] * a1.y + xm[e] * m1.y; g[6] += o[e] * a1.z + xm[e] * m1.z; g[7] += o[e] * a1.w + xm[e] * m1.w; }
      }
      u32x4 ov; ov.x = pk2(o[0], o[1]); ov.y = pk2(o[2], o[3]); ov.z = pk2(o[4], o[5]); ov.w = pk2(o[6], o[7]);
      *(u32x4*)(dst + (size_t)t * 1024 + c0) = ov;
    }
    if (MLSTM) {
#pragma unroll
      for (int j = 0; j < 8; ++j) g[j] = wave_sum(g[j]);
      if (lane == 0) {
        f32x4 o0, o1;
        o0.x = g[0] + b_if[0]; o0.y = g[1] + b_if[1]; o0.z = g[2] + b_if[2]; o0.w = g[3] + b_if[3];
        o1.x = logsigm(g[4] + b_if[4]); o1.y = logsigm(g[5] + b_if[5]); o1.z = logsigm(g[6] + b_if[6]); o1.w = logsigm(g[7] + b_if[7]);
        *(f32x4*)(gates + (size_t)t * 8) = o0; *(f32x4*)(gates + (size_t)t * 8 + 4) = o1;
      }
    }
  }
}

template <bool SILU>
__device__ __forceinline__ void conv_item(const bf16_t* src, bf16_t* dst, const float* cw, const float* cb, int c0, int t0) {
  const bool first = ((t0 & (SEQ - 1)) == 0);
  u32x4 xr[19];
#pragma unroll
  for (int i = 0; i < 19; ++i) { if (i < 3 && first) xr[i] = (u32x4){0u, 0u, 0u, 0u}; else xr[i] = *(const u32x4*)(src + (size_t)(t0 - 3 + i) * 1024 + c0); }
  float w[4][8], bs[8];
#pragma unroll
  for (int k = 0; k < 4; ++k) { const f32x4 a = *(const f32x4*)(cw + k * 1024 + c0), b = *(const f32x4*)(cw + k * 1024 + c0 + 4);
    w[k][0] = a.x; w[k][1] = a.y; w[k][2] = a.z; w[k][3] = a.w; w[k][4] = b.x; w[k][5] = b.y; w[k][6] = b.z; w[k][7] = b.w; }
  { const f32x4 a = *(const f32x4*)(cb + c0), b = *(const f32x4*)(cb + c0 + 4); bs[0] = a.x; bs[1] = a.y; bs[2] = a.z; bs[3] = a.w; bs[4] = b.x; bs[5] = b.y; bs[6] = b.z; bs[7] = b.w; }
#pragma unroll
  for (int t = 0; t < 16; ++t) {
    float o[8];
#pragma unroll
    for (int e = 0; e < 8; ++e) o[e] = bs[e];
#pragma unroll
    for (int k = 0; k < 4; ++k) { const u32x4 v = xr[t + k];
      o[0] += w[k][0] * bf_lo(v.x); o[1] += w[k][1] * bf_hi(v.x); o[2] += w[k][2] * bf_lo(v.y); o[3] += w[k][3] * bf_hi(v.y);
      o[4] += w[k][4] * bf_lo(v.z); o[5] += w[k][5] * bf_hi(v.z); o[6] += w[k][6] * bf_lo(v.w); o[7] += w[k][7] * bf_hi(v.w); }
    if (SILU) {
#pragma unroll
      for (int e = 0; e < 8; ++e) o[e] = o[e] * sigm(o[e]); }
    u32x4 ov; ov.x = pk2(o[0], o[1]); ov.y = pk2(o[2], o[3]); ov.z = pk2(o[4], o[5]); ov.w = pk2(o[6], o[7]);
    *(u32x4*)(dst + (size_t)(t0 + t) * 1024 + c0) = ov;
  }
}
template <bool SILU>
__device__ __forceinline__ void conv_stream(const bf16_t* src, bf16_t* dst, const float* cw, const float* cb, int gtid, int GT) {
  for (int g = gtid; g < 131072; g += GT) conv_item<SILU>(src, dst, cw, cb, (g & 127) * 8, (g >> 7) * 16);
}
__device__ __forceinline__ void gates_tile(const bf16_t* xc, const bf16_t* xm, const bf16_t* wgT, float* part, int tok0, int h, int wid, int lane) {
  const int i16 = lane & 15, kg = lane >> 4;
#pragma unroll 1
  for (int tt = wid; tt < 16; tt += 8) {
    const int t16 = tok0 + tt * 16;
    f32x4 acc = {0.f, 0.f, 0.f, 0.f};
    const bf16_t* ap = xc + (size_t)(t16 + i16) * 1024 + h * 256 + kg * 8;
    const bf16_t* bp = wgT + (size_t)i16 * 2048 + h * 256 + kg * 8;
#pragma unroll
    for (int ks = 0; ks < 8; ++ks) { const bf16x8 a = *(const bf16x8*)(ap + ks * 32), b = *(const bf16x8*)(bp + ks * 32); acc = __builtin_amdgcn_mfma_f32_16x16x32_bf16(a, b, acc, 0, 0, 0); }
    ap = xm + (size_t)(t16 + i16) * 1024 + h * 256 + kg * 8; bp += 1024;
#pragma unroll
    for (int ks = 0; ks < 8; ++ks) { const bf16x8 a = *(const bf16x8*)(ap + ks * 32), b = *(const bf16x8*)(bp + ks * 32); acc = __builtin_amdgcn_mfma_f32_16x16x32_bf16(a, b, acc, 0, 0, 0); }
    if (i16 < 8) *(f32x4*)(part + ((size_t)h * 8 + i16) * T + t16 + 4 * kg) = acc;
  }
}

__device__ __forceinline__ void gates_gemm(const bf16_t* xc, const bf16_t* xm, const bf16_t* wgT, float* part, int gw, int NW, int lane) {
  const int i16 = lane & 15, kg = lane >> 4;
  for (int item = gw; item < 2048; item += NW) {
    const int tile = item >> 1, half = item & 1, tok0 = tile * 16;
    f32x4 acc = {0.f, 0.f, 0.f, 0.f};
    const bf16_t* ap = (half ? xm : xc) + (size_t)(tok0 + i16) * 1024 + kg * 8;
    const bf16_t* bp = wgT + (size_t)i16 * 2048 + half * 1024 + kg * 8;
#pragma unroll 16
    for (int ks = 0; ks < 32; ++ks) { const bf16x8 a = *(const bf16x8*)(ap + ks * 32), b = *(const bf16x8*)(bp + ks * 32); acc = __builtin_amdgcn_mfma_f32_16x16x32_bf16(a, b, acc, 0, 0, 0); }
    if (i16 < 8) *(f32x4*)(part + ((size_t)half * 8 + i16) * T + tok0 + 4 * kg) = acc;
  }
}

#define XB_TMO      128
#define XB_XCNT(j)  (256  + 64 * (j))
#define XB_XSUB(j)  (1280 + 64 * (j))
#define XB_XGEN(j)  (2304 + 64 * (j))
#define XB_TOP      3328
#define XB_TOPGEN   3392
#define XCD_BAR_WORDS 3456
#define XB_SPIN_CAP (1u << 18)
__device__ __forceinline__ unsigned xb_ld(unsigned* p)              { return __hip_atomic_load(p, __ATOMIC_RELAXED, __HIP_MEMORY_SCOPE_AGENT); }
__device__ __forceinline__ unsigned xb_add(unsigned* p, unsigned v) { return __hip_atomic_fetch_add(p, v, __ATOMIC_RELAXED, __HIP_MEMORY_SCOPE_AGENT); }
__device__ __forceinline__ unsigned xb_xcc_id() { return (unsigned)__builtin_amdgcn_s_getreg((3 << 11) | 20) & 0xFu; }
#define XB_SPIN(cond, bar) do { unsigned _sp = 0; while (cond) { __builtin_amdgcn_s_sleep(1); \
    if ((++_sp & 255u) == 0u) { if (xb_ld(&(bar)[XB_TMO])) break; if (_sp > XB_SPIN_CAP) { atomicAdd(&(bar)[XB_TMO], 1u); break; } } } } while (0)
struct XcdBarrier { unsigned* bar; unsigned x; volatile LAS unsigned* st; };
__device__ __forceinline__ XcdBarrier xcd_barrier_post(unsigned* bar, volatile LAS unsigned* st) {
    XcdBarrier b; b.bar = bar; b.x = xb_xcc_id(); b.st = st;
    if (threadIdx.x == 0) (void)xb_add(&bar[XB_XCNT(b.x)], 1u);
    return b;
}
__device__ __forceinline__ void xcd_barrier_complete(unsigned* bar, unsigned x, unsigned& nloc, unsigned& nx) {
    const unsigned G = gridDim.x * gridDim.y * gridDim.z;
    unsigned sum, cnt, mine, sp = 0u;
    for (;;) {
        sum = 0u; cnt = 0u; mine = 0u;
#pragma unroll
        for (unsigned j = 0; j < 16; ++j) { const unsigned c = xb_ld(&bar[XB_XCNT(j)]); sum += c; cnt += (c > 0u) ? 1u : 0u; mine = (j == x) ? c : mine; }
        if (sum == G) break;
        __builtin_amdgcn_s_sleep(1);
        if ((++sp & 255u) == 0u) { if (xb_ld(&bar[XB_TMO])) break; if (sp > XB_SPIN_CAP) { atomicAdd(&bar[XB_TMO], 1u); break; } }
    }
    nloc = mine > 0u ? mine : 1u; nx = cnt > 0u ? cnt : 1u;
}
__device__ __forceinline__ void xcd_barrier(const XcdBarrier& b) {
    asm volatile("s_waitcnt vmcnt(0)" ::: "memory");
    __syncthreads();
    if (threadIdx.x == 0) {
        unsigned* bar = b.bar;
        __builtin_amdgcn_s_waitcnt(0);
        unsigned nloc = b.st[0], nx = b.st[1];
        if (nloc == 0u) { xcd_barrier_complete(bar, b.x, nloc, nx); b.st[0] = nloc; b.st[1] = nx; }
        const unsigned old = xb_add(&bar[XB_XSUB(b.x)], 1u);
        const unsigned gen = old / nloc;
        if (old + 1u == (gen + 1u) * nloc) {
            __builtin_amdgcn_fence(__ATOMIC_RELEASE, "agent");
            asm volatile("s_waitcnt vmcnt(0)" ::: "memory");
            const unsigned og = xb_add(&bar[XB_TOP], 1u);
            const unsigned tg = og / nx;
            if (og + 1u == (tg + 1u) * nx) xb_add(&bar[XB_TOPGEN], 1u);
            else XB_SPIN(xb_ld(&bar[XB_TOPGEN]) == tg, bar);
            __builtin_amdgcn_fence(__ATOMIC_ACQUIRE, "agent");
            xb_add(&bar[XB_XGEN(b.x)], 1u);
            asm volatile("s_waitcnt vmcnt(0)" ::: "memory");
        } else {
            XB_SPIN(xb_ld(&bar[XB_XGEN(b.x)]) == gen, bar);
            __builtin_amdgcn_fence(__ATOMIC_ACQUIRE, "agent");
            asm volatile("s_waitcnt vmcnt(0)" ::: "memory");
        }
    }
    __syncthreads();
}

#define W0 ((char*)p.ws + O_SLOTS)
#define W1 ((char*)p.ws + O_SLOTS + SLOT)
#define W2 ((char*)p.ws + O_SLOTS + 2 * SLOT)
#define W3 ((char*)p.ws + O_SLOTS + 3 * SLOT)
#define W4 ((char*)p.ws + O_SLOTS + 4 * SLOT)
#define W5 ((char*)p.ws + O_SLOTS + 5 * SLOT)
#define D0 ((char*)p.out)
#define D1 ((char*)p.out + SLOT)
#define WinT ((const char*)p.ws + O_WINT)
#define WbT ((const char*)p.ws + O_WBT)
#define WoutT ((const char*)p.ws + O_WOUTT)
#define WkvT ((const char*)p.ws + O_WKVT)
#define WqT ((const char*)p.ws + O_WQT)
#define WkT ((const char*)p.ws + O_WKT)
#define WvT ((const char*)p.ws + O_WVT)
#define WoT ((const char*)p.ws + O_WOT)
#define WlruT ((const char*)p.ws + O_WLRUT)
#define binR ((float*)(p.ws + O_BINR))
#define Wxc ((float*)(p.ws + O_WXC))
#define Wxm ((float*)(p.ws + O_WXM))
#define gates ((float*)(p.ws + O_GATES))
#define Bc ((float*)(p.ws + O_BC))
#define Av ((float*)(p.ws + O_AV))
#define Mt ((float*)(p.ws + O_MT))
#define denp ((float*)(p.ws + O_DENP))
#define nkloc ((float*)(p.ws + O_NKLOC))
#define nprev ((float*)(p.ws + O_NPREV))
#define Kmem ((char*)p.ws + O_KMEM)
#define VmemT ((char*)p.ws + O_VMEMT)
#define memN ((char*)p.ws + O_MEMN)
#define hend ((float*)(p.ws + O_HEND))
#define slog ((float*)(p.ws + O_SLOG))
#define carry ((float*)(p.ws + O_CARRY))
__device__ __forceinline__ void transpose_item(const Params& p, int it, LAS float* ldsf) {
  int r = it;
  if (r < 576) { transpose_tile(p.in[3], 9216, 1024, (r / 36) * 64, (r % 36) * 256, (bf16_t*)WinT, RmWin(), 1.0f, ldsf); return; } r -= 576;
  if (r < 192) { const int n_ = r >> 6, q = r & 63; transpose_tile(p.in[25] + (size_t)n_ * 1048576, 1024, 1024, (q >> 2) * 64, (q & 3) * 256, (bf16_t*)WbT + (size_t)n_ * 1048576, RmId(), 1.0f, ldsf); return; } r -= 192;
  if (r < 64) { transpose_tile(p.in[26], 1024, 1024, (r >> 2) * 64, (r & 3) * 256, (bf16_t*)WoutT, RmId(), 1.0f, ldsf); return; } r -= 64;
  if (r < 128) { transpose_tile(p.in[24], 2048, 1024, (r >> 3) * 64, (r & 7) * 256, (bf16_t*)WkvT, RmId(), 1.0f, ldsf); return; } r -= 128;
  if (r < 64) { const int mat = r >> 4, q = r & 15, h = q >> 2, kb = q & 3;
    const float* srcp = (mat == 0 ? p.in[14] : mat == 1 ? p.in[15] : mat == 2 ? p.in[16] : p.in[17]) + (size_t)h * 65536;
    bf16_t* dstp = (bf16_t*)WqT + (size_t)mat * 262144 + (size_t)h * 65536;
    transpose_tile(srcp, 256, 256, kb * 64, 0, dstp, RmId(), mat == 1 ? 0.0625f : 1.0f, ldsf); return; } r -= 64;
  { const int mat = r >> 4, q = r & 15, g = q >> 2, kb = q & 3; RmLru rm; rm.mat = mat;
    transpose_tile((mat == 0 ? p.in[7] : p.in[9]) + (size_t)g * 65536, 256, 256, kb * 64, 0, (bf16_t*)WlruT + (size_t)g * 131072, rm, 1.0f, ldsf); }
}

constexpr unsigned ALLPH = (1u << 18) - 1u;
template <unsigned MASK>
__global__ void __launch_bounds__(512) mk_fwd(Params p) {
  extern __shared__ __attribute__((aligned(16))) unsigned char smem[];
  LAS unsigned char* lds = (LAS unsigned char*)smem;
  LAS float* ldsf = (LAS float*)lds;
  LAS float* xP = (LAS float*)(lds + STAGE_BYTES);
  LAS float* xD = (LAS float*)(lds + STAGE_BYTES + 4096);
  LAS float* xW = (LAS float*)(lds + STAGE_BYTES + 5120);
  LAS float* xT = (LAS float*)(lds + STAGE_BYTES + 7168);
  cg::grid_group grid = cg::this_grid();
  volatile LAS unsigned* xst = (volatile LAS unsigned*)(lds + STAGE_BYTES + 8192);
  if (threadIdx.x == 0) { xst[0] = 0u; xst[1] = 0u; }
  __syncthreads();
  XcdBarrier xb; if constexpr (MASK == ALLPH) xb = xcd_barrier_post((unsigned*)(p.ws + O_BAR), xst);
  const int G = gridDim.x, wg = blockIdx.x, NW = G * 8, GT = G * 512;
  const float* x = p.in[0];

  if constexpr ((MASK >> 0) & 1) {
  int tid = threadIdx.x; asm volatile("" : "+v"(tid)); const int lane = tid & 63, wid = tid >> 6, gw = wg * 8 + wid, gtid = wg * 512 + tid; (void)lane; (void)gw; (void)gtid;
  {
    for (int e = wg; e < 256; e += G) {
      const int it = e < 64 ? (e >> 2) * 36 + 8 + (e & 3) : e < 192 ? 832 + (e - 64) : 960 + (e - 192);
      transpose_item(p, it, ldsf);
    }
    for (int row = gw * 4; row < T; row += NW * 4) rmsnorm_rows_bf16<4>(x + (size_t)row * 1024, p.in[2], (bf16_t*)W0 + (size_t)row * 1024, lane);
    for (int row = gw; row < 512; row += NW) rmsnorm_row_bf16(p.in[1] + (size_t)row * 1024, p.in[23], (bf16_t*)memN + (size_t)row * 1024, lane);
    for (int w = gw; w < 2048; w += NW) {
      const int which = w >> 10, i = w & 1023, h = i >> 8, ii = i & 255;
      float a[8];
#pragma unroll
      for (int j = 0; j < 8; ++j) a[j] = 0.f;
      const float* wif = p.in[19];
#pragma unroll
      for (int jj = 0; jj < 4; ++jj) { const int o = lane + 64 * jj;
        if (which == 0) {
          const float wq = p.in[14][(size_t)h * 65536 + ii * 256 + o], wk = p.in[15][(size_t)h * 65536 + ii * 256 + o];
          const f32x4 q0 = *(const f32x4*)(wif + (size_t)(h * 256 + o) * 8), q1 = *(const f32x4*)(wif + (size_t)(h * 256 + o) * 8 + 4);
          const f32x4 k0 = *(const f32x4*)(wif + (size_t)(1024 + h * 256 + o) * 8), k1 = *(const f32x4*)(wif + (size_t)(1024 + h * 256 + o) * 8 + 4);
          a[0] += wq * q0.x + wk * k0.x; a[1] += wq * q0.y + wk * k0.y; a[2] += wq * q0.z + wk * k0.z; a[3] += wq * q0.w + wk * k0.w;
          a[4] += wq * q1.x + wk * k1.x; a[5] += wq * q1.y + wk * k1.y; a[6] += wq * q1.z + wk * k1.z; a[7] += wq * q1.w + wk * k1.w;
        } else {
          const float wv = p.in[16][(size_t)h * 65536 + ii * 256 + o];
          const f32x4 v0 = *(const f32x4*)(wif + (size_t)(2048 + h * 256 + o) * 8), v1 = *(const f32x4*)(wif + (size_t)(2048 + h * 256 + o) * 8 + 4);
          a[0] += wv * v0.x; a[1] += wv * v0.y; a[2] += wv * v0.z; a[3] += wv * v0.w; a[4] += wv * v1.x; a[5] += wv * v1.y; a[6] += wv * v1.z; a[7] += wv * v1.w;
        } }
#pragma unroll
      for (int j = 0; j < 8; ++j) a[j] = wave_sum(a[j]);
      if (lane == 0) { bf16_t* d = (bf16_t*)(p.ws + O_WGT) + which * 1024 + i;
#pragma unroll
        for (int j = 0; j < 8; ++j) { d[(size_t)j * 2048] = (bf16_t)(pk2(a[j], 0.f) & 0xffffu); d[(size_t)(8 + j) * 2048] = 0; } }
    }
    for (int n = gtid; n < 9216; n += GT) binR[RmWin()((int)n)] = p.in[4][n];
  }
  }
  if constexpr (MASK == ALLPH) xcd_barrier(xb);

  if constexpr ((MASK >> 1) & 1) {
  int tid = threadIdx.x; asm volatile("" : "+v"(tid)); const int lane = tid & 63, wid = tid >> 6, gw = wg * 8 + wid, gtid = wg * 512 + tid; (void)lane; (void)gw; (void)gtid;
  {
    SchedTiles S; S.A = W0; S.Bt = WinT; S.out0 = W1; S.out1 = W1; S.bias = binR; S.nN = 4; S.G = G; S.c = wg;
    EpiBf16 E; E.m_Av = Av; E.m_Mt = Mt;
    gemm_phase<SchedTiles, EpiBf16, false>(lds, 1024, 1024, 16, 16, S, E);
  }
  }
  if constexpr (MASK == ALLPH) xcd_barrier(xb);

  if constexpr ((MASK >> 2) & 1) {
  int tid = threadIdx.x; asm volatile("" : "+v"(tid)); const int lane = tid & 63, wid = tid >> 6, gw = wg * 8 + wid, gtid = wg * 512 + tid; (void)lane; (void)gw; (void)gtid;
  {
    const int pm = wg >> 2, h = wg & 3, tok0 = pm * 256;
    conv_item<true>((const bf16_t*)W1, (bf16_t*)W2, p.in[12], p.in[13], h * 256 + (tid & 31) * 8, tok0 + (tid >> 5) * 16);
    asm volatile("s_waitcnt vmcnt(0)" ::: "memory"); __syncthreads();
    EpiBf16 E; E.m_Av = Av; E.m_Mt = Mt;
    SchedP3X SX; SX.xc = W2; SX.mx = W1; SX.wq = WqT; SX.wk = WkT; SX.wo = WoT; SX.q = W3; SX.k = W4; SX.og = W5; SX.b_o = p.in[18]; SX.G = G; SX.c = wg;
    gemm_phase<SchedP3X, EpiBf16, false>(lds, 1024, 256, 4, 4, SX, E);
    gates_tile((const bf16_t*)W2, (const bf16_t*)W1, (const bf16_t*)(p.ws + O_WGT), gates, tok0, h, wid, lane);
  }
  }
  if constexpr (MASK == ALLPH) xcd_barrier(xb);

  if constexpr ((MASK >> 3) & 1) {
  int tid = threadIdx.x; asm volatile("" : "+v"(tid)); const int lane = tid & 63, wid = tid >> 6, gw = wg * 8 + wid, gtid = wg * 512 + tid; (void)lane; (void)gw; (void)gtid;
  }


  if constexpr ((MASK >> 4) & 1) {
  int tid = threadIdx.x; asm volatile("" : "+v"(tid)); const int lane = tid & 63, wid = tid >> 6, gw = wg * 8 + wid, gtid = wg * 512 + tid; (void)lane; (void)gw; (void)gtid;
  if (wg < 8) {
    const int b = wg >> 2, h = wg & 3;
    const size_t t0 = (size_t)b * SEQ + (size_t)tid * 16;
    float c[16], ig[16];
    float run = 0.f;
    { const float bi = p.in[20][h], bf = p.in[20][4 + h];
      const float* gi = gates + (size_t)h * T + t0; const float* gf = gates + (size_t)(4 + h) * T + t0;
#pragma unroll
      for (int k4 = 0; k4 < 4; ++k4) {
        f32x4 a = *(const f32x4*)(gi + 4 * k4), f = *(const f32x4*)(gf + 4 * k4);
#pragma unroll
        for (int hh = 1; hh < 4; ++hh) { a = a + *(const f32x4*)(gi + (size_t)hh * 8 * T + 4 * k4); f = f + *(const f32x4*)(gf + (size_t)hh * 8 * T + 4 * k4); }
#pragma unroll
        for (int e = 0; e < 4; ++e) { ig[4 * k4 + e] = a[e] + bi; run += logsigm(f[e] + bf); c[4 * k4 + e] = run; } } }
    const float off = block_excl_scan<false>(run, xT);
    float pmx = -3.0e38f;
#pragma unroll
    for (int k = 0; k < 16; ++k) { c[k] += off; ig[k] = ig[k] - c[k]; pmx = fmaxf(pmx, ig[k]); }
    const float offm = block_excl_scan<true>(pmx, xT);
    float rm = offm;
#pragma unroll
    for (int k = 0; k < 16; ++k) { rm = fmaxf(rm, ig[k]); const float mtv = fmaxf(rm, 0.f); Bc[(t0 + k) * 4 + h] = c[k] + mtv;   Av[(t0 + k) * 4 + h] = ig[k]; Mt[(t0 + k) * 4 + h] = mtv; }
  } else if (wg < 24) {
    const int idx = wg - 8; SchedOne S; S.has = true;
    if (idx < 8) { const int pm = idx >> 2, pn = idx & 3;
      S.u.A0 = S.u.A1 = memN + (size_t)pm * 256 * 1024 * 2; S.u.B0 = S.u.B1 = WkvT + (size_t)pn * 256 * 1024 * 2; S.u.out = Kmem + ((size_t)pm * 256 * 1024 + pn * 256) * 2; S.u.ldc = 1024; }
    else { const int pm = (idx - 8) >> 1, b = (idx - 8) & 1;
      S.u.A0 = S.u.A1 = WkvT + (size_t)(1024 + pm * 256) * 1024 * 2; S.u.B0 = S.u.B1 = memN + (size_t)b * 256 * 1024 * 2; S.u.out = VmemT + (size_t)(b * 1024 + pm * 256) * 256 * 2; S.u.ldc = 256; }
    S.u.bias = nullptr; S.u.sub = 0; S.u.row0 = 0; S.u.col0 = 0; S.u.aux0 = 0; S.u.aux1 = 0;
    EpiBf16 E; E.m_Av = Av; E.m_Mt = Mt;
    gemm_phase<SchedOne, EpiBf16, false>(lds, 1024, 1024, 16, 16, S, E);
  } else {
    for (int l = wg - 24; l < 800; l += G - 24) {
      int it;
      if (l < 512) { const int j = l & 31; it = (l >> 5) * 36 + (j < 8 ? j : j + 4); }
      else if (l < 704) it = 576 + (l - 512); else if (l < 768) it = 768 + (l - 704); else it = 1024 + (l - 768);
      transpose_item(p, it, ldsf);
    }
    EpiBf16 E; E.m_Av = Av; E.m_Mt = Mt;
    SchedP3Y SY; SY.xc = W2; SY.mx = W1; SY.wk = WkT; SY.wv = WvT; SY.vt = D0; SY.ktw = D1; SY.G = G - 24; SY.c = wg - 24; SY.base = 0; SY.count = 256;
    gemm_phase<SchedP3Y, EpiBf16, false>(lds, 256, 1024, 4, 4, SY, E);
  }
  }
  if constexpr (MASK == ALLPH) xcd_barrier(xb);

  if constexpr ((MASK >> 5) & 1) {
  int tid = threadIdx.x; asm volatile("" : "+v"(tid)); const int lane = tid & 63, wid = tid >> 6, gw = wg * 8 + wid, gtid = wg * 512 + tid; (void)lane; (void)gw; (void)gtid;
  { EpiBf16 E; E.m_Av = Av; E.m_Mt = Mt;
    SchedP3Y SY; SY.xc = W2; SY.mx = W1; SY.wk = WkT; SY.wv = WvT; SY.vt = D0; SY.ktw = D1; SY.G = G; SY.c = wg; SY.base = 256; SY.count = 256;
    gemm_phase<SchedP3Y, EpiBf16, false>(lds, 256, 1024, 4, 4, SY, E);
    asm volatile("s_waitcnt vmcnt(0)" ::: "memory"); __syncthreads(); }
  if (wg < 256) { const int unit = wg;
    const int bh = unit >> 5, ci = unit & 31, b = bh >> 2, h = bh & 3, tok0 = b * SEQ + ci * 256;
    { SchedOne S; S.has = true; S.u.A0 = S.u.A1 = D0 + (size_t)unit * 131072; S.u.B0 = S.u.B1 = D1 + (size_t)unit * 131072; S.u.out = W1 + (size_t)unit * 131072; S.u.bias = nullptr; S.u.ldc = 256; S.u.sub = 0;
      S.u.row0 = tok0; S.u.col0 = 0; S.u.aux0 = h; S.u.aux1 = unit;
      EpiBf16 E; E.m_Av = Av; E.m_Mt = Mt;
      gemm_phase<SchedOne, EpiBf16, false>(lds, 256, 256, 4, 4, S, E); }
    { SchedOne S; S.has = true; const size_t to = ((size_t)tok0 * 1024 + h * 256) * 2;
      S.u.A0 = S.u.A1 = W3 + to; S.u.B0 = S.u.B1 = W4 + to; S.u.out = W0 + to; S.u.bias = nullptr; S.u.ldc = 1024; S.u.sub = 0; S.u.row0 = tok0; S.u.col0 = 0; S.u.aux0 = h; S.u.aux1 = unit;
      EpiU1 E; E.m_Av = Av; E.m_Mt = Mt; E.m_denp = denp;
      gemm_phase<SchedOne, EpiU1, false>(lds, 1024, 1024, 4, 4, S, E); }
    { const float mprev = ci == 0 ? 0.f : Mt[(size_t)(tok0 - 1) * 4 + h];
      const int r = tid >> 1, hf = tid & 1;
      const float sc = __expf(mprev - Mt[(size_t)(tok0 + r) * 4 + h]);
      u32x4* qp = (u32x4*)((bf16_t*)W3 + (size_t)(tok0 + r) * 1024 + h * 256 + hf * 128);
      u32x4 v[16];
#pragma unroll
      for (int i = 0; i < 16; ++i) v[i] = qp[i];
#pragma unroll
      for (int i = 0; i < 16; ++i) { u32x4 o;
        o.x = pk2(bf_lo(v[i].x) * sc, bf_hi(v[i].x) * sc); o.y = pk2(bf_lo(v[i].y) * sc, bf_hi(v[i].y) * sc); o.z = pk2(bf_lo(v[i].z) * sc, bf_hi(v[i].z) * sc); o.w = pk2(bf_lo(v[i].w) * sc, bf_hi(v[i].w) * sc); qp[i] = o; } }
    { const float me = Mt[(size_t)(tok0 + 255) * 4 + h];
      if (tid < 256) xW[tid] = __expf(Av[(size_t)(tok0 + tid) * 4 + h] - me);
      __syncthreads();
      const int cg8 = tid & 31, sg = tid >> 5;
      const bf16_t* kp = (const bf16_t*)W4 + (size_t)(tok0 + sg * 16) * 1024 + h * 256 + cg8 * 8;
      u32x4 v[16];
#pragma unroll
      for (int i = 0; i < 16; ++i) v[i] = *(const u32x4*)(kp + (size_t)i * 1024);
      float a[8];
#pragma unroll
      for (int j = 0; j < 8; ++j) a[j] = 0.f;
#pragma unroll
      for (int i = 0; i < 16; ++i) { const float w = xW[sg * 16 + i];
        a[0] += w * bf_lo(v[i].x); a[1] += w * bf_hi(v[i].x); a[2] += w * bf_lo(v[i].y); a[3] += w * bf_hi(v[i].y); a[4] += w * bf_lo(v[i].z); a[5] += w * bf_hi(v[i].z); a[6] += w * bf_lo(v[i].w); a[7] += w * bf_hi(v[i].w); }
#pragma unroll
      for (int j = 0; j < 8; ++j) ldsf[sg * 256 + cg8 * 8 + j] = a[j];
      __syncthreads();
      if (tid < 256) { float s = 0.f;
#pragma unroll
        for (int g2 = 0; g2 < 16; ++g2) s += ldsf[g2 * 256 + tid];
        nkloc[(size_t)unit * 256 + tid] = s; }
      __syncthreads(); }
  }
  }
  if constexpr (MASK == ALLPH) xcd_barrier(xb);

  if constexpr ((MASK >> 6) & 1) {
  int tid = threadIdx.x; asm volatile("" : "+v"(tid)); const int lane = tid & 63, wid = tid >> 6, gw = wg * 8 + wid, gtid = wg * 512 + tid; (void)lane; (void)gw; (void)gtid;
  {
    for (int g = gtid; g < 131072; g += GT) {
      const int bh = (int)(g >> 14), e4 = (int)(g & 16383), b = bh >> 2, h = bh & 3;
      u32x2* base = (u32x2*)((bf16_t*)W1 + (size_t)bh * 32 * 65536 + (size_t)e4 * 4);
      u32x2 kv[32]; float me[32];
#pragma unroll
      for (int c = 0; c < 32; ++c) { kv[c] = base[(size_t)c * 16384]; me[c] = Mt[(size_t)(b * SEQ + c * 256 + 255) * 4 + h]; }
      float C0 = 0.f, C1 = 0.f, C2 = 0.f, C3 = 0.f; float mprev = 0.f;
#pragma unroll
      for (int c = 0; c < 32; ++c) {
        const float dec = __expf(mprev - me[c]); mprev = me[c];
        u32x2 w; w.x = pk2(C0, C1); w.y = pk2(C2, C3); base[(size_t)c * 16384] = w;
        C0 = dec * C0 + bf_lo(kv[c].x); C1 = dec * C1 + bf_hi(kv[c].x); C2 = dec * C2 + bf_lo(kv[c].y); C3 = dec * C3 + bf_hi(kv[c].y);
      }
    }
    for (int g = gtid; g < 2048; g += GT) {
      const int bh = (int)(g >> 8), col = (int)(g & 255), b = bh >> 2, h = bh & 3;
      float nk[32], me[32];
#pragma unroll
      for (int c = 0; c < 32; ++c) { nk[c] = nkloc[(size_t)(bh * 32 + c) * 256 + col]; me[c] = Mt[(size_t)(b * SEQ + c * 256 + 255) * 4 + h]; }
      float n = 0.f, mprev = 0.f;
#pragma unroll
      for (int c = 0; c < 32; ++c) { const float dec = __expf(mprev - me[c]); mprev = me[c]; nprev[(size_t)(bh * 32 + c) * 256 + col] = n; n = dec * n + nk[c]; }
    }
    for (int row = gw * 4; row < T; row += NW * 4) rmsnorm_rows_bf16<4>(x + (size_t)row * 1024, p.in[2], (bf16_t*)W4 + (size_t)row * 1024, lane);
  }
  }
  if constexpr (MASK == ALLPH) xcd_barrier(xb);

  if constexpr ((MASK >> 7) & 1) {
  int tid = threadIdx.x; asm volatile("" : "+v"(tid)); const int lane = tid & 63, wid = tid >> 6, gw = wg * 8 + wid, gtid = wg * 512 + tid; (void)lane; (void)gw; (void)gtid;
  if (wg < 256) { const int unit = wg;
    const int bh = unit >> 5, ci = unit & 31, b = bh >> 2, h = bh & 3, tok0 = b * SEQ + ci * 256;
    { if (tid < 256) xW[tid] = nprev[(size_t)unit * 256 + tid];
      __syncthreads();
      const int r = tid >> 1, hf = tid & 1;
      const u32x4* qp = (const u32x4*)((const bf16_t*)W3 + (size_t)(tok0 + r) * 1024 + h * 256 + hf * 128);
      u32x4 v[16];
#pragma unroll
      for (int i = 0; i < 16; ++i) v[i] = qp[i];
      float s = 0.f;
#pragma unroll
      for (int i = 0; i < 16; ++i) { const LAS float* nv = xW + hf * 128 + i * 8;
        const f32x4 n0 = *(const LAS f32x4*)nv, n1 = *(const LAS f32x4*)(nv + 4);
        s += bf_lo(v[i].x) * n0.x + bf_hi(v[i].x) * n0.y + bf_lo(v[i].y) * n0.z + bf_hi(v[i].y) * n0.w + bf_lo(v[i].z) * n1.x + bf_hi(v[i].z) * n1.y + bf_lo(v[i].w) * n1.z + bf_hi(v[i].w) * n1.w; }
      s += __shfl_xor(s, 1);
      if (hf == 0) xD[r] = s;
      __syncthreads(); }
    SchedOne S; S.has = true; const size_t to = ((size_t)tok0 * 1024 + h * 256) * 2;
    S.u.A0 = W0 + to; S.u.A1 = W3 + to; S.u.B0 = D0 + (size_t)unit * 131072; S.u.B1 = W1 + (size_t)unit * 131072;
    S.u.out = nullptr; S.u.bias = nullptr; S.u.ldc = 1024; S.u.sub = 0; S.u.row0 = tok0; S.u.col0 = 0; S.u.aux0 = h; S.u.aux1 = unit;
    EpiU2 E; E.P = xP; E.deni = xD; E.m_denp = denp; E.m_Bc = Bc; E.m_Mt = Mt; E.og = (const bf16_t*)W5; E.norm_g = p.in[21]; E.skip = p.in[22]; E.xc = (bf16_t*)W2;
    gemm_phase<SchedOne, EpiU2, true>(lds, 1024, 256, 8, 4, S, E);
    __syncthreads();
  }
  }
  if constexpr (MASK == ALLPH) xcd_barrier(xb);

  if constexpr ((MASK >> 8) & 1) {
  int tid = threadIdx.x; asm volatile("" : "+v"(tid)); const int lane = tid & 63, wid = tid >> 6, gw = wg * 8 + wid, gtid = wg * 512 + tid; (void)lane; (void)gw; (void)gtid;
  {
    SchedTiles S; S.A = W4; S.Bt = WinT + (size_t)1024 * 1024 * 2; S.out0 = W0; S.out1 = W1; S.bias = binR + 1024; S.nN = 8; S.G = G; S.c = wg;
    EpiBf16 E; E.m_Av = Av; E.m_Mt = Mt;
    gemm_phase<SchedTiles, EpiBf16, false>(lds, 1024, 1024, 16, 16, S, E);
  }
  }
  if constexpr (MASK == ALLPH) xcd_barrier(xb);

  if constexpr ((MASK >> 9) & 1) {
  int tid = threadIdx.x; asm volatile("" : "+v"(tid)); const int lane = tid & 63, wid = tid >> 6, gw = wg * 8 + wid, gtid = wg * 512 + tid; (void)lane; (void)gw; (void)gtid;
  {
    conv_stream<false>((const bf16_t*)W0, (bf16_t*)W3, p.in[5], p.in[6], gtid, GT);
    if (wg < 256) { const int L = wg;
      const int pm = L >> 2, h = L & 3, b = pm >> 5;
      { SchedOne S; S.has = true;
        S.u.A0 = S.u.A1 = W1 + ((size_t)pm * 256 * 1024 + h * 256) * 2; S.u.B0 = S.u.B1 = Kmem + ((size_t)b * 256 * 1024 + h * 256) * 2; S.u.out = W5 + (size_t)L * 131072; S.u.bias = nullptr; S.u.ldc = 256; S.u.sub = 0;
        S.u.row0 = 0; S.u.col0 = 0; S.u.aux0 = 0; S.u.aux1 = 0;
        EpiSoftmax E; E.P = xP;
        gemm_phase<SchedOne, EpiSoftmax, true>(lds, 1024, 1024, 4, 4, S, E); }
      asm volatile("s_waitcnt vmcnt(0)" ::: "memory"); __syncthreads();
      { SchedOne S; S.has = true;
        S.u.A0 = S.u.A1 = W5 + (size_t)L * 131072; S.u.B0 = S.u.B1 = VmemT + (size_t)(b * 1024 + h * 256) * 256 * 2; S.u.out = D0 + ((size_t)pm * 256 * 1024 + h * 256) * 2; S.u.bias = nullptr; S.u.ldc = 1024; S.u.sub = 0;
        S.u.row0 = 0; S.u.col0 = 0; S.u.aux0 = 0; S.u.aux1 = 0;
        EpiBf16 E; E.m_Av = Av; E.m_Mt = Mt;
        gemm_phase<SchedOne, EpiBf16, false>(lds, 256, 256, 4, 4, S, E); }
      __syncthreads();
    }
  }
  }
  if constexpr (MASK == ALLPH) xcd_barrier(xb);

  if constexpr ((MASK >> 10) & 1) {
  int tid = threadIdx.x; asm volatile("" : "+v"(tid)); const int lane = tid & 63, wid = tid >> 6, gw = wg * 8 + wid, gtid = wg * 512 + tid; (void)lane; (void)gw; (void)gtid;
  {
    SchedLru S; S.u_ = W3; S.wl = WlruT; S.G = G; S.c = wg;
    EpiLru E; E.b_a = p.in[8]; E.b_x = p.in[10]; E.lam = p.in[11]; E.u = (const bf16_t*)W3; E.loga = (bf16_t*)W0; E.bb = (bf16_t*)W1;
    gemm_phase<SchedLru, EpiLru, false>(lds, 1024, 256, 4, 4, S, E);
    asm volatile("s_waitcnt vmcnt(0)" ::: "memory"); __syncthreads();
#pragma unroll 1
    for (int i = 0; i < 2; ++i) { const int L = i * G + wg; if (L < 512) {
      const int pm = (L & 7) * 8 + (L >> 6), pn = (L >> 3) & 7;
      const int ch = (pn >> 1) * 256 + (pn & 1) * 128 + (tid & 127), j = pm * 4 + (tid >> 7);
      const bf16_t* la = (const bf16_t*)W0 + (size_t)j * 64 * 1024 + ch; const bf16_t* bp = (const bf16_t*)W1 + (size_t)j * 64 * 1024 + ch;
      float h = 0.f, s = 0.f;
#pragma unroll 16
      for (int t = 0; t < 64; ++t) { const float l = bf2f(la[(size_t)t * 1024]); h = __expf(l) * h + bf2f(bp[(size_t)t * 1024]); s += l; }
      hend[(size_t)j * 1024 + ch] = h; slog[(size_t)j * 1024 + ch] = s; } }
  }
  }
  if constexpr (MASK == ALLPH) xcd_barrier(xb);

  if constexpr ((MASK >> 11) & 1) {
  int tid = threadIdx.x; asm volatile("" : "+v"(tid)); const int lane = tid & 63, wid = tid >> 6, gw = wg * 8 + wid, gtid = wg * 512 + tid; (void)lane; (void)gw; (void)gtid;
  }

  if constexpr ((MASK >> 12) & 1) {
  int tid = threadIdx.x; asm volatile("" : "+v"(tid)); const int lane = tid & 63, wid = tid >> 6, gw = wg * 8 + wid, gtid = wg * 512 + tid; (void)lane; (void)gw; (void)gtid;
  }

  if constexpr ((MASK >> 13) & 1) {
  int tid = threadIdx.x; asm volatile("" : "+v"(tid)); const int lane = tid & 63, wid = tid >> 6, gw = wg * 8 + wid, gtid = wg * 512 + tid; (void)lane; (void)gw; (void)gtid;
  for (int g = gtid; g < 131072; g += GT) {
    const int cp = (int)(g & 511), j = (int)(g >> 9);
    const unsigned* la = (const unsigned*)((const bf16_t*)W0 + (size_t)j * 64 * 1024 + cp * 2);
    const unsigned* bp = (const unsigned*)((const bf16_t*)W1 + (size_t)j * 64 * 1024 + cp * 2);
    unsigned* yo = (unsigned*)((bf16_t*)W3 + (size_t)j * 64 * 1024 + cp * 2);
    float h0 = 0.f, h1 = 0.f;
    { const int jb = (j >> 7) * 128, jl = j & 127;
#pragma unroll 8
      for (int jj = 0; jj < jl; ++jj) { const size_t o = (size_t)(jb + jj) * 1024 + cp * 2;
        const float sx = slog[o], sy = slog[o + 1], ex = hend[o], ey = hend[o + 1];
        h0 = __expf(sx) * h0 + ex; h1 = __expf(sy) * h1 + ey; } }
#pragma unroll 1
    for (int tb = 0; tb < 64; tb += 16) {
      unsigned av[16], bw[16];
#pragma unroll
      for (int t = 0; t < 16; ++t) { av[t] = la[(size_t)(tb + t) * 512]; bw[t] = bp[(size_t)(tb + t) * 512]; }
#pragma unroll
      for (int t = 0; t < 16; ++t) { h0 = __expf(bf_lo(av[t])) * h0 + bf_lo(bw[t]); h1 = __expf(bf_hi(av[t])) * h1 + bf_hi(bw[t]); yo[(size_t)(tb + t) * 512] = pk2(h0, h1); }
    }
  }
  }
  if constexpr (MASK == ALLPH) xcd_barrier(xb);

  if constexpr ((MASK >> 14) & 1) {
  int tid = threadIdx.x; asm volatile("" : "+v"(tid)); const int lane = tid & 63, wid = tid >> 6, gw = wg * 8 + wid, gtid = wg * 512 + tid; (void)lane; (void)gw; (void)gtid;
  {
    SchedZ S; S.hn = W4; S.wint = WinT; S.y0 = W3; S.y1 = W2; S.y2 = D0; S.binr = binR; S.G = G; S.c = wg;
    EpiZ E;
    gemm_phase<SchedZ, EpiZ, false>(lds, 1024, 1024, 16, 16, S, E);
  }
  }
  if constexpr (MASK == ALLPH) xcd_barrier(xb);

  if constexpr ((MASK >> 15) & 1) {
  int tid = threadIdx.x; asm volatile("" : "+v"(tid)); const int lane = tid & 63, wid = tid >> 6, gw = wg * 8 + wid, gtid = wg * 512 + tid; (void)lane; (void)gw; (void)gtid;
  {
    SchedMerge S; S.hn = W4; S.wint = WinT; S.wbt = WbT; S.y0 = W3; S.y1 = W2; S.y2 = D0; S.binr = binR; S.G = G; S.c = wg;
    EpiMerge E; E.gsc = (bf16_t*)D1; E.macc = (float*)W0; E.merged = (bf16_t*)W5;
    gemm_phase<SchedMerge, EpiMerge, false>(lds, 1024, 1024, 16, 16, S, E);
  }
  }
  if constexpr (MASK == ALLPH) xcd_barrier(xb);

  if constexpr ((MASK >> 16) & 1) {
  int tid = threadIdx.x; asm volatile("" : "+v"(tid)); const int lane = tid & 63, wid = tid >> 6, gw = wg * 8 + wid, gtid = wg * 512 + tid; (void)lane; (void)gw; (void)gtid;
  {
    int pm, pn; SchedOne S; S.has = static_tile((long)wg, 64, 4, pm, pn);
    S.u.A0 = S.u.A1 = W5 + (size_t)pm * 256 * 1024 * 2; S.u.B0 = S.u.B1 = WoutT + (size_t)pn * 256 * 1024 * 2; S.u.out = nullptr; S.u.bias = nullptr; S.u.ldc = 1024; S.u.sub = 0;
    S.u.row0 = pm * 256; S.u.col0 = pn * 256; S.u.aux0 = pm; S.u.aux1 = pn;
    EpiOutNorm E; E.x = x; E.out = p.out; E.g = p.in[27]; E.P = xP; E.xch = (float*)(p.ws + O_XCH); E.cnt = (unsigned*)(p.ws + O_CNT);
    gemm_phase<SchedOne, EpiOutNorm, true>(lds, 1024, 1024, 16, 16, S, E);
  }
  }


  if constexpr ((MASK >> 17) & 1) {
  int tid = threadIdx.x; asm volatile("" : "+v"(tid)); const int lane = tid & 63, wid = tid >> 6, gw = wg * 8 + wid, gtid = wg * 512 + tid; (void)lane; (void)gw; (void)gtid;
  }
}

#ifndef MK_SINGLE
#define MK_SINGLE 1
#endif
template <unsigned MASK>
static void launch_phase(const Params& p, int grid, size_t lds, hipStream_t stream) {
  static bool attr = false;
  if (!attr) { (void)hipFuncSetAttribute((const void*)mk_fwd<MASK>, hipFuncAttributeMaxDynamicSharedMemorySize, (int)lds); attr = true; }
  hipLaunchKernelGGL(mk_fwd<MASK>, dim3(grid), dim3(512), lds, stream, p);
}
extern "C" void kernel_launch(void* const* d_in, const int* in_sizes, int n_in, void* d_out, int out_size, void* d_ws, size_t ws_size, hipStream_t stream) {
  constexpr size_t kDynLds = STAGE_BYTES + 16384;
  static int grid_blocks = 0;
  if (!grid_blocks) {
    int dev = 0, cus = 0, per_cu = 0;
    (void)hipGetDevice(&dev);
    (void)hipDeviceGetAttribute(&cus, hipDeviceAttributeMultiprocessorCount, dev);
#if MK_SINGLE
    (void)hipFuncSetAttribute((const void*)mk_fwd<ALLPH>, hipFuncAttributeMaxDynamicSharedMemorySize, (int)kDynLds);
    (void)hipOccupancyMaxActiveBlocksPerMultiprocessor(&per_cu, (const void*)mk_fwd<ALLPH>, 512, kDynLds);
    if (per_cu < 1) fprintf(stderr, "occupancy query says %d blocks/CU\n", per_cu);
#endif
    if (ws_size < WS_NEED) fprintf(stderr, "workspace too small: %zu < %zu\n", ws_size, (size_t)WS_NEED);
    grid_blocks = 256; if (cus < 256) fprintf(stderr, "this kernel needs 256 CUs, device has %d\n", cus);
  }
  Params p{};
  for (int i = 0; i < 28; ++i) p.in[i] = (const float*)d_in[i];
  p.out = (float*)d_out; p.ws = (unsigned char*)d_ws;
#if MK_SINGLE
  (void)hipMemsetAsync((unsigned char*)d_ws + O_BAR, 0, 32768, stream);
  void* args[] = {&p};
  hipError_t e = hipLaunchCooperativeKernel((void*)mk_fwd<ALLPH>, dim3(grid_blocks), dim3(512), args, kDynLds, stream);
  if (e != hipSuccess) fprintf(stderr, "cooperative launch failed: %s (grid %d)\n", hipGetErrorString(e), grid_blocks);
#else
  const int g = grid_blocks;
  launch_phase<1u << 0>(p, g, kDynLds, stream); launch_phase<1u << 1>(p, g, kDynLds, stream); launch_phase<1u << 2>(p, g, kDynLds, stream); launch_phase<1u << 3>(p, g, kDynLds, stream);
  launch_phase<1u << 4>(p, g, kDynLds, stream); launch_phase<1u << 5>(p, g, kDynLds, stream); launch_phase<1u << 6>(p, g, kDynLds, stream); launch_phase<1u << 7>(p, g, kDynLds, stream);
  launch_phase<1u << 8>(p, g, kDynLds, stream); launch_phase<1u << 9>(p, g, kDynLds, stream); launch_phase<1u << 10>(p, g, kDynLds, stream); launch_phase<1u << 11>(p, g, kDynLds, stream);
  launch_phase<1u << 12>(p, g, kDynLds, stream); launch_phase<1u << 13>(p, g, kDynLds, stream); launch_phase<1u << 14>(p, g, kDynLds, stream); launch_phase<1u << 15>(p, g, kDynLds, stream);
  launch_phase<1u << 16>(p, g, kDynLds, stream); launch_phase<1u << 17>(p, g, kDynLds, stream);
#endif
}
```

```cpp
#include <hip/hip_runtime.h>
#include <hip/hip_cooperative_groups.h>
#include <cstdio>
namespace cg = cooperative_groups;

#define LAS __attribute__((address_space(3)))
typedef unsigned short bf16_t;
typedef short bf16x8 __attribute__((ext_vector_type(8)));
typedef float f32x4 __attribute__((ext_vector_type(4)));
typedef unsigned u32x4 __attribute__((ext_vector_type(4)));
typedef unsigned u32x2 __attribute__((ext_vector_type(2)));

constexpr int T = 16384, DM = 1024, SEQ = 8192;
constexpr size_t SLOT = (size_t)T * DM * 2;

constexpr size_t O_WINT = 0;
constexpr size_t O_WBT = O_WINT + (size_t)9216 * 1024 * 2;
constexpr size_t O_WOUTT = O_WBT + (size_t)3 * 1024 * 1024 * 2;
constexpr size_t O_WKVT = O_WOUTT + (size_t)1024 * 1024 * 2;
constexpr size_t O_WQT = O_WKVT + (size_t)2048 * 1024 * 2;
constexpr size_t O_WKT = O_WQT + 524288;
constexpr size_t O_WVT = O_WKT + 524288;
constexpr size_t O_WOT = O_WVT + 524288;
constexpr size_t O_WLRUT = O_WOT + 524288;
constexpr size_t O_BINR = O_WLRUT + 1048576;
constexpr size_t O_WXC = O_BINR + 36864;
constexpr size_t O_WXM = O_WXC + 32768;
constexpr size_t O_GATES = O_WXM + 32768;
constexpr size_t O_BC = O_GATES + (size_t)T * 32 * 4;
constexpr size_t O_AV = O_BC + (size_t)T * 4 * 4;
constexpr size_t O_MT = O_AV + (size_t)T * 4 * 4;
constexpr size_t O_DENP = O_MT + (size_t)T * 4 * 4;
constexpr size_t O_NKLOC = O_DENP + 1048576;
constexpr size_t O_NPREV = O_NKLOC + 262144;
constexpr size_t O_KMEM = O_NPREV + 262144;
constexpr size_t O_VMEMT = O_KMEM + 1048576;
constexpr size_t O_MEMN = O_VMEMT + 1048576;
constexpr size_t O_HEND = O_MEMN + 1048576;
constexpr size_t O_SLOG = O_HEND + 1048576;
constexpr size_t O_CARRY = O_SLOG + 1048576;
constexpr size_t O_BAR = O_CARRY + 1048576;
constexpr size_t O_CNT = O_BAR + 16384;
constexpr size_t O_XCH = O_CNT + 16384;
constexpr size_t O_WGT = O_XCH + 262144;
constexpr size_t O_SMALL_END = O_WGT + 65536;
constexpr size_t O_SLOTS = (size_t)46 * 1024 * 1024;
static_assert(O_SMALL_END <= O_SLOTS, "small region overflow");
constexpr size_t WS_NEED = O_SLOTS + 6 * SLOT;

struct Params { const float* in[28]; float* out; unsigned char* ws; };

__device__ __forceinline__ unsigned pk2(float lo, float hi) { unsigned r; asm volatile("v_cvt_pk_bf16_f32 %0, %1, %2" : "=v"(r) : "v"(lo), "v"(hi)); return r; }
__device__ __forceinline__ float bf_lo(unsigned w) { return __uint_as_float(w << 16); }
__device__ __forceinline__ float bf_hi(unsigned w) { return __uint_as_float(w & 0xffff0000u); }
__device__ __forceinline__ float bf2f(bf16_t b) { return __uint_as_float(((unsigned)b) << 16); }
__device__ __forceinline__ float sigm(float x) { return 1.0f / (1.0f + __expf(-x)); }
__device__ __forceinline__ float sigmf(float x) { return __builtin_amdgcn_rcpf(1.0f + __expf(-x)); }
__device__ __forceinline__ float logsigm(float x) { return fminf(x, 0.f) - log1pf(expf(-fabsf(x))); }
__device__ __forceinline__ float wave_sum(float v) {
#pragma unroll
  for (int o = 1; o < 64; o <<= 1) v += __shfl_xor(v, o);
  return v;
}

constexpr int BM = 256, BK = 64, HALF = 128, HTB = HALF * BK * 2, STAGE_BYTES = 8 * HTB;
__device__ __forceinline__ int lds_byte(int r, int c) { const int st = (r >> 4) * 2 + (c >> 5), rr = r & 15, cc = c & 31, ob = rr * 64 + cc * 2; return st * 1024 + (ob ^ (((ob >> 9) & 1) << 5)); }
__device__ __forceinline__ void stage_rc(int b, int& R, int& C) { const int st = b / 1024, sb = b % 1024, swz = sb ^ (((sb >> 9) & 1) << 5); R = (st >> 1) * 16 + swz / 64; C = (st & 1) * 32 + (swz % 64) / 2; }

__device__ __forceinline__ int perm32(int rho) { const int n = rho >> 4, i = rho & 15; return 8 * (i >> 2) + 4 * n + (i & 3); }
struct UnitD { const char* A0; const char* A1; const char* B0; const char* B1; char* out; const float* bias; int ldc, sub, row0, col0, aux0, aux1; };

__device__ __forceinline__ bool static_tile(long L, int nM, int nN, int& pm, int& pn) {
  const int nwg = nM * nN; if (L >= nwg) return false;
  int wgid = (int)L; { const int q = nwg / 8, r = nwg % 8, xcd = wgid % 8, off = wgid / 8; wgid = (xcd < r ? xcd * (q + 1) : r * (q + 1) + (xcd - r) * q) + off; }
  const int nig = 8 * nN, gid = wgid / nig, fm = gid * 8, gsz = (nM - fm) < 8 ? (nM - fm) : 8;
  pm = fm + ((wgid % nig) % gsz); pn = (wgid % nig) / gsz; return true;
}

#define ROWOF(ai, m) (128 * (ai) + 64 * wr + 16 * (m) + fr)
#define COLOF(bj, n) (128 * (bj) + 32 * wc + 8 * fq + 4 * (n))
#define UNR _Pragma("unroll")

#ifndef GP_SP2
#define GP_SP2 0
#endif
#ifndef GP_ALIGN
#define GP_ALIGN 1
#endif
template <class Sched, class Epi, bool DRAIN>
__device__ __forceinline__ void gemm_phase(LAS unsigned char* lds, const int lda, const int ldb, const int nt, const int nt0, const Sched& S, const Epi& E) {
  int tid = threadIdx.x; asm volatile("" : "+v"(tid));
  const int wid = __builtin_amdgcn_readfirstlane(tid >> 6), lane = tid & 63, wr = wid >> 2, wc = wid & 3, fr = lane & 15, fq = lane >> 4;
  unsigned voffA, voffB;
  { int R, C; stage_rc(tid * 16, R, C); const int Rb = (R & ~31) + perm32(R & 31); voffA = (unsigned)(R * lda + C) * 2u; voffB = (unsigned)(Rb * ldb + C) * 2u; }
  const size_t qstepA = (size_t)64 * lda * 2, qstepB = (size_t)64 * ldb * 2;
  const size_t kstep = (size_t)(BK * 2);
  const size_t hstepA = (size_t)HALF * lda * 2, hstepB = (size_t)HALF * ldb * 2;
  const unsigned ldsw = (unsigned)wid * 1024u;
  const int aoff = lds_byte(wr * 64 + fr, fq * 8), boff = lds_byte(wc * 32 + fr, fq * 8);
#define G_SA(b, h) (((b) * 2 + (h)) * HTB)
#define G_SB(b, h) ((4 + (b) * 2 + (h)) * HTB)
#define qoffA qstepA
#define qoffB qstepB
#define voffA_ voffA
#define G_STAGE(bufoff, gbase, voff) do { _Pragma("unroll") for (int _i = 0; _i < 2; ++_i) \
    __builtin_amdgcn_global_load_lds((const unsigned*)((const char*)(gbase) + (size_t)_i * q##voff + v##voff), (LAS unsigned*)(lds + (bufoff) + ldsw + _i * 8192), 16, 0, 0); } while (0)
#define G_LDA(dst, b, h) do { _Pragma("unroll") for (int m = 0; m < 4; ++m) _Pragma("unroll") for (int k = 0; k < 2; ++k) dst[m][k] = *(const LAS bf16x8*)(lds + G_SA(b, h) + aoff + m * 2048 + k * 1024); } while (0)
#define G_LDB(dst, b, h) do { _Pragma("unroll") for (int n = 0; n < 2; ++n) _Pragma("unroll") for (int k = 0; k < 2; ++k) dst[n][k] = *(const LAS bf16x8*)(lds + G_SB(b, h) + boff + n * 2048 + k * 1024); } while (0)
#define G_MMA(ai, bj, At, Bt) do { __builtin_amdgcn_s_setprio(1); _Pragma("unroll") for (int m = 0; m < 4; ++m) _Pragma("unroll") for (int n = 0; n < 2; ++n) _Pragma("unroll") for (int k = 0; k < 2; ++k) \
    acc[ai][bj][m][n] = __builtin_amdgcn_mfma_f32_16x16x32_bf16(Bt[n][k], At[m][k], acc[ai][bj][m][n], 0, 0, 0); __builtin_amdgcn_s_setprio(0); } while (0)
#define G_WAIT_V(n) asm volatile("s_waitcnt vmcnt(" #n ")" ::: "memory")
#define G_WAIT_L(n) asm volatile("s_waitcnt lgkmcnt(" #n ")" ::: "memory")
#define G_BAR __builtin_amdgcn_s_barrier()
#define G_SCHED __builtin_amdgcn_sched_barrier(0)
  UnitD cur, nxt; int ui = 0;
  if (!S.next(0, cur)) return;
  f32x4 acc[2][2][4][2];
#pragma unroll
  for (int a = 0; a < 2; ++a)
#pragma unroll
    for (int b = 0; b < 2; ++b)
#pragma unroll
      for (int m = 0; m < 4; ++m)
#pragma unroll
        for (int n = 0; n < 2; ++n) acc[a][b][m][n] = (f32x4){0.f, 0.f, 0.f, 0.f};
  bf16x8 At[4][2], B0[2][2], B1[2][2];
  {
    const char* cA = cur.A0; const char* cB = cur.B0;
#if GP_SP2
    G_STAGE(G_SB(0, 0), cB, offB); G_STAGE(G_SB(0, 1), cB + hstepB, offB); G_STAGE(G_SA(0, 0), cA, offA); G_STAGE(G_SA(0, 1), cA + hstepA, offA);
    if (wr == 1) G_BAR;
    G_WAIT_V(2); G_BAR;
    G_STAGE(G_SB(1, 0), cB + kstep, offB); G_STAGE(G_SA(1, 0), cA + kstep, offA); G_STAGE(G_SB(1, 1), cB + hstepB + kstep, offB);
    G_WAIT_V(6); G_BAR;
#else
    G_STAGE(G_SB(0, 0), cB, offB); G_STAGE(G_SA(0, 0), cA, offA); G_STAGE(G_SB(0, 1), cB + hstepB, offB); G_STAGE(G_SA(0, 1), cA + hstepA, offA);
    if (wr == 1) G_BAR;
    G_WAIT_V(4); G_BAR;
    G_STAGE(G_SB(1, 0), cB + kstep, offB); G_STAGE(G_SA(1, 0), cA + kstep, offA); G_STAGE(G_SB(1, 1), cB + hstepB + kstep, offB);
    G_WAIT_V(6); G_BAR;
#endif
  }
  for (;;) {
    const bool has_next = S.next(ui + 1, nxt);
    const char* nA = has_next ? nxt.A0 : cur.A0; const char* nB = has_next ? nxt.B0 : cur.B0;
    for (int t = 0; t < nt; t += 2) {
      const bool last = (t == nt - 2);
      const char* a1 = (t + 1 < nt0) ? cur.A0 + (size_t)(t + 1) * kstep : cur.A1 + (size_t)(t + 1 - nt0) * kstep;
      const char* a2; const char* b2;
      if (last) { a2 = nA; b2 = nB; }
      else if (t + 2 < nt0) { a2 = cur.A0 + (size_t)(t + 2) * kstep; b2 = cur.B0 + (size_t)(t + 2) * kstep; }
      else { a2 = cur.A1 + (size_t)(t + 2 - nt0) * kstep; b2 = cur.B1 + (size_t)(t + 2 - nt0) * kstep; }
      const char* a3 = a2 + kstep; const char* b3 = b2 + kstep;
#if GP_SP2
      G_LDB(B0, 0, 0); G_LDB(B1, 0, 1); G_SCHED; G_LDA(At, 0, 0); G_STAGE(G_SA(1, 1), a1 + hstepA, offA);
      G_WAIT_V(8); G_WAIT_L(0); G_BAR; G_MMA(0, 0, At, B0); G_MMA(0, 1, At, B1); G_BAR; G_SCHED;
      G_LDA(At, 0, 1); G_STAGE(G_SB(0, 0), b2, offB); G_STAGE(G_SB(0, 1), b2 + hstepB, offB); G_STAGE(G_SA(0, 0), a2, offA);
      G_WAIT_V(8); G_WAIT_L(0); G_BAR; G_MMA(1, 0, At, B0); G_MMA(1, 1, At, B1); G_BAR; G_SCHED;
      G_LDB(B0, 1, 0); G_LDB(B1, 1, 1); G_SCHED; G_LDA(At, 1, 0); G_STAGE(G_SA(0, 1), a2 + hstepA, offA);
      G_WAIT_V(8); G_WAIT_L(0); G_BAR; G_MMA(0, 0, At, B0); G_MMA(0, 1, At, B1); G_BAR; G_SCHED;
      G_LDA(At, 1, 1); G_STAGE(G_SB(1, 0), b3, offB); G_STAGE(G_SB(1, 1), b3 + hstepB, offB); G_STAGE(G_SA(1, 0), a3, offA);
      G_WAIT_V(8); G_WAIT_L(0); G_BAR; G_MMA(1, 0, At, B0); G_MMA(1, 1, At, B1); G_BAR; G_SCHED;
#else
      G_LDB(B0, 0, 0); G_SCHED; G_LDA(At, 0, 0); G_STAGE(G_SA(1, 1), a1 + hstepA, offA);
      G_WAIT_L(8); G_BAR; G_WAIT_L(0); G_MMA(0, 0, At, B0); G_BAR; G_SCHED;
      G_LDB(B1, 0, 1); G_STAGE(G_SB(0, 0), b2, offB);
      G_BAR; G_WAIT_L(0); G_MMA(0, 1, At, B1); G_BAR;
      G_LDA(At, 0, 1); G_STAGE(G_SA(0, 0), a2, offA);
      G_BAR; G_WAIT_L(0); G_MMA(1, 0, At, B0); G_BAR; G_SCHED;
      G_STAGE(G_SB(0, 1), b2 + hstepB, offB);
      G_WAIT_V(6); G_BAR; G_MMA(1, 1, At, B1); G_BAR;
      G_LDB(B0, 1, 0); G_SCHED; G_LDA(At, 1, 0); G_STAGE(G_SA(0, 1), a2 + hstepA, offA);
      G_WAIT_L(8); G_BAR; G_WAIT_L(0); G_MMA(0, 0, At, B0); G_BAR; G_SCHED;
      G_LDB(B1, 1, 1); G_STAGE(G_SB(1, 0), b3, offB);
      G_BAR; G_WAIT_L(0); G_MMA(0, 1, At, B1); G_BAR;
      G_LDA(At, 1, 1); G_STAGE(G_SA(1, 0), a3, offA);
      G_BAR; G_WAIT_L(0); G_MMA(1, 0, At, B0); G_BAR; G_SCHED;
      G_STAGE(G_SB(1, 1), b3 + hstepB, offB);
      G_WAIT_V(6); G_BAR; G_MMA(1, 1, At, B1); G_BAR;
#endif
    }
#if GP_ALIGN
    if (wr == 0) G_BAR;
#endif
    if constexpr (!DRAIN) { int fr2 = fr, fq2 = fq; asm volatile("" : "+v"(fr2), "+v"(fq2)); E.run(acc, cur, wr, wc, fr2, fq2); }
    if (!has_next) break;
#pragma unroll
    for (int a = 0; a < 2; ++a)
#pragma unroll
      for (int b = 0; b < 2; ++b)
#pragma unroll
        for (int m = 0; m < 4; ++m)
#pragma unroll
          for (int n = 0; n < 2; ++n) acc[a][b][m][n] = (f32x4){0.f, 0.f, 0.f, 0.f};
    cur = nxt; ++ui;
#if GP_ALIGN
    if (wr == 1) G_BAR;
#endif
  }
  G_WAIT_V(0);
#if !GP_ALIGN
  if (wr == 0) G_BAR;
#endif
  G_BAR;
  if constexpr (DRAIN) { int fr2 = fr, fq2 = fq; asm volatile("" : "+v"(fr2), "+v"(fq2)); E.run(acc, cur, wr, wc, fr2, fq2); }
#undef G_SA
#undef G_SB
#undef G_STAGE
#undef G_LDA
#undef G_LDB
#undef G_MMA
#undef G_WAIT_V
#undef G_WAIT_L
#undef G_BAR
#undef G_SCHED
}

typedef f32x4 Acc[2][2][4][2];

template <bool MAX>
__device__ __forceinline__ void row_allreduce(float (&v)[2][4], LAS float* P, int wr, int wc, int fr, int fq) {
  UNR for (int ai = 0; ai < 2; ++ai) UNR for (int m = 0; m < 4; ++m) {
    float x = v[ai][m];
    float y = __shfl_xor(x, 16); x = MAX ? fmaxf(x, y) : x + y;
    y = __shfl_xor(x, 32); x = MAX ? fmaxf(x, y) : x + y;
    if (fq == 0) P[ROWOF(ai, m) * 4 + wc] = x;
  }
  __syncthreads();
  UNR for (int ai = 0; ai < 2; ++ai) UNR for (int m = 0; m < 4; ++m) {
    const f32x4 q = *(const LAS f32x4*)(P + ROWOF(ai, m) * 4);
    v[ai][m] = MAX ? fmaxf(fmaxf(q.x, q.y), fmaxf(q.z, q.w)) : (q.x + q.y) + (q.z + q.w);
  }
  __syncthreads();
}

struct EpiBf16 {
  const float* m_Av; const float* m_Mt;
  __device__ __forceinline__ void run(Acc& acc, const UnitD& u, int wr, int wc, int fr, int fq) const {
    bf16_t* base = (bf16_t*)u.out + (size_t)(64 * wr + fr) * u.ldc + 32 * wc + 8 * fq;
    UNR for (int bj = 0; bj < 2; ++bj) {
      f32x4 b0 = u.bias ? *(const f32x4*)(u.bias + COLOF(bj, 0)) : (f32x4){0.f, 0.f, 0.f, 0.f};
      f32x4 b1 = u.bias ? *(const f32x4*)(u.bias + COLOF(bj, 1)) : (f32x4){0.f, 0.f, 0.f, 0.f};
      if (u.sub == 2) { const float me = m_Mt[(size_t)(u.row0 + 255) * 4 + u.aux0];
        UNR for (int j = 0; j < 4; ++j) { b0[j] = __expf(m_Av[(size_t)(u.row0 + COLOF(bj, 0) + j) * 4 + u.aux0] - me); b1[j] = __expf(m_Av[(size_t)(u.row0 + COLOF(bj, 1) + j) * 4 + u.aux0] - me); } }
      UNR for (int ai = 0; ai < 2; ++ai) UNR for (int m = 0; m < 4; ++m) {
        f32x4 v0 = acc[ai][bj][m][0], v1 = acc[ai][bj][m][1];
        if (u.sub == 2) { v0 = v0 * b0; v1 = v1 * b1; } else { v0 = v0 + b0; v1 = v1 + b1; }
        if (u.sub == 1) { v0.x = sigmf(v0.x); v0.y = sigmf(v0.y); v0.z = sigmf(v0.z); v0.w = sigmf(v0.w); v1.x = sigmf(v1.x); v1.y = sigmf(v1.y); v1.z = sigmf(v1.z); v1.w = sigmf(v1.w); }
        u32x4 w; w.x = pk2(v0.x, v0.y); w.y = pk2(v0.z, v0.w); w.z = pk2(v1.x, v1.y); w.w = pk2(v1.z, v1.w);
        *(u32x4*)(base + (size_t)(128 * ai + 16 * m) * u.ldc + 128 * bj) = w;
      }
      asm volatile("" ::: "memory");
    }
  }
};
struct EpiU1 {
  const float* m_Av; const float* m_Mt; float* m_denp;
  __device__ __forceinline__ void run(Acc& acc, const UnitD& u, int wr, int wc, int fr, int fq) const {
    const int h = u.aux0, unit = u.aux1, tok0 = u.row0;
    float av[2][8];
    UNR for (int bj = 0; bj < 2; ++bj) UNR for (int j = 0; j < 8; ++j) av[bj][j] = m_Av[(size_t)(tok0 + COLOF(bj, 0) + j) * 4 + h];
    float mtv[2][4];
    UNR for (int ai = 0; ai < 2; ++ai) UNR for (int m = 0; m < 4; ++m) mtv[ai][m] = m_Mt[(size_t)(tok0 + ROWOF(ai, m)) * 4 + h];
    UNR for (int ai = 0; ai < 2; ++ai) UNR for (int m = 0; m < 4; ++m) {
      const int r = ROWOF(ai, m);
      const float mt = mtv[ai][m];
      bf16_t* rowp = (bf16_t*)u.out + (size_t)r * u.ldc;
      float rs = 0.f;
      UNR for (int bj = 0; bj < 2; ++bj) {
        float v[8];
        UNR for (int j = 0; j < 8; ++j) { const int c = COLOF(bj, 0) + j; const float w = (c <= r) ? __expf(av[bj][j] - mt) : 0.f; v[j] = acc[ai][bj][m][j >> 2][j & 3] * w; rs += v[j]; }
        u32x4 w2; w2.x = pk2(v[0], v[1]); w2.y = pk2(v[2], v[3]); w2.z = pk2(v[4], v[5]); w2.w = pk2(v[6], v[7]);
        *(u32x4*)(rowp + COLOF(bj, 0)) = w2;
      }
      rs += __shfl_xor(rs, 16); rs += __shfl_xor(rs, 32);
      if (fq == 0) m_denp[((size_t)unit * 256 + r) * 4 + wc] = rs;
      asm volatile("" ::: "memory");
    }
  }
};
struct EpiLru {
  const float* b_a; const float* b_x; const float* lam; const bf16_t* u; bf16_t* loga; bf16_t* bb;
  __device__ __forceinline__ void run(Acc& acc, const UnitD& ud, int wr, int wc, int fr, int fq) const {
    const int chb = ud.col0;
    UNR for (int bj = 0; bj < 2; ++bj) {
      const int ch = chb + 64 * bj + 16 * wc + 4 * fq;
      const f32x4 ba = *(const f32x4*)(b_a + ch), bx = *(const f32x4*)(b_x + ch), l = *(const f32x4*)(lam + ch);
      f32x4 ls;
      UNR for (int j = 0; j < 4; ++j) ls[j] = 8.0f * logsigm(l[j]);
      const size_t o0 = ((size_t)ud.row0 + 64 * wr + fr) * 1024 + ch;
      UNR for (int ai = 0; ai < 2; ++ai) { u32x2 uq[4];
      UNR for (int m = 0; m < 4; ++m) uq[m] = *(const u32x2*)(u + o0 + (size_t)(128 * ai + 16 * m) * 1024);
      UNR for (int m = 0; m < 4; ++m) {
        const size_t o = o0 + (size_t)(128 * ai + 16 * m) * 1024;
        const u32x2 uw = uq[m];
        const float uu[4] = {bf_lo(uw.x), bf_hi(uw.x), bf_lo(uw.y), bf_hi(uw.y)};
        float la[4], bv[4];
        UNR for (int j = 0; j < 4; ++j) {
          const float rg = sigmf(acc[ai][bj][m][0][j] + ba[j]);
          const float ig = sigmf(acc[ai][bj][m][1][j] + bx[j]);
          la[j] = rg * ls[j];
          const float x2 = 2.0f * la[j];
          const float om = (x2 > -0.02f) ? -(x2 * (1.0f + x2 * (0.5f + x2 * (1.0f / 6.0f)))) : 1.0f - __expf(x2);
          bv[j] = __builtin_amdgcn_sqrtf(fmaxf(om, 0.f)) * ig * uu[j];
        }
        u32x2 w1; w1.x = pk2(la[0], la[1]); w1.y = pk2(la[2], la[3]);
        u32x2 w2; w2.x = pk2(bv[0], bv[1]); w2.y = pk2(bv[2], bv[3]);
        *(u32x2*)(loga + o) = w1; *(u32x2*)(bb + o) = w2;
      }
      asm volatile("" ::: "memory"); }
    }
  }
};
struct EpiZ {
  __device__ __forceinline__ void run(Acc& acc, const UnitD& u, int wr, int wc, int fr, int fq) const {
    bf16_t* base = (bf16_t*)u.out + (size_t)(64 * wr + fr) * u.ldc + 32 * wc + 8 * fq;
    UNR for (int bj = 0; bj < 2; ++bj) {
      const f32x4 b0 = *(const f32x4*)(u.bias + COLOF(bj, 0)), b1 = *(const f32x4*)(u.bias + COLOF(bj, 1));
      u32x4 o[2][4];
      UNR for (int ai = 0; ai < 2; ++ai) UNR for (int m = 0; m < 4; ++m) o[ai][m] = *(const u32x4*)(base + (size_t)(128 * ai + 16 * m) * u.ldc + 128 * bj);
      UNR for (int ai = 0; ai < 2; ++ai) UNR for (int m = 0; m < 4; ++m) {
        const f32x4 z0 = acc[ai][bj][m][0] + b0, z1 = acc[ai][bj][m][1] + b1; const u32x4 ov = o[ai][m];
        u32x4 w; w.x = pk2(bf_lo(ov.x) * z0.x * sigm(z0.x), bf_hi(ov.x) * z0.y * sigm(z0.y)); w.y = pk2(bf_lo(ov.y) * z0.z * sigm(z0.z), bf_hi(ov.y) * z0.w * sigm(z0.w));
        w.z = pk2(bf_lo(ov.z) * z1.x * sigm(z1.x), bf_hi(ov.z) * z1.y * sigm(z1.y)); w.w = pk2(bf_lo(ov.w) * z1.z * sigm(z1.z), bf_hi(ov.w) * z1.w * sigm(z1.w));
        *(u32x4*)(base + (size_t)(128 * ai + 16 * m) * u.ldc + 128 * bj) = w;
      }
      asm volatile("" ::: "memory");
    }
  }
};
struct EpiMerge {
  bf16_t* gsc; float* macc; bf16_t* merged;
  __device__ __forceinline__ void run(Acc& acc, const UnitD& u, int wr, int wc, int fr, int fq) const {
    const size_t org = (size_t)(u.row0 + 64 * wr + fr) * 1024 + u.col0 + 32 * wc + 8 * fq;
    if ((u.sub & 1) == 0) {
      UNR for (int bj = 0; bj < 2; ++bj) {
        const f32x4 b0 = *(const f32x4*)(u.bias + COLOF(bj, 0)), b1 = *(const f32x4*)(u.bias + COLOF(bj, 1));
        UNR for (int ai = 0; ai < 2; ++ai) UNR for (int m = 0; m < 4; ++m) {
          const f32x4 v0 = acc[ai][bj][m][0] + b0, v1 = acc[ai][bj][m][1] + b1;
          u32x4 w; w.x = pk2(sigm(v0.x), sigm(v0.y)); w.y = pk2(sigm(v0.z), sigm(v0.w)); w.z = pk2(sigm(v1.x), sigm(v1.y)); w.w = pk2(sigm(v1.z), sigm(v1.w));
          *(u32x4*)(gsc + org + (size_t)(128 * ai + 16 * m) * 1024 + 128 * bj) = w;
        }
      }
    } else {
      UNR for (int bj = 0; bj < 2; ++bj) {
        u32x4 g[2][4], a[2][4];
        UNR for (int ai = 0; ai < 2; ++ai) UNR for (int m = 0; m < 4; ++m) { const size_t o = org + (size_t)(128 * ai + 16 * m) * 1024 + 128 * bj; g[ai][m] = *(const u32x4*)(gsc + o); if (u.sub != 1) a[ai][m] = *(const u32x4*)(merged + o); }
        UNR for (int ai = 0; ai < 2; ++ai) UNR for (int m = 0; m < 4; ++m) {
          const size_t o = org + (size_t)(128 * ai + 16 * m) * 1024 + 128 * bj;
          const u32x4 gg = g[ai][m];
          f32x4 v0 = acc[ai][bj][m][0], v1 = acc[ai][bj][m][1];
          v0.x *= bf_lo(gg.x); v0.y *= bf_hi(gg.x); v0.z *= bf_lo(gg.y); v0.w *= bf_hi(gg.y); v1.x *= bf_lo(gg.z); v1.y *= bf_hi(gg.z); v1.z *= bf_lo(gg.w); v1.w *= bf_hi(gg.w);
          if (u.sub != 1) { const u32x4 aa = a[ai][m]; v0.x += bf_lo(aa.x); v0.y += bf_hi(aa.x); v0.z += bf_lo(aa.y); v0.w += bf_hi(aa.y); v1.x += bf_lo(aa.z); v1.y += bf_hi(aa.z); v1.z += bf_lo(aa.w); v1.w += bf_hi(aa.w); }
          u32x4 w; w.x = pk2(v0.x, v0.y); w.y = pk2(v0.z, v0.w); w.z = pk2(v1.x, v1.y); w.w = pk2(v1.z, v1.w); *(u32x4*)(merged + o) = w;
        }
        asm volatile("" ::: "memory");
      }
    }
  }
};
struct EpiOut {
  const float* x; float* out;
  __device__ __forceinline__ void run(Acc& acc, const UnitD& u, int wr, int wc, int fr, int fq) const {
    const size_t org = (size_t)(u.row0 + 64 * wr + fr) * 1024 + u.col0 + 32 * wc + 8 * fq;
    UNR for (int bj = 0; bj < 2; ++bj) {
      f32x4 xv[2][4][2];
      UNR for (int ai = 0; ai < 2; ++ai) UNR for (int m = 0; m < 4; ++m) { const size_t o = org + (size_t)(128 * ai + 16 * m) * 1024 + 128 * bj; xv[ai][m][0] = *(const f32x4*)(x + o); xv[ai][m][1] = *(const f32x4*)(x + o + 4); }
      UNR for (int ai = 0; ai < 2; ++ai) UNR for (int m = 0; m < 4; ++m) { const size_t o = org + (size_t)(128 * ai + 16 * m) * 1024 + 128 * bj;
        *(f32x4*)(out + o) = xv[ai][m][0] + acc[ai][bj][m][0]; *(f32x4*)(out + o + 4) = xv[ai][m][1] + acc[ai][bj][m][1]; }
      asm volatile("" ::: "memory");
    }
  }
};
struct EpiSoftmax {
  LAS float* P;
  __device__ __forceinline__ void run(Acc& acc, const UnitD& u, int wr, int wc, int fr, int fq) const {
    float mx[2][4], sm[2][4];
    UNR for (int ai = 0; ai < 2; ++ai) UNR for (int m = 0; m < 4; ++m) { float x = -3.0e38f;
      UNR for (int bj = 0; bj < 2; ++bj) UNR for (int n = 0; n < 2; ++n) UNR for (int j = 0; j < 4; ++j) { acc[ai][bj][m][n][j] *= 0.0625f; x = fmaxf(x, acc[ai][bj][m][n][j]); }
      mx[ai][m] = x; }
    row_allreduce<true>(mx, P, wr, wc, fr, fq);
    UNR for (int ai = 0; ai < 2; ++ai) UNR for (int m = 0; m < 4; ++m) { float s = 0.f;
      UNR for (int bj = 0; bj < 2; ++bj) UNR for (int n = 0; n < 2; ++n) UNR for (int j = 0; j < 4; ++j) { const float e = __expf(acc[ai][bj][m][n][j] - mx[ai][m]); acc[ai][bj][m][n][j] = e; s += e; }
      sm[ai][m] = s; }
    row_allreduce<false>(sm, P, wr, wc, fr, fq);
    UNR for (int ai = 0; ai < 2; ++ai) UNR for (int m = 0; m < 4; ++m) {
      const float inv = __builtin_amdgcn_rcpf(sm[ai][m]);
      bf16_t* rowp = (bf16_t*)u.out + (size_t)ROWOF(ai, m) * u.ldc;
      UNR for (int bj = 0; bj < 2; ++bj) { const f32x4 v0 = acc[ai][bj][m][0] * inv, v1 = acc[ai][bj][m][1] * inv;
        u32x4 w; w.x = pk2(v0.x, v0.y); w.y = pk2(v0.z, v0.w); w.z = pk2(v1.x, v1.y); w.w = pk2(v1.z, v1.w); *(u32x4*)(rowp + COLOF(bj, 0)) = w; }
    }
  }
};
struct EpiU2 {
  LAS float* P; LAS float* deni; const float* m_denp; const float* m_Bc; const float* m_Mt; const bf16_t* og; const float* norm_g; const float* skip; bf16_t* xc;
  __device__ __forceinline__ void run(Acc& acc, const UnitD& u, int wr, int wc, int fr, int fq) const {
    const int h = u.aux0, unit = u.aux1, tok0 = u.row0;
    float s1[2][4], s2[2][4];
    UNR for (int ai = 0; ai < 2; ++ai) UNR for (int m = 0; m < 4; ++m) {
      const int r = ROWOF(ai, m); const size_t tok = (size_t)tok0 + r;
      const f32x4 dp = *(const f32x4*)(m_denp + ((size_t)unit * 256 + r) * 4);
      const float den = (dp.x + dp.y) + (dp.z + dp.w) + deni[r];
      const float mt = m_Bc[tok * 4 + h];
      const float inv = __builtin_amdgcn_rcpf(fmaxf(fabsf(den), __expf(-mt)));
      float s = 0.f;
      const bf16_t* ogp = og + tok * 1024 + h * 256 + 32 * wc + 8 * fq;
      UNR for (int bj = 0; bj < 2; ++bj) {
        const u32x4 o = *(const u32x4*)(ogp + 128 * bj);
        f32x4 v0 = acc[ai][bj][m][0] * inv, v1 = acc[ai][bj][m][1] * inv;
        v0.x *= bf_lo(o.x); v0.y *= bf_hi(o.x); v0.z *= bf_lo(o.y); v0.w *= bf_hi(o.y); v1.x *= bf_lo(o.z); v1.y *= bf_hi(o.z); v1.z *= bf_lo(o.w); v1.w *= bf_hi(o.w);
        acc[ai][bj][m][0] = v0; acc[ai][bj][m][1] = v1; s += ((v0.x + v0.y) + (v0.z + v0.w)) + ((v1.x + v1.y) + (v1.z + v1.w));
      }
      s1[ai][m] = s;
      if (m == 3) asm volatile("" ::: "memory");
    }
    row_allreduce<false>(s1, P, wr, wc, fr, fq);
    UNR for (int ai = 0; ai < 2; ++ai) UNR for (int m = 0; m < 4; ++m) { const float mu = s1[ai][m] * (1.0f / 256.0f); float s = 0.f;
      UNR for (int bj = 0; bj < 2; ++bj) UNR for (int n = 0; n < 2; ++n) { f32x4 v = acc[ai][bj][m][n] - mu; acc[ai][bj][m][n] = v; s += (v.x * v.x + v.y * v.y) + (v.z * v.z + v.w * v.w); }
      s2[ai][m] = s; }
    row_allreduce<false>(s2, P, wr, wc, fr, fq);
    UNR for (int ai = 0; ai < 2; ++ai) UNR for (int m = 0; m < 4; ++m) s2[ai][m] = __builtin_amdgcn_rsqf(s2[ai][m] * (1.0f / 256.0f) + 1e-6f);
    bf16_t* xb = xc + (size_t)(tok0 + 64 * wr + fr) * 1024 + h * 256 + 32 * wc + 8 * fq;
    UNR for (int bj = 0; bj < 2; ++bj) {
      const int ch = h * 256 + COLOF(bj, 0);
      const f32x4 g0 = *(const f32x4*)(norm_g + ch), g1 = *(const f32x4*)(norm_g + ch + 4), k0 = *(const f32x4*)(skip + ch), k1 = *(const f32x4*)(skip + ch + 4);
      UNR for (int ai = 0; ai < 2; ++ai) {
        u32x4 xq[4];
        UNR for (int m = 0; m < 4; ++m) xq[m] = *(const u32x4*)(xb + (size_t)(128 * ai + 16 * m) * 1024 + 128 * bj);
        UNR for (int m = 0; m < 4; ++m) {
          const u32x4 xv = xq[m];
          const f32x4 v0 = acc[ai][bj][m][0] * s2[ai][m], v1 = acc[ai][bj][m][1] * s2[ai][m];
          u32x4 w; w.x = pk2(v0.x * g0.x + k0.x * bf_lo(xv.x), v0.y * g0.y + k0.y * bf_hi(xv.x)); w.y = pk2(v0.z * g0.z + k0.z * bf_lo(xv.y), v0.w * g0.w + k0.w * bf_hi(xv.y));
          w.z = pk2(v1.x * g1.x + k1.x * bf_lo(xv.z), v1.y * g1.y + k1.y * bf_hi(xv.z)); w.w = pk2(v1.z * g1.z + k1.z * bf_lo(xv.w), v1.w * g1.w + k1.w * bf_hi(xv.w));
          *(u32x4*)(xb + (size_t)(128 * ai + 16 * m) * 1024 + 128 * bj) = w;
        }
        asm volatile("" ::: "memory");
      }
    }
  }
};

struct EpiOutNorm {
  const float* x; float* out; const float* g; LAS float* P; float* xch; unsigned* cnt;
  __device__ __forceinline__ void run(Acc& acc, const UnitD& u, int wr, int wc, int fr, int fq) const {
    const int pm = u.aux0, pn = u.aux1;
    const size_t org = (size_t)(u.row0 + 64 * wr + fr) * 1024 + u.col0 + 32 * wc + 8 * fq;
    UNR for (int bj = 0; bj < 2; ++bj) UNR for (int ai = 0; ai < 2; ++ai) {
      f32x4 xv[4][2];
      UNR for (int m = 0; m < 4; ++m) { const size_t o = org + (size_t)(128 * ai + 16 * m) * 1024 + 128 * bj; xv[m][0] = *(const f32x4*)(x + o); xv[m][1] = *(const f32x4*)(x + o + 4); }
      UNR for (int m = 0; m < 4; ++m) { acc[ai][bj][m][0] += xv[m][0]; acc[ai][bj][m][1] += xv[m][1]; }
      asm volatile("" ::: "memory");
    }
    float ss[2][4];
    UNR for (int ai = 0; ai < 2; ++ai) UNR for (int m = 0; m < 4; ++m) { float s = 0.f;
      UNR for (int bj = 0; bj < 2; ++bj) UNR for (int n = 0; n < 2; ++n) { const f32x4 v = acc[ai][bj][m][n]; s += (v.x * v.x + v.y * v.y) + (v.z * v.z + v.w * v.w); }
      ss[ai][m] = s; }
    row_allreduce<false>(ss, P, wr, wc, fr, fq);
    if (wc == 0 && fq == 0) {
      UNR for (int ai = 0; ai < 2; ++ai) UNR for (int m = 0; m < 4; ++m)
        __hip_atomic_store(xch + ((size_t)(pm * 256 + ROWOF(ai, m))) * 4 + pn, ss[ai][m], __ATOMIC_RELAXED, __HIP_MEMORY_SCOPE_AGENT);
    }
    asm volatile("s_waitcnt vmcnt(0)" ::: "memory");
    __syncthreads();
    if (threadIdx.x == 0) {
      unsigned* c = cnt + 64 * pm;
      __hip_atomic_fetch_add(c, 1u, __ATOMIC_RELAXED, __HIP_MEMORY_SCOPE_AGENT);
      unsigned sp = 0;
      while (__hip_atomic_load(c, __ATOMIC_RELAXED, __HIP_MEMORY_SCOPE_AGENT) < 4u) { __builtin_amdgcn_s_sleep(1); if (++sp > (1u << 22)) break; }
      __builtin_amdgcn_fence(__ATOMIC_ACQUIRE, "agent");
      asm volatile("s_waitcnt vmcnt(0)" ::: "memory");
    }
    __syncthreads();
    UNR for (int ai = 0; ai < 2; ++ai) UNR for (int m = 0; m < 4; ++m) {
      const float* sl = xch + ((size_t)(pm * 256 + ROWOF(ai, m))) * 4;
      const float t = (__hip_atomic_load(sl, __ATOMIC_RELAXED, __HIP_MEMORY_SCOPE_AGENT) + __hip_atomic_load(sl + 1, __ATOMIC_RELAXED, __HIP_MEMORY_SCOPE_AGENT))
                    + (__hip_atomic_load(sl + 2, __ATOMIC_RELAXED, __HIP_MEMORY_SCOPE_AGENT) + __hip_atomic_load(sl + 3, __ATOMIC_RELAXED, __HIP_MEMORY_SCOPE_AGENT));
      ss[ai][m] = 1.0f / sqrtf(t * (1.0f / 1024.0f) + 1e-6f);
    }
    int fr3 = fr, fq3 = fq; asm volatile("" : "+v"(fr3), "+v"(fq3));
    const size_t org2 = (size_t)(u.row0 + 64 * wr + fr3) * 1024 + u.col0 + 32 * wc + 8 * fq3;
    UNR for (int bj = 0; bj < 2; ++bj) {
      const f32x4 g0 = *(const f32x4*)(g + u.col0 + COLOF(bj, 0)), g1 = *(const f32x4*)(g + u.col0 + COLOF(bj, 1));
      UNR for (int ai = 0; ai < 2; ++ai) UNR for (int m = 0; m < 4; ++m) { const size_t o = org2 + (size_t)(128 * ai + 16 * m) * 1024 + 128 * bj;
        *(f32x4*)(out + o) = acc[ai][bj][m][0] * ss[ai][m] * g0; *(f32x4*)(out + o + 4) = acc[ai][bj][m][1] * ss[ai][m] * g1; }
    }
  }
};

struct SchedTiles {
  const char* A; const char* Bt; char* out0; char* out1; const float* bias; int nN, G, c;
  __device__ __forceinline__ bool next(int i, UnitD& u) const {
    int pm, pn; if (!static_tile((long)i * G + c, 64, nN, pm, pn)) return false;
    u.A0 = u.A1 = A + (size_t)pm * 256 * 1024 * 2; u.B0 = u.B1 = Bt + (size_t)pn * 256 * 1024 * 2;
    u.out = ((pn >> 2) ? out1 : out0) + ((size_t)pm * 256 * 1024 + (pn & 3) * 256) * 2; u.bias = bias ? bias + pn * 256 : nullptr; u.ldc = 1024; u.sub = 0;
    u.row0 = pm * 256; u.col0 = (pn & 3) * 256; u.aux0 = 0; u.aux1 = 0; return true;
  }
};
struct SchedOne { UnitD u; bool has; __device__ __forceinline__ bool next(int i, UnitD& o) const { if (i != 0 || !has) return false; o = u; return true; } };
struct SchedP3X {
  const char* xc; const char* mx; const char* wq; const char* wk; const char* wo; char* q; char* k; char* og; const float* b_o; int G, c;
  __device__ __forceinline__ bool next(int i, UnitD& u) const {
    const int L = i * G + c; if (L >= 768) return false;
    const int kind = L >> 8, idx = L & 255, pm = idx >> 2, h = idx & 3;
    const size_t to = ((size_t)pm * 256 * 1024 + h * 256) * 2;
    u.A0 = u.A1 = (kind == 2 ? mx : xc) + to; u.B0 = u.B1 = wq + (size_t)(kind == 0 ? 0 : kind == 1 ? 524288 : 1572864) + (size_t)h * 131072;
    u.out = q + (size_t)kind * SLOT + to; u.bias = kind == 2 ? b_o + h * 256 : nullptr; u.ldc = 1024; u.sub = kind == 2 ? 1 : 0;
    u.row0 = pm * 256; u.col0 = h * 256; u.aux0 = h; u.aux1 = 0; return true;
  }
};
struct SchedP3Y {
  const char* xc; const char* mx; const char* wk; const char* wv; char* vt; char* ktw; int G, c, base, count;
  __device__ __forceinline__ bool next(int i, UnitD& u) const {
    const int Lr = i * G + c; if (Lr >= count) return false;
    const int L = base + Lr;
    const int kind = L >> 8, unit = L & 255, bh = unit >> 5, ci = unit & 31, b = bh >> 2, h = bh & 3, tok0 = b * SEQ + ci * 256;
    u.A0 = u.A1 = (kind ? wk : wv) + (size_t)h * 131072; u.B0 = u.B1 = (kind ? xc : mx) + ((size_t)tok0 * 1024 + h * 256) * 2;
    u.out = (kind ? ktw : vt) + (size_t)unit * 131072; u.bias = nullptr; u.ldc = 256; u.sub = kind ? 2 : 0; u.row0 = tok0; u.col0 = 0; u.aux0 = h; u.aux1 = unit; return true;
  }
};
struct SchedZ {
  const char* hn; const char* wint; char* y0; char* y1; char* y2; const float* binr; int G, c;
  __device__ __forceinline__ bool next(int i, UnitD& u) const {
    const int L = i * G + c; if (L >= 768) return false;
    const int br = L >> 8, r = L & 255, pm = (r & 7) * 8 + (r >> 5), pn = (r >> 3) & 3;
    u.A0 = u.A1 = hn + (size_t)pm * 256 * 1024 * 2; u.B0 = u.B1 = wint + (size_t)(3072 + br * 1024 + pn * 256) * 1024 * 2;
    u.out = (char*)((size_t)y0 * (size_t)(br == 0) + (size_t)y1 * (size_t)(br == 1) + (size_t)y2 * (size_t)(br == 2)) + ((size_t)pm * 256 * 1024 + pn * 256) * 2; u.bias = binr + 3072 + br * 1024 + pn * 256; u.ldc = 1024; u.sub = 0; u.row0 = pm * 256; u.col0 = pn * 256; u.aux0 = 0; u.aux1 = 0; return true;
  }
};
struct SchedMerge {
  const char* hn; const char* wint; const char* wbt; const char* y0; const char* y1; const char* y2; const float* binr; int G, c;
  __device__ __forceinline__ bool next(int i, UnitD& u) const {
    const int tile = (i / 6) * G + c; if (tile >= 256) return false;
    const int kind = i % 6, n = kind >> 1, pm = (tile & 7) * 8 + (tile >> 5), pn = (tile >> 3) & 3;
    if ((kind & 1) == 0) { u.A0 = u.A1 = hn + (size_t)pm * 256 * 1024 * 2; u.B0 = u.B1 = wint + (size_t)(6144 + n * 1024 + pn * 256) * 1024 * 2; u.bias = binr + 6144 + n * 1024 + pn * 256; }
    else { u.A0 = u.A1 = (const char*)((size_t)y0 * (size_t)(n == 0) + (size_t)y1 * (size_t)(n == 1) + (size_t)y2 * (size_t)(n == 2)) + (size_t)pm * 256 * 1024 * 2; u.B0 = u.B1 = wbt + (size_t)(n * 1024 + pn * 256) * 1024 * 2; u.bias = nullptr; }
    u.out = nullptr; u.ldc = 1024; u.sub = kind; u.row0 = pm * 256; u.col0 = pn * 256; u.aux0 = 0; u.aux1 = 0; return true;
  }
};
struct SchedLru {
  const char* u_; const char* wl; int G, c;
  __device__ __forceinline__ bool next(int i, UnitD& u) const {
    const int L = i * G + c; if (L >= 512) return false;
    const int pm = (L & 7) * 8 + (L >> 6), pn = (L >> 3) & 7;
    u.A0 = u.A1 = u_ + ((size_t)pm * 256 * 1024 + (pn >> 1) * 256) * 2; u.B0 = u.B1 = wl + (size_t)pn * 131072;
    u.out = nullptr; u.bias = nullptr; u.ldc = 1024; u.sub = 0; u.row0 = pm * 256; u.col0 = (pn >> 1) * 256 + (pn & 1) * 128; u.aux0 = 0; u.aux1 = 0; return true;
  }
};

template <int NR>
__device__ __forceinline__ void rmsnorm_rows_bf16(const float* xr, const float* g, bf16_t* o, int lane) {
  f32x4 v[NR][4]; float s[NR];
#pragma unroll
  for (int r = 0; r < NR; ++r)
#pragma unroll
    for (int j = 0; j < 4; ++j) v[r][j] = ((const f32x4*)(xr + (size_t)r * 1024))[lane + 64 * j];
#pragma unroll
  for (int r = 0; r < NR; ++r) { float t = 0.f;
#pragma unroll
    for (int j = 0; j < 4; ++j) t += (v[r][j].x * v[r][j].x + v[r][j].y * v[r][j].y) + (v[r][j].z * v[r][j].z + v[r][j].w * v[r][j].w);
    s[r] = 1.0f / sqrtf(wave_sum(t) * (1.0f / 1024.0f) + 1e-6f); }
#pragma unroll
  for (int j = 0; j < 4; ++j) { const f32x4 gg = ((const f32x4*)g)[lane + 64 * j];
#pragma unroll
    for (int r = 0; r < NR; ++r) { u32x2 w; w.x = pk2(v[r][j].x * s[r] * gg.x, v[r][j].y * s[r] * gg.y); w.y = pk2(v[r][j].z * s[r] * gg.z, v[r][j].w * s[r] * gg.w); ((u32x2*)(o + (size_t)r * 1024))[lane + 64 * j] = w; } }
}
__device__ __forceinline__ void rmsnorm_row_bf16(const float* xr, const float* g, bf16_t* o, int lane) { rmsnorm_rows_bf16<1>(xr, g, o, lane); }

template <class RowMap>
__device__ __forceinline__ void transpose_tile(const float* __restrict__ src, int N, int K, int k0, int n0, bf16_t* dst, RowMap rm, float scale, LAS float* scr) {
  const int tid = threadIdx.x;
  { const int n4 = tid & 15, kk = tid >> 4;
    f32x4 a[4], b[4];
#pragma unroll
    for (int cb = 0; cb < 4; ++cb) { a[cb] = *(const f32x4*)(src + (size_t)(k0 + kk) * N + n0 + cb * 64 + 4 * n4); b[cb] = *(const f32x4*)(src + (size_t)(k0 + kk + 32) * N + n0 + cb * 64 + 4 * n4); }
#pragma unroll
    for (int cb = 0; cb < 4; ++cb) { LAS float* s0 = scr + kk * 261 + cb * 64 + 4 * n4; LAS float* s1 = s0 + 32 * 261;
      s0[0] = a[cb].x; s0[1] = a[cb].y; s0[2] = a[cb].z; s0[3] = a[cb].w; s1[0] = b[cb].x; s1[1] = b[cb].y; s1[2] = b[cb].z; s1[3] = b[cb].w; } }
  __syncthreads();
#pragma unroll
  for (int cb = 0; cb < 4; ++cb) { const int nn = cb * 64 + (tid >> 3), kc = tid & 7; const LAS float* s = scr + (kc * 8) * 261 + nn;
    u32x4 o; o.x = pk2(s[0] * scale, s[261] * scale); o.y = pk2(s[522] * scale, s[783] * scale); o.z = pk2(s[1044] * scale, s[1305] * scale); o.w = pk2(s[1566] * scale, s[1827] * scale);
    *(u32x4*)(dst + (size_t)rm(n0 + nn) * K + k0 + kc * 8) = o; }
  __syncthreads();
}
struct RmId { __device__ __forceinline__ int operator()(int n) const { return n; } };
struct RmWin { __device__ __forceinline__ int operator()(int n) const { const int b = n >> 10; const int mb = b == 0 ? 1 : b == 1 ? 3 : b == 2 ? 0 : b == 3 ? 4 : b == 4 ? 2 : b; return mb * 1024 + (n & 1023); } };
struct RmLru { int mat; __device__ __forceinline__ int operator()(int o) const { const int pnl = o >> 7, cl = o & 127; return pnl * 256 + 128 * (cl >> 6) + 32 * ((cl >> 4) & 3) + 8 * ((cl >> 2) & 3) + 4 * mat + (cl & 3); } };

template <bool MAX>
__device__ __forceinline__ float block_excl_scan(float v, LAS float* tmp) {
  const int lane = threadIdx.x & 63, wid = threadIdx.x >> 6;
  const float ident = MAX ? -3.0e38f : 0.f;
  float inc = v;
#pragma unroll
  for (int o = 1; o < 64; o <<= 1) { const float y = __shfl_up(inc, o); if (lane >= o) inc = MAX ? fmaxf(inc, y) : inc + y; }
  if (lane == 63) tmp[wid] = inc;
  __syncthreads();
  float base = ident;
  for (int w = 0; w < wid; ++w) base = MAX ? fmaxf(base, tmp[w]) : base + tmp[w];
  float ex = __shfl_up(inc, 1); if (lane == 0) ex = ident;
  __syncthreads();
  return MAX ? fmaxf(base, ex) : base + ex;
}

template <bool MLSTM>
__device__ __forceinline__ void conv_rows(const Params& p, const bf16_t* src, bf16_t* dst, const float* cw, const float* cb, float* gates, const float* b_if, LAS float* wxc, LAS float* wxm, int gw, int NW, int lane) {
  for (int t = gw; t < T; t += NW) {
    const int tl = t & (SEQ - 1);
    float g[8];
#pragma unroll
    for (int j = 0; j < 8; ++j) g[j] = 0.f;
#pragma unroll
    for (int i = 0; i < 2; ++i) { const int c0 = i * 512 + lane * 8;
      float o[8], xm[8];
      { const f32x4 a = *(const f32x4*)(cb + c0), b = *(const f32x4*)(cb + c0 + 4);
        o[0] = a.x; o[1] = a.y; o[2] = a.z; o[3] = a.w; o[4] = b.x; o[5] = b.y; o[6] = b.z; o[7] = b.w; }
#pragma unroll
      for (int e = 0; e < 8; ++e) xm[e] = 0.f;
#pragma unroll
      for (int k = 0; k < 4; ++k) {
        if (tl - 3 + k >= 0) {
          const u32x4 v = *(const u32x4*)(src + (size_t)(t - 3 + k) * 1024 + c0);
          const f32x4 wa = *(const f32x4*)(cw + k * 1024 + c0), wb = *(const f32x4*)(cw + k * 1024 + c0 + 4);
          const float xv[8] = {bf_lo(v.x), bf_hi(v.x), bf_lo(v.y), bf_hi(v.y), bf_lo(v.z), bf_hi(v.z), bf_lo(v.w), bf_hi(v.w)};
          const float wv[8] = {wa.x, wa.y, wa.z, wa.w, wb.x, wb.y, wb.z, wb.w};
#pragma unroll
          for (int e = 0; e < 8; ++e) { o[e] += wv[e] * xv[e]; if (k == 3) xm[e] = xv[e]; }
        }
      }
      if (MLSTM) {
#pragma unroll
        for (int e = 0; e < 8; ++e) o[e] = o[e] * sigm(o[e]);
#pragma unroll
        for (int e = 0; e < 8; ++e) { const int c = c0 + e;
          const f32x4 a0 = *(const LAS f32x4*)(wxc + c * 8), a1 = *(const LAS f32x4*)(wxc + c * 8 + 4), m0 = *(const LAS f32x4*)(wxm + c * 8), m1 = *(const LAS f32x4*)(wxm + c * 8 + 4);
          g[0] += o[e] * a0.x + xm[e] * m0.x; g[1] += o[e] * a0.y + xm[e] * m0.y; g[2] += o[e] * a0.z + xm[e] * m0.z; g[3] += o[e] * a0.w + xm[e] * m0.w;
          g[4] += o[e] * a1.x + xm[e] * m1.x; g[5] += o[e] * a1.y + xm[e] * m1.y; g[6] += o[e] * a1.z + xm[e] * m1.z; g[7] += o[e] * a1.w + xm[e] * m1.w; }
      }
      u32x4 ov; ov.x = pk2(o[0], o[1]); ov.y = pk2(o[2], o[3]); ov.z = pk2(o[4], o[5]); ov.w = pk2(o[6], o[7]);
      *(u32x4*)(dst + (size_t)t * 1024 + c0) = ov;
    }
    if (MLSTM) {
#pragma unroll
      for (int j = 0; j < 8; ++j) g[j] = wave_sum(g[j]);
      if (lane == 0) {
        f32x4 o0, o1;
        o0.x = g[0] + b_if[0]; o0.y = g[1] + b_if[1]; o0.z = g[2] + b_if[2]; o0.w = g[3] + b_if[3];
        o1.x = logsigm(g[4] + b_if[4]); o1.y = logsigm(g[5] + b_if[5]); o1.z = logsigm(g[6] + b_if[6]); o1.w = logsigm(g[7] + b_if[7]);
        *(f32x4*)(gates + (size_t)t * 8) = o0; *(f32x4*)(gates + (size_t)t * 8 + 4) = o1;
      }
    }
  }
}

template <bool SILU>
__device__ __forceinline__ void conv_item(const bf16_t* src, bf16_t* dst, const float* cw, const float* cb, int c0, int t0) {
  const bool first = ((t0 & (SEQ - 1)) == 0);
  u32x4 xr[19];
#pragma unroll
  for (int i = 0; i < 19; ++i) { if (i < 3 && first) xr[i] = (u32x4){0u, 0u, 0u, 0u}; else xr[i] = *(const u32x4*)(src + (size_t)(t0 - 3 + i) * 1024 + c0); }
  float w[4][8], bs[8];
#pragma unroll
  for (int k = 0; k < 4; ++k) { const f32x4 a = *(const f32x4*)(cw + k * 1024 + c0), b = *(const f32x4*)(cw + k * 1024 + c0 + 4);
    w[k][0] = a.x; w[k][1] = a.y; w[k][2] = a.z; w[k][3] = a.w; w[k][4] = b.x; w[k][5] = b.y; w[k][6] = b.z; w[k][7] = b.w; }
  { const f32x4 a = *(const f32x4*)(cb + c0), b = *(const f32x4*)(cb + c0 + 4); bs[0] = a.x; bs[1] = a.y; bs[2] = a.z; bs[3] = a.w; bs[4] = b.x; bs[5] = b.y; bs[6] = b.z; bs[7] = b.w; }
#pragma unroll
  for (int t = 0; t < 16; ++t) {
    float o[8];
#pragma unroll
    for (int e = 0; e < 8; ++e) o[e] = bs[e];
#pragma unroll
    for (int k = 0; k < 4; ++k) { const u32x4 v = xr[t + k];
      o[0] += w[k][0] * bf_lo(v.x); o[1] += w[k][1] * bf_hi(v.x); o[2] += w[k][2] * bf_lo(v.y); o[3] += w[k][3] * bf_hi(v.y);
      o[4] += w[k][4] * bf_lo(v.z); o[5] += w[k][5] * bf_hi(v.z); o[6] += w[k][6] * bf_lo(v.w); o[7] += w[k][7] * bf_hi(v.w); }
    if (SILU) {
#pragma unroll
      for (int e = 0; e < 8; ++e) o[e] = o[e] * sigmf(o[e]); }
    u32x4 ov; ov.x = pk2(o[0], o[1]); ov.y = pk2(o[2], o[3]); ov.z = pk2(o[4], o[5]); ov.w = pk2(o[6], o[7]);
    *(u32x4*)(dst + (size_t)(t0 + t) * 1024 + c0) = ov;
  }
}
template <bool SILU>
__device__ __forceinline__ void conv_stream(const bf16_t* src, bf16_t* dst, const float* cw, const float* cb, int gtid, int GT) {
  for (int g = gtid; g < 131072; g += GT) conv_item<SILU>(src, dst, cw, cb, (g & 127) * 8, (g >> 7) * 16);
}
__device__ __forceinline__ void gates_tile(const bf16_t* xc, const bf16_t* xm, const bf16_t* wgT, float* part, int tok0, int h, int wid, int lane) {
  const int i16 = lane & 15, kg = lane >> 4;
#pragma unroll 1
  for (int tt = wid; tt < 16; tt += 8) {
    const int t16 = tok0 + tt * 16;
    f32x4 acc = {0.f, 0.f, 0.f, 0.f};
    const bf16_t* ap = xc + (size_t)(t16 + i16) * 1024 + h * 256 + kg * 8;
    const bf16_t* bp = wgT + (size_t)i16 * 2048 + h * 256 + kg * 8;
#pragma unroll
    for (int ks = 0; ks < 8; ++ks) { const bf16x8 a = *(const bf16x8*)(ap + ks * 32), b = *(const bf16x8*)(bp + ks * 32); acc = __builtin_amdgcn_mfma_f32_16x16x32_bf16(a, b, acc, 0, 0, 0); }
    ap = xm + (size_t)(t16 + i16) * 1024 + h * 256 + kg * 8; bp += 1024;
#pragma unroll
    for (int ks = 0; ks < 8; ++ks) { const bf16x8 a = *(const bf16x8*)(ap + ks * 32), b = *(const bf16x8*)(bp + ks * 32); acc = __builtin_amdgcn_mfma_f32_16x16x32_bf16(a, b, acc, 0, 0, 0); }
    if (i16 < 8) *(f32x4*)(part + ((size_t)h * 8 + i16) * T + t16 + 4 * kg) = acc;
  }
}

__device__ __forceinline__ void gates_gemm(const bf16_t* xc, const bf16_t* xm, const bf16_t* wgT, float* part, int gw, int NW, int lane) {
  const int i16 = lane & 15, kg = lane >> 4;
  for (int item = gw; item < 2048; item += NW) {
    const int tile = item >> 1, half = item & 1, tok0 = tile * 16;
    f32x4 acc = {0.f, 0.f, 0.f, 0.f};
    const bf16_t* ap = (half ? xm : xc) + (size_t)(tok0 + i16) * 1024 + kg * 8;
    const bf16_t* bp = wgT + (size_t)i16 * 2048 + half * 1024 + kg * 8;
#pragma unroll 16
    for (int ks = 0; ks < 32; ++ks) { const bf16x8 a = *(const bf16x8*)(ap + ks * 32), b = *(const bf16x8*)(bp + ks * 32); acc = __builtin_amdgcn_mfma_f32_16x16x32_bf16(a, b, acc, 0, 0, 0); }
    if (i16 < 8) *(f32x4*)(part + ((size_t)half * 8 + i16) * T + tok0 + 4 * kg) = acc;
  }
}

#define XB_TMO      128
#define XB_XCNT(j)  (256  + 64 * (j))
#define XB_XSUB(j)  (1280 + 64 * (j))
#define XB_XGEN(j)  (2304 + 64 * (j))
#define XB_TOP      3328
#define XB_TOPGEN   3392
#define XCD_BAR_WORDS 3456
#define XB_SPIN_CAP (1u << 18)
__device__ __forceinline__ unsigned xb_ld(unsigned* p)              { return __hip_atomic_load(p, __ATOMIC_RELAXED, __HIP_MEMORY_SCOPE_AGENT); }
__device__ __forceinline__ unsigned xb_add(unsigned* p, unsigned v) { return __hip_atomic_fetch_add(p, v, __ATOMIC_RELAXED, __HIP_MEMORY_SCOPE_AGENT); }
__device__ __forceinline__ unsigned xb_xcc_id() { return (unsigned)__builtin_amdgcn_s_getreg((3 << 11) | 20) & 0xFu; }
#define XB_SPIN(cond, bar) do { unsigned _sp = 0; while (cond) { __builtin_amdgcn_s_sleep(1); \
    if ((++_sp & 255u) == 0u) { if (xb_ld(&(bar)[XB_TMO])) break; if (_sp > XB_SPIN_CAP) { atomicAdd(&(bar)[XB_TMO], 1u); break; } } } } while (0)
struct XcdBarrier { unsigned* bar; unsigned x; volatile LAS unsigned* st; };
__device__ __forceinline__ XcdBarrier xcd_barrier_post(unsigned* bar, volatile LAS unsigned* st) {
    XcdBarrier b; b.bar = bar; b.x = xb_xcc_id(); b.st = st;
    if (threadIdx.x == 0) (void)xb_add(&bar[XB_XCNT(b.x)], 1u);
    return b;
}
__device__ __forceinline__ void xcd_barrier_complete(unsigned* bar, unsigned x, unsigned& nloc, unsigned& nx) {
    const unsigned G = gridDim.x * gridDim.y * gridDim.z;
    unsigned sum, cnt, mine, sp = 0u;
    for (;;) {
        sum = 0u; cnt = 0u; mine = 0u;
#pragma unroll
        for (unsigned j = 0; j < 16; ++j) { const unsigned c = xb_ld(&bar[XB_XCNT(j)]); sum += c; cnt += (c > 0u) ? 1u : 0u; mine = (j == x) ? c : mine; }
        if (sum == G) break;
        __builtin_amdgcn_s_sleep(1);
        if ((++sp & 255u) == 0u) { if (xb_ld(&bar[XB_TMO])) break; if (sp > XB_SPIN_CAP) { atomicAdd(&bar[XB_TMO], 1u); break; } }
    }
    nloc = mine > 0u ? mine : 1u; nx = cnt > 0u ? cnt : 1u;
}
__device__ __forceinline__ void xcd_barrier(const XcdBarrier& b) {
    asm volatile("s_waitcnt vmcnt(0)" ::: "memory");
    __syncthreads();
    if (threadIdx.x == 0) {
        unsigned* bar = b.bar;
        __builtin_amdgcn_s_waitcnt(0);
        unsigned nloc = b.st[0], nx = b.st[1];
        if (nloc == 0u) { xcd_barrier_complete(bar, b.x, nloc, nx); b.st[0] = nloc; b.st[1] = nx; }
        const unsigned old = xb_add(&bar[XB_XSUB(b.x)], 1u);
        const unsigned gen = old / nloc;
        if (old + 1u == (gen + 1u) * nloc) {
            __builtin_amdgcn_fence(__ATOMIC_RELEASE, "agent");
            asm volatile("s_waitcnt vmcnt(0)" ::: "memory");
            const unsigned og = xb_add(&bar[XB_TOP], 1u);
            const unsigned tg = og / nx;
            if (og + 1u == (tg + 1u) * nx) xb_add(&bar[XB_TOPGEN], 1u);
            else XB_SPIN(xb_ld(&bar[XB_TOPGEN]) == tg, bar);
            __builtin_amdgcn_fence(__ATOMIC_ACQUIRE, "agent");
            xb_add(&bar[XB_XGEN(b.x)], 1u);
            asm volatile("s_waitcnt vmcnt(0)" ::: "memory");
        } else {
            XB_SPIN(xb_ld(&bar[XB_XGEN(b.x)]) == gen, bar);
            __builtin_amdgcn_fence(__ATOMIC_ACQUIRE, "agent");
            asm volatile("s_waitcnt vmcnt(0)" ::: "memory");
        }
    }
    __syncthreads();
}

#define W0 ((char*)p.ws + O_SLOTS)
#define W1 ((char*)p.ws + O_SLOTS + SLOT)
#define W2 ((char*)p.ws + O_SLOTS + 2 * SLOT)
#define W3 ((char*)p.ws + O_SLOTS + 3 * SLOT)
#define W4 ((char*)p.ws + O_SLOTS + 4 * SLOT)
#define W5 ((char*)p.ws + O_SLOTS + 5 * SLOT)
#define D0 ((char*)p.out)
#define D1 ((char*)p.out + SLOT)
#define WinT ((const char*)p.ws + O_WINT)
#define WbT ((const char*)p.ws + O_WBT)
#define WoutT ((const char*)p.ws + O_WOUTT)
#define WkvT ((const char*)p.ws + O_WKVT)
#define WqT ((const char*)p.ws + O_WQT)
#define WkT ((const char*)p.ws + O_WKT)
#define WvT ((const char*)p.ws + O_WVT)
#define WoT ((const char*)p.ws + O_WOT)
#define WlruT ((const char*)p.ws + O_WLRUT)
#define binR ((float*)(p.ws + O_BINR))
#define Wxc ((float*)(p.ws + O_WXC))
#define Wxm ((float*)(p.ws + O_WXM))
#define gates ((float*)(p.ws + O_GATES))
#define Bc ((float*)(p.ws + O_BC))
#define Av ((float*)(p.ws + O_AV))
#define Mt ((float*)(p.ws + O_MT))
#define denp ((float*)(p.ws + O_DENP))
#define nkloc ((float*)(p.ws + O_NKLOC))
#define nprev ((float*)(p.ws + O_NPREV))
#define Kmem ((char*)p.ws + O_KMEM)
#define VmemT ((char*)p.ws + O_VMEMT)
#define memN ((char*)p.ws + O_MEMN)
#define hend ((float*)(p.ws + O_HEND))
#define slog ((float*)(p.ws + O_SLOG))
#define carry ((float*)(p.ws + O_CARRY))
__device__ __forceinline__ void transpose_item(const Params& p, int it, LAS float* ldsf) {
  int r = it;
  if (r < 576) { transpose_tile(p.in[3], 9216, 1024, (r / 36) * 64, (r % 36) * 256, (bf16_t*)WinT, RmWin(), 1.0f, ldsf); return; } r -= 576;
  if (r < 192) { const int n_ = r >> 6, q = r & 63; transpose_tile(p.in[25] + (size_t)n_ * 1048576, 1024, 1024, (q >> 2) * 64, (q & 3) * 256, (bf16_t*)WbT + (size_t)n_ * 1048576, RmId(), 1.0f, ldsf); return; } r -= 192;
  if (r < 64) { transpose_tile(p.in[26], 1024, 1024, (r >> 2) * 64, (r & 3) * 256, (bf16_t*)WoutT, RmId(), 1.0f, ldsf); return; } r -= 64;
  if (r < 128) { transpose_tile(p.in[24], 2048, 1024, (r >> 3) * 64, (r & 7) * 256, (bf16_t*)WkvT, RmId(), 1.0f, ldsf); return; } r -= 128;
  if (r < 64) { const int mat = r >> 4, q = r & 15, h = q >> 2, kb = q & 3;
    const float* srcp = (mat == 0 ? p.in[14] : mat == 1 ? p.in[15] : mat == 2 ? p.in[16] : p.in[17]) + (size_t)h * 65536;
    bf16_t* dstp = (bf16_t*)WqT + (size_t)mat * 262144 + (size_t)h * 65536;
    transpose_tile(srcp, 256, 256, kb * 64, 0, dstp, RmId(), mat == 1 ? 0.0625f : 1.0f, ldsf); return; } r -= 64;
  { const int mat = r >> 4, q = r & 15, g = q >> 2, kb = q & 3; RmLru rm; rm.mat = mat;
    transpose_tile((mat == 0 ? p.in[7] : p.in[9]) + (size_t)g * 65536, 256, 256, kb * 64, 0, (bf16_t*)WlruT + (size_t)g * 131072, rm, 1.0f, ldsf); }
}

constexpr unsigned ALLPH = (1u << 18) - 1u;
template <unsigned MASK>
__global__ void __launch_bounds__(512) mk_fwd(Params p) {
  extern __shared__ __attribute__((aligned(16))) unsigned char smem[];
  LAS unsigned char* lds = (LAS unsigned char*)smem;
  LAS float* ldsf = (LAS float*)lds;
  LAS float* xP = (LAS float*)(lds + STAGE_BYTES);
  LAS float* xD = (LAS float*)(lds + STAGE_BYTES + 4096);
  LAS float* xW = (LAS float*)(lds + STAGE_BYTES + 5120);
  LAS float* xT = (LAS float*)(lds + STAGE_BYTES + 7168);
  cg::grid_group grid = cg::this_grid();
  volatile LAS unsigned* xst = (volatile LAS unsigned*)(lds + STAGE_BYTES + 8192);
  if (threadIdx.x == 0) { xst[0] = 0u; xst[1] = 0u; }
  __syncthreads();
  XcdBarrier xb; if constexpr (MASK == ALLPH) xb = xcd_barrier_post((unsigned*)(p.ws + O_BAR), xst);
  const int G = gridDim.x, wg = blockIdx.x, NW = G * 8, GT = G * 512;
  const float* x = p.in[0];

  if constexpr ((MASK >> 0) & 1) {
  int tid = threadIdx.x; asm volatile("" : "+v"(tid)); const int lane = tid & 63, wid = tid >> 6, gw = wg * 8 + wid, gtid = wg * 512 + tid; (void)lane; (void)gw; (void)gtid;
  {
    for (int e = wg; e < 256; e += G) {
      const int it = e < 64 ? (e >> 2) * 36 + 8 + (e & 3) : e < 192 ? 832 + (e - 64) : 960 + (e - 192);
      transpose_item(p, it, ldsf);
    }
    for (int row = gw * 4; row < T; row += NW * 4) rmsnorm_rows_bf16<4>(x + (size_t)row * 1024, p.in[2], (bf16_t*)W0 + (size_t)row * 1024, lane);
    for (int row = gw; row < 512; row += NW) rmsnorm_row_bf16(p.in[1] + (size_t)row * 1024, p.in[23], (bf16_t*)memN + (size_t)row * 1024, lane);
    for (int w = gw; w < 2048; w += NW) {
      const int which = w >> 10, i = w & 1023, h = i >> 8, ii = i & 255;
      float a[8];
#pragma unroll
      for (int j = 0; j < 8; ++j) a[j] = 0.f;
      const float* wif = p.in[19];
#pragma unroll
      for (int jj = 0; jj < 4; ++jj) { const int o = lane + 64 * jj;
        if (which == 0) {
          const float wq = p.in[14][(size_t)h * 65536 + ii * 256 + o], wk = p.in[15][(size_t)h * 65536 + ii * 256 + o];
          const f32x4 q0 = *(const f32x4*)(wif + (size_t)(h * 256 + o) * 8), q1 = *(const f32x4*)(wif + (size_t)(h * 256 + o) * 8 + 4);
          const f32x4 k0 = *(const f32x4*)(wif + (size_t)(1024 + h * 256 + o) * 8), k1 = *(const f32x4*)(wif + (size_t)(1024 + h * 256 + o) * 8 + 4);
          a[0] += wq * q0.x + wk * k0.x; a[1] += wq * q0.y + wk * k0.y; a[2] += wq * q0.z + wk * k0.z; a[3] += wq * q0.w + wk * k0.w;
          a[4] += wq * q1.x + wk * k1.x; a[5] += wq * q1.y + wk * k1.y; a[6] += wq * q1.z + wk * k1.z; a[7] += wq * q1.w + wk * k1.w;
        } else {
          const float wv = p.in[16][(size_t)h * 65536 + ii * 256 + o];
          const f32x4 v0 = *(const f32x4*)(wif + (size_t)(2048 + h * 256 + o) * 8), v1 = *(const f32x4*)(wif + (size_t)(2048 + h * 256 + o) * 8 + 4);
          a[0] += wv * v0.x; a[1] += wv * v0.y; a[2] += wv * v0.z; a[3] += wv * v0.w; a[4] += wv * v1.x; a[5] += wv * v1.y; a[6] += wv * v1.z; a[7] += wv * v1.w;
        } }
#pragma unroll
      for (int j = 0; j < 8; ++j) a[j] = wave_sum(a[j]);
      if (lane == 0) { bf16_t* d = (bf16_t*)(p.ws + O_WGT) + which * 1024 + i;
#pragma unroll
        for (int j = 0; j < 8; ++j) { d[(size_t)j * 2048] = (bf16_t)(pk2(a[j], 0.f) & 0xffffu); d[(size_t)(8 + j) * 2048] = 0; } }
    }
    for (int n = gtid; n < 9216; n += GT) binR[RmWin()((int)n)] = p.in[4][n];
  }
  }
  if constexpr (MASK == ALLPH) xcd_barrier(xb);

  if constexpr ((MASK >> 1) & 1) {
  int tid = threadIdx.x; asm volatile("" : "+v"(tid)); const int lane = tid & 63, wid = tid >> 6, gw = wg * 8 + wid, gtid = wg * 512 + tid; (void)lane; (void)gw; (void)gtid;
  {
    SchedTiles S; S.A = W0; S.Bt = WinT; S.out0 = W1; S.out1 = W1; S.bias = binR; S.nN = 4; S.G = G; S.c = wg;
    EpiBf16 E; E.m_Av = Av; E.m_Mt = Mt;
    gemm_phase<SchedTiles, EpiBf16, false>(lds, 1024, 1024, 16, 16, S, E);
  }
  }
  if constexpr (MASK == ALLPH) xcd_barrier(xb);

  if constexpr ((MASK >> 2) & 1) {
  int tid = threadIdx.x; asm volatile("" : "+v"(tid)); const int lane = tid & 63, wid = tid >> 6, gw = wg * 8 + wid, gtid = wg * 512 + tid; (void)lane; (void)gw; (void)gtid;
  {
    const int pm = wg >> 2, h = wg & 3, tok0 = pm * 256;
    conv_item<true>((const bf16_t*)W1, (bf16_t*)W2, p.in[12], p.in[13], h * 256 + (tid & 31) * 8, tok0 + (tid >> 5) * 16);
    asm volatile("s_waitcnt vmcnt(0)" ::: "memory"); __syncthreads();
    EpiBf16 E; E.m_Av = Av; E.m_Mt = Mt;
    SchedP3X SX; SX.xc = W2; SX.mx = W1; SX.wq = WqT; SX.wk = WkT; SX.wo = WoT; SX.q = W3; SX.k = W4; SX.og = W5; SX.b_o = p.in[18]; SX.G = G; SX.c = wg;
    gemm_phase<SchedP3X, EpiBf16, false>(lds, 1024, 256, 4, 4, SX, E);
    gates_tile((const bf16_t*)W2, (const bf16_t*)W1, (const bf16_t*)(p.ws + O_WGT), gates, tok0, h, wid, lane);
  }
  }
  if constexpr (MASK == ALLPH) xcd_barrier(xb);

  if constexpr ((MASK >> 3) & 1) {
  int tid = threadIdx.x; asm volatile("" : "+v"(tid)); const int lane = tid & 63, wid = tid >> 6, gw = wg * 8 + wid, gtid = wg * 512 + tid; (void)lane; (void)gw; (void)gtid;
  }


  if constexpr ((MASK >> 4) & 1) {
  int tid = threadIdx.x; asm volatile("" : "+v"(tid)); const int lane = tid & 63, wid = tid >> 6, gw = wg * 8 + wid, gtid = wg * 512 + tid; (void)lane; (void)gw; (void)gtid;
  if (wg < 8) {
    const int b = wg >> 2, h = wg & 3;
    const size_t t0 = (size_t)b * SEQ + (size_t)tid * 16;
    float c[16], ig[16];
    float run = 0.f;
    { const float bi = p.in[20][h], bf = p.in[20][4 + h];
      const float* gi = gates + (size_t)h * T + t0; const float* gf = gates + (size_t)(4 + h) * T + t0;
#pragma unroll
      for (int k4 = 0; k4 < 4; ++k4) {
        f32x4 a = *(const f32x4*)(gi + 4 * k4), f = *(const f32x4*)(gf + 4 * k4);
#pragma unroll
        for (int hh = 1; hh < 4; ++hh) { a = a + *(const f32x4*)(gi + (size_t)hh * 8 * T + 4 * k4); f = f + *(const f32x4*)(gf + (size_t)hh * 8 * T + 4 * k4); }
#pragma unroll
        for (int e = 0; e < 4; ++e) { ig[4 * k4 + e] = a[e] + bi; run += logsigm(f[e] + bf); c[4 * k4 + e] = run; } } }
    const float off = block_excl_scan<false>(run, xT);
    float pmx = -3.0e38f;
#pragma unroll
    for (int k = 0; k < 16; ++k) { c[k] += off; ig[k] = ig[k] - c[k]; pmx = fmaxf(pmx, ig[k]); }
    const float offm = block_excl_scan<true>(pmx, xT);
    float rm = offm;
#pragma unroll
    for (int k = 0; k < 16; ++k) { rm = fmaxf(rm, ig[k]); const float mtv = fmaxf(rm, 0.f); Bc[(t0 + k) * 4 + h] = c[k] + mtv;   Av[(t0 + k) * 4 + h] = ig[k]; Mt[(t0 + k) * 4 + h] = mtv; }
  } else if (wg < 24) {
    const int idx = wg - 8; SchedOne S; S.has = true;
    if (idx < 8) { const int pm = idx >> 2, pn = idx & 3;
      S.u.A0 = S.u.A1 = memN + (size_t)pm * 256 * 1024 * 2; S.u.B0 = S.u.B1 = WkvT + (size_t)pn * 256 * 1024 * 2; S.u.out = Kmem + ((size_t)pm * 256 * 1024 + pn * 256) * 2; S.u.ldc = 1024; }
    else { const int pm = (idx - 8) >> 1, b = (idx - 8) & 1;
      S.u.A0 = S.u.A1 = WkvT + (size_t)(1024 + pm * 256) * 1024 * 2; S.u.B0 = S.u.B1 = memN + (size_t)b * 256 * 1024 * 2; S.u.out = VmemT + (size_t)(b * 1024 + pm * 256) * 256 * 2; S.u.ldc = 256; }
    S.u.bias = nullptr; S.u.sub = 0; S.u.row0 = 0; S.u.col0 = 0; S.u.aux0 = 0; S.u.aux1 = 0;
    EpiBf16 E; E.m_Av = Av; E.m_Mt = Mt;
    gemm_phase<SchedOne, EpiBf16, false>(lds, 1024, 1024, 16, 16, S, E);
  } else {
    for (int l = wg - 24; l < 800; l += G - 24) {
      int it;
      if (l < 512) { const int j = l & 31; it = (l >> 5) * 36 + (j < 8 ? j : j + 4); }
      else if (l < 704) it = 576 + (l - 512); else if (l < 768) it = 768 + (l - 704); else it = 1024 + (l - 768);
      transpose_item(p, it, ldsf);
    }
    EpiBf16 E; E.m_Av = Av; E.m_Mt = Mt;
    SchedP3Y SY; SY.xc = W2; SY.mx = W1; SY.wk = WkT; SY.wv = WvT; SY.vt = D0; SY.ktw = D1; SY.G = G - 24; SY.c = wg - 24; SY.base = 0; SY.count = 256;
    gemm_phase<SchedP3Y, EpiBf16, false>(lds, 256, 1024, 4, 4, SY, E);
  }
  }
  if constexpr (MASK == ALLPH) xcd_barrier(xb);

  if constexpr ((MASK >> 5) & 1) {
  int tid = threadIdx.x; asm volatile("" : "+v"(tid)); const int lane = tid & 63, wid = tid >> 6, gw = wg * 8 + wid, gtid = wg * 512 + tid; (void)lane; (void)gw; (void)gtid;
  { EpiBf16 E; E.m_Av = Av; E.m_Mt = Mt;
    SchedP3Y SY; SY.xc = W2; SY.mx = W1; SY.wk = WkT; SY.wv = WvT; SY.vt = D0; SY.ktw = D1; SY.G = G; SY.c = wg; SY.base = 256; SY.count = 256;
    gemm_phase<SchedP3Y, EpiBf16, false>(lds, 256, 1024, 4, 4, SY, E);
    asm volatile("s_waitcnt vmcnt(0)" ::: "memory"); __syncthreads(); }
  if (wg < 256) { const int unit = wg;
    const int bh = unit >> 5, ci = unit & 31, b = bh >> 2, h = bh & 3, tok0 = b * SEQ + ci * 256;
    { SchedOne S; S.has = true; S.u.A0 = S.u.A1 = D0 + (size_t)unit * 131072; S.u.B0 = S.u.B1 = D1 + (size_t)unit * 131072; S.u.out = W1 + (size_t)unit * 131072; S.u.bias = nullptr; S.u.ldc = 256; S.u.sub = 0;
      S.u.row0 = tok0; S.u.col0 = 0; S.u.aux0 = h; S.u.aux1 = unit;
      EpiBf16 E; E.m_Av = Av; E.m_Mt = Mt;
      gemm_phase<SchedOne, EpiBf16, false>(lds, 256, 256, 4, 4, S, E); }
    { SchedOne S; S.has = true; const size_t to = ((size_t)tok0 * 1024 + h * 256) * 2;
      S.u.A0 = S.u.A1 = W3 + to; S.u.B0 = S.u.B1 = W4 + to; S.u.out = W0 + to; S.u.bias = nullptr; S.u.ldc = 1024; S.u.sub = 0; S.u.row0 = tok0; S.u.col0 = 0; S.u.aux0 = h; S.u.aux1 = unit;
      EpiU1 E; E.m_Av = Av; E.m_Mt = Mt; E.m_denp = denp;
      gemm_phase<SchedOne, EpiU1, false>(lds, 1024, 1024, 4, 4, S, E); }
    { const float mprev = ci == 0 ? 0.f : Mt[(size_t)(tok0 - 1) * 4 + h];
      const int r = tid >> 1, hf = tid & 1;
      const float sc = __expf(mprev - Mt[(size_t)(tok0 + r) * 4 + h]);
      u32x4* qp = (u32x4*)((bf16_t*)W3 + (size_t)(tok0 + r) * 1024 + h * 256 + hf * 128);
      u32x4 v[16];
#pragma unroll
      for (int i = 0; i < 16; ++i) v[i] = qp[i];
#pragma unroll
      for (int i = 0; i < 16; ++i) { u32x4 o;
        o.x = pk2(bf_lo(v[i].x) * sc, bf_hi(v[i].x) * sc); o.y = pk2(bf_lo(v[i].y) * sc, bf_hi(v[i].y) * sc); o.z = pk2(bf_lo(v[i].z) * sc, bf_hi(v[i].z) * sc); o.w = pk2(bf_lo(v[i].w) * sc, bf_hi(v[i].w) * sc); qp[i] = o; } }
    { const float me = Mt[(size_t)(tok0 + 255) * 4 + h];
      if (tid < 256) xW[tid] = __expf(Av[(size_t)(tok0 + tid) * 4 + h] - me);
      __syncthreads();
      const int cg8 = tid & 31, sg = tid >> 5;
      const bf16_t* kp = (const bf16_t*)W4 + (size_t)(tok0 + sg * 16) * 1024 + h * 256 + cg8 * 8;
      u32x4 v[16];
#pragma unroll
      for (int i = 0; i < 16; ++i) v[i] = *(const u32x4*)(kp + (size_t)i * 1024);
      float a[8];
#pragma unroll
      for (int j = 0; j < 8; ++j) a[j] = 0.f;
#pragma unroll
      for (int i = 0; i < 16; ++i) { const float w = xW[sg * 16 + i];
        a[0] += w * bf_lo(v[i].x); a[1] += w * bf_hi(v[i].x); a[2] += w * bf_lo(v[i].y); a[3] += w * bf_hi(v[i].y); a[4] += w * bf_lo(v[i].z); a[5] += w * bf_hi(v[i].z); a[6] += w * bf_lo(v[i].w); a[7] += w * bf_hi(v[i].w); }
#pragma unroll
      for (int j = 0; j < 8; ++j) ldsf[sg * 256 + cg8 * 8 + j] = a[j];
      __syncthreads();
      if (tid < 256) { float s = 0.f;
#pragma unroll
        for (int g2 = 0; g2 < 16; ++g2) s += ldsf[g2 * 256 + tid];
        nkloc[(size_t)unit * 256 + tid] = s; }
      __syncthreads(); }
  }
  }
  if constexpr (MASK == ALLPH) xcd_barrier(xb);

  if constexpr ((MASK >> 6) & 1) {
  int tid = threadIdx.x; asm volatile("" : "+v"(tid)); const int lane = tid & 63, wid = tid >> 6, gw = wg * 8 + wid, gtid = wg * 512 + tid; (void)lane; (void)gw; (void)gtid;
  {
    for (int g = gtid; g < 131072; g += GT) {
      const int bh = (int)(g >> 14), e4 = (int)(g & 16383), b = bh >> 2, h = bh & 3;
      u32x2* base = (u32x2*)((bf16_t*)W1 + (size_t)bh * 32 * 65536 + (size_t)e4 * 4);
      u32x2 kv[32]; float me[32];
#pragma unroll
      for (int c = 0; c < 32; ++c) { kv[c] = base[(size_t)c * 16384]; me[c] = Mt[(size_t)(b * SEQ + c * 256 + 255) * 4 + h]; }
      float C0 = 0.f, C1 = 0.f, C2 = 0.f, C3 = 0.f; float mprev = 0.f;
#pragma unroll
      for (int c = 0; c < 32; ++c) {
        const float dec = __expf(mprev - me[c]); mprev = me[c];
        u32x2 w; w.x = pk2(C0, C1); w.y = pk2(C2, C3); base[(size_t)c * 16384] = w;
        C0 = dec * C0 + bf_lo(kv[c].x); C1 = dec * C1 + bf_hi(kv[c].x); C2 = dec * C2 + bf_lo(kv[c].y); C3 = dec * C3 + bf_hi(kv[c].y);
      }
    }
    for (int g = gtid; g < 2048; g += GT) {
      const int bh = (int)(g >> 8), col = (int)(g & 255), b = bh >> 2, h = bh & 3;
      float nk[32], me[32];
#pragma unroll
      for (int c = 0; c < 32; ++c) { nk[c] = nkloc[(size_t)(bh * 32 + c) * 256 + col]; me[c] = Mt[(size_t)(b * SEQ + c * 256 + 255) * 4 + h]; }
      float n = 0.f, mprev = 0.f;
#pragma unroll
      for (int c = 0; c < 32; ++c) { const float dec = __expf(mprev - me[c]); mprev = me[c]; nprev[(size_t)(bh * 32 + c) * 256 + col] = n; n = dec * n + nk[c]; }
    }
    for (int row = gw * 4; row < T; row += NW * 4) rmsnorm_rows_bf16<4>(x + (size_t)row * 1024, p.in[2], (bf16_t*)W4 + (size_t)row * 1024, lane);
  }
  }
  if constexpr (MASK == ALLPH) xcd_barrier(xb);

  if constexpr ((MASK >> 7) & 1) {
  int tid = threadIdx.x; asm volatile("" : "+v"(tid)); const int lane = tid & 63, wid = tid >> 6, gw = wg * 8 + wid, gtid = wg * 512 + tid; (void)lane; (void)gw; (void)gtid;
  if (wg < 256) { const int unit = wg;
    const int bh = unit >> 5, ci = unit & 31, b = bh >> 2, h = bh & 3, tok0 = b * SEQ + ci * 256;
    { if (tid < 256) xW[tid] = nprev[(size_t)unit * 256 + tid];
      __syncthreads();
      const int r = tid >> 1, hf = tid & 1;
      const u32x4* qp = (const u32x4*)((const bf16_t*)W3 + (size_t)(tok0 + r) * 1024 + h * 256 + hf * 128);
      u32x4 v[16];
#pragma unroll
      for (int i = 0; i < 16; ++i) v[i] = qp[i];
      float s = 0.f;
#pragma unroll
      for (int i = 0; i < 16; ++i) { const LAS float* nv = xW + hf * 128 + i * 8;
        const f32x4 n0 = *(const LAS f32x4*)nv, n1 = *(const LAS f32x4*)(nv + 4);
        s += bf_lo(v[i].x) * n0.x + bf_hi(v[i].x) * n0.y + bf_lo(v[i].y) * n0.z + bf_hi(v[i].y) * n0.w + bf_lo(v[i].z) * n1.x + bf_hi(v[i].z) * n1.y + bf_lo(v[i].w) * n1.z + bf_hi(v[i].w) * n1.w; }
      s += __shfl_xor(s, 1);
      if (hf == 0) xD[r] = s;
      __syncthreads(); }
    SchedOne S; S.has = true; const size_t to = ((size_t)tok0 * 1024 + h * 256) * 2;
    S.u.A0 = W0 + to; S.u.A1 = W3 + to; S.u.B0 = D0 + (size_t)unit * 131072; S.u.B1 = W1 + (size_t)unit * 131072;
    S.u.out = nullptr; S.u.bias = nullptr; S.u.ldc = 1024; S.u.sub = 0; S.u.row0 = tok0; S.u.col0 = 0; S.u.aux0 = h; S.u.aux1 = unit;
    EpiU2 E; E.P = xP; E.deni = xD; E.m_denp = denp; E.m_Bc = Bc; E.m_Mt = Mt; E.og = (const bf16_t*)W5; E.norm_g = p.in[21]; E.skip = p.in[22]; E.xc = (bf16_t*)W2;
    gemm_phase<SchedOne, EpiU2, true>(lds, 1024, 256, 8, 4, S, E);
    __syncthreads();
  }
  }
  if constexpr (MASK == ALLPH) xcd_barrier(xb);

  if constexpr ((MASK >> 8) & 1) {
  int tid = threadIdx.x; asm volatile("" : "+v"(tid)); const int lane = tid & 63, wid = tid >> 6, gw = wg * 8 + wid, gtid = wg * 512 + tid; (void)lane; (void)gw; (void)gtid;
  {
    SchedTiles S; S.A = W4; S.Bt = WinT + (size_t)1024 * 1024 * 2; S.out0 = W0; S.out1 = W1; S.bias = binR + 1024; S.nN = 8; S.G = G; S.c = wg;
    EpiBf16 E; E.m_Av = Av; E.m_Mt = Mt;
    gemm_phase<SchedTiles, EpiBf16, false>(lds, 1024, 1024, 16, 16, S, E);
  }
  }
  if constexpr (MASK == ALLPH) xcd_barrier(xb);

  if constexpr ((MASK >> 9) & 1) {
  int tid = threadIdx.x; asm volatile("" : "+v"(tid)); const int lane = tid & 63, wid = tid >> 6, gw = wg * 8 + wid, gtid = wg * 512 + tid; (void)lane; (void)gw; (void)gtid;
  {
    conv_stream<false>((const bf16_t*)W0, (bf16_t*)W3, p.in[5], p.in[6], gtid, GT);
    if (wg < 256) { const int L = wg;
      const int pm = L >> 2, h = L & 3, b = pm >> 5;
      { SchedOne S; S.has = true;
        S.u.A0 = S.u.A1 = W1 + ((size_t)pm * 256 * 1024 + h * 256) * 2; S.u.B0 = S.u.B1 = Kmem + ((size_t)b * 256 * 1024 + h * 256) * 2; S.u.out = W5 + (size_t)L * 131072; S.u.bias = nullptr; S.u.ldc = 256; S.u.sub = 0;
        S.u.row0 = 0; S.u.col0 = 0; S.u.aux0 = 0; S.u.aux1 = 0;
        EpiSoftmax E; E.P = xP;
        gemm_phase<SchedOne, EpiSoftmax, true>(lds, 1024, 1024, 4, 4, S, E); }
      asm volatile("s_waitcnt vmcnt(0)" ::: "memory"); __syncthreads();
      { SchedOne S; S.has = true;
        S.u.A0 = S.u.A1 = W5 + (size_t)L * 131072; S.u.B0 = S.u.B1 = VmemT + (size_t)(b * 1024 + h * 256) * 256 * 2; S.u.out = D0 + ((size_t)pm * 256 * 1024 + h * 256) * 2; S.u.bias = nullptr; S.u.ldc = 1024; S.u.sub = 0;
        S.u.row0 = 0; S.u.col0 = 0; S.u.aux0 = 0; S.u.aux1 = 0;
        EpiBf16 E; E.m_Av = Av; E.m_Mt = Mt;
        gemm_phase<SchedOne, EpiBf16, false>(lds, 256, 256, 4, 4, S, E); }
      __syncthreads();
    }
  }
  }
  if constexpr (MASK == ALLPH) xcd_barrier(xb);

  if constexpr ((MASK >> 10) & 1) {
  int tid = threadIdx.x; asm volatile("" : "+v"(tid)); const int lane = tid & 63, wid = tid >> 6, gw = wg * 8 + wid, gtid = wg * 512 + tid; (void)lane; (void)gw; (void)gtid;
  {
    SchedLru S; S.u_ = W3; S.wl = WlruT; S.G = G; S.c = wg;
    EpiLru E; E.b_a = p.in[8]; E.b_x = p.in[10]; E.lam = p.in[11]; E.u = (const bf16_t*)W3; E.loga = (bf16_t*)W0; E.bb = (bf16_t*)W1;
    gemm_phase<SchedLru, EpiLru, false>(lds, 1024, 256, 4, 4, S, E);
    asm volatile("s_waitcnt vmcnt(0)" ::: "memory"); __syncthreads();
#pragma unroll 1
    for (int i = 0; i < 2; ++i) { const int L = i * G + wg; if (L < 512) {
      const int pm = (L & 7) * 8 + (L >> 6), pn = (L >> 3) & 7;
      const int ch = (pn >> 1) * 256 + (pn & 1) * 128 + (tid & 127), j = pm * 4 + (tid >> 7);
      const bf16_t* la = (const bf16_t*)W0 + (size_t)j * 64 * 1024 + ch; const bf16_t* bp = (const bf16_t*)W1 + (size_t)j * 64 * 1024 + ch;
      float h = 0.f, s = 0.f;
#pragma unroll 16
      for (int t = 0; t < 64; ++t) { const float l = bf2f(la[(size_t)t * 1024]); h = __expf(l) * h + bf2f(bp[(size_t)t * 1024]); s += l; }
      hend[(size_t)j * 1024 + ch] = h; slog[(size_t)j * 1024 + ch] = s; } }
  }
  }
  if constexpr (MASK == ALLPH) xcd_barrier(xb);

  if constexpr ((MASK >> 11) & 1) {
  int tid = threadIdx.x; asm volatile("" : "+v"(tid)); const int lane = tid & 63, wid = tid >> 6, gw = wg * 8 + wid, gtid = wg * 512 + tid; (void)lane; (void)gw; (void)gtid;
  }

  if constexpr ((MASK >> 12) & 1) {
  int tid = threadIdx.x; asm volatile("" : "+v"(tid)); const int lane = tid & 63, wid = tid >> 6, gw = wg * 8 + wid, gtid = wg * 512 + tid; (void)lane; (void)gw; (void)gtid;
  }

  if constexpr ((MASK >> 13) & 1) {
  int tid = threadIdx.x; asm volatile("" : "+v"(tid)); const int lane = tid & 63, wid = tid >> 6, gw = wg * 8 + wid, gtid = wg * 512 + tid; (void)lane; (void)gw; (void)gtid;
  for (int g = gtid; g < 131072; g += GT) {
    const int cp = (int)(g & 511), j = (int)(g >> 9);
    const unsigned* la = (const unsigned*)((const bf16_t*)W0 + (size_t)j * 64 * 1024 + cp * 2);
    const unsigned* bp = (const unsigned*)((const bf16_t*)W1 + (size_t)j * 64 * 1024 + cp * 2);
    unsigned* yo = (unsigned*)((bf16_t*)W3 + (size_t)j * 64 * 1024 + cp * 2);
    float h0 = 0.f, h1 = 0.f;
    { const int jb = (j >> 7) * 128, jl = j & 127;
#pragma unroll 8
      for (int jj = 0; jj < jl; ++jj) { const size_t o = (size_t)(jb + jj) * 1024 + cp * 2;
        const float sx = slog[o], sy = slog[o + 1], ex = hend[o], ey = hend[o + 1];
        h0 = __expf(sx) * h0 + ex; h1 = __expf(sy) * h1 + ey; } }
#pragma unroll 1
    for (int tb = 0; tb < 64; tb += 16) {
      unsigned av[16], bw[16];
#pragma unroll
      for (int t = 0; t < 16; ++t) { av[t] = la[(size_t)(tb + t) * 512]; bw[t] = bp[(size_t)(tb + t) * 512]; }
#pragma unroll
      for (int t = 0; t < 16; ++t) { h0 = __expf(bf_lo(av[t])) * h0 + bf_lo(bw[t]); h1 = __expf(bf_hi(av[t])) * h1 + bf_hi(bw[t]); yo[(size_t)(tb + t) * 512] = pk2(h0, h1); }
    }
  }
  }
  if constexpr (MASK == ALLPH) xcd_barrier(xb);

  if constexpr ((MASK >> 14) & 1) {
  int tid = threadIdx.x; asm volatile("" : "+v"(tid)); const int lane = tid & 63, wid = tid >> 6, gw = wg * 8 + wid, gtid = wg * 512 + tid; (void)lane; (void)gw; (void)gtid;
  {
    SchedZ S; S.hn = W4; S.wint = WinT; S.y0 = W3; S.y1 = W2; S.y2 = D0; S.binr = binR; S.G = G; S.c = wg;
    EpiZ E;
    gemm_phase<SchedZ, EpiZ, false>(lds, 1024, 1024, 16, 16, S, E);
  }
  }
  if constexpr (MASK == ALLPH) xcd_barrier(xb);

  if constexpr ((MASK >> 15) & 1) {
  int tid = threadIdx.x; asm volatile("" : "+v"(tid)); const int lane = tid & 63, wid = tid >> 6, gw = wg * 8 + wid, gtid = wg * 512 + tid; (void)lane; (void)gw; (void)gtid;
  {
    SchedMerge S; S.hn = W4; S.wint = WinT; S.wbt = WbT; S.y0 = W3; S.y1 = W2; S.y2 = D0; S.binr = binR; S.G = G; S.c = wg;
    EpiMerge E; E.gsc = (bf16_t*)D1; E.macc = (float*)W0; E.merged = (bf16_t*)W5;
    gemm_phase<SchedMerge, EpiMerge, false>(lds, 1024, 1024, 16, 16, S, E);
  }
  }
  if constexpr (MASK == ALLPH) xcd_barrier(xb);

  if constexpr ((MASK >> 16) & 1) {
  int tid = threadIdx.x; asm volatile("" : "+v"(tid)); const int lane = tid & 63, wid = tid >> 6, gw = wg * 8 + wid, gtid = wg * 512 + tid; (void)lane; (void)gw; (void)gtid;
  {
    int pm, pn; SchedOne S; S.has = static_tile((long)wg, 64, 4, pm, pn);
    S.u.A0 = S.u.A1 = W5 + (size_t)pm * 256 * 1024 * 2; S.u.B0 = S.u.B1 = WoutT + (size_t)pn * 256 * 1024 * 2; S.u.out = nullptr; S.u.bias = nullptr; S.u.ldc = 1024; S.u.sub = 0;
    S.u.row0 = pm * 256; S.u.col0 = pn * 256; S.u.aux0 = pm; S.u.aux1 = pn;
    EpiOutNorm E; E.x = x; E.out = p.out; E.g = p.in[27]; E.P = xP; E.xch = (float*)(p.ws + O_XCH); E.cnt = (unsigned*)(p.ws + O_CNT);
    gemm_phase<SchedOne, EpiOutNorm, true>(lds, 1024, 1024, 16, 16, S, E);
  }
  }


  if constexpr ((MASK >> 17) & 1) {
  int tid = threadIdx.x; asm volatile("" : "+v"(tid)); const int lane = tid & 63, wid = tid >> 6, gw = wg * 8 + wid, gtid = wg * 512 + tid; (void)lane; (void)gw; (void)gtid;
  }
}

#ifndef MK_SINGLE
#define MK_SINGLE 1
#endif
template <unsigned MASK>
static void launch_phase(const Params& p, int grid, size_t lds, hipStream_t stream) {
  static bool attr = false;
  if (!attr) { (void)hipFuncSetAttribute((const void*)mk_fwd<MASK>, hipFuncAttributeMaxDynamicSharedMemorySize, (int)lds); attr = true; }
  hipLaunchKernelGGL(mk_fwd<MASK>, dim3(grid), dim3(512), lds, stream, p);
}
extern "C" void kernel_launch(void* const* d_in, const int* in_sizes, int n_in, void* d_out, int out_size, void* d_ws, size_t ws_size, hipStream_t stream) {
  constexpr size_t kDynLds = STAGE_BYTES + 16384;
  static int grid_blocks = 0;
  if (!grid_blocks) {
    int dev = 0, cus = 0, per_cu = 0;
    (void)hipGetDevice(&dev);
    (void)hipDeviceGetAttribute(&cus, hipDeviceAttributeMultiprocessorCount, dev);
#if MK_SINGLE
    (void)hipFuncSetAttribute((const void*)mk_fwd<ALLPH>, hipFuncAttributeMaxDynamicSharedMemorySize, (int)kDynLds);
    (void)hipOccupancyMaxActiveBlocksPerMultiprocessor(&per_cu, (const void*)mk_fwd<ALLPH>, 512, kDynLds);
    if (per_cu < 1) fprintf(stderr, "occupancy query says %d blocks/CU\n", per_cu);
#endif
    if (ws_size < WS_NEED) fprintf(stderr, "workspace too small: %zu < %zu\n", ws_size, (size_t)WS_NEED);
    grid_blocks = 256; if (cus < 256) fprintf(stderr, "this kernel needs 256 CUs, device has %d\n", cus);
  }
  Params p{};
  for (int i = 0; i < 28; ++i) p.in[i] = (const float*)d_in[i];
  p.out = (float*)d_out; p.ws = (unsigned char*)d_ws;
#if MK_SINGLE
  (void)hipMemsetAsync((unsigned char*)d_ws + O_BAR, 0, 32768, stream);
  void* args[] = {&p};
  hipError_t e = hipLaunchCooperativeKernel((void*)mk_fwd<ALLPH>, dim3(grid_blocks), dim3(512), args, kDynLds, stream);
  if (e != hipSuccess) fprintf(stderr, "cooperative launch failed: %s (grid %d)\n", hipGetErrorString(e), grid_blocks);
#else
  const int g = grid_blocks;
  launch_phase<1u << 0>(p, g, kDynLds, stream); launch_phase<1u << 1>(p, g, kDynLds, stream); launch_phase<1u << 2>(p, g, kDynLds, stream); launch_phase<1u << 3>(p, g, kDynLds, stream);
  launch_phase<1u << 4>(p, g, kDynLds, stream); launch_phase<1u << 5>(p, g, kDynLds, stream); launch_phase<1u << 6>(p, g, kDynLds, stream); launch_phase<1u << 7>(p, g, kDynLds, stream);
  launch_phase<1u << 8>(p, g, kDynLds, stream); launch_phase<1u << 9>(p, g, kDynLds, stream); launch_phase<1u << 10>(p, g, kDynLds, stream); launch_phase<1u << 11>(p, g, kDynLds, stream);
  launch_phase<1u << 12>(p, g, kDynLds, stream); launch_phase<1u << 13>(p, g, kDynLds, stream); launch_phase<1u << 14>(p, g, kDynLds, stream); launch_phase<1u << 15>(p, g, kDynLds, stream);
  launch_phase<1u << 16>(p, g, kDynLds, stream); launch_phase<1u << 17>(p, g, kDynLds, stream);
#endif
}
```

```cpp
#include <hip/hip_runtime.h>
#include <hip/hip_cooperative_groups.h>
#include <cstdio>
namespace cg = cooperative_groups;

#define LAS __attribute__((address_space(3)))
typedef unsigned short bf16_t;
typedef short bf16x8 __attribute__((ext_vector_type(8)));
typedef float f32x4 __attribute__((ext_vector_type(4)));
typedef unsigned u32x4 __attribute__((ext_vector_type(4)));
typedef unsigned u32x2 __attribute__((ext_vector_type(2)));

constexpr int T = 16384, DM = 1024, SEQ = 8192;
constexpr size_t SLOT = (size_t)T * DM * 2;

constexpr size_t O_WINT = 0;
constexpr size_t O_WBT = O_WINT + (size_t)9216 * 1024 * 2;
constexpr size_t O_WOUTT = O_WBT + (size_t)3 * 1024 * 1024 * 2;
constexpr size_t O_WKVT = O_WOUTT + (size_t)1024 * 1024 * 2;
constexpr size_t O_WQT = O_WKVT + (size_t)2048 * 1024 * 2;
constexpr size_t O_WKT = O_WQT + 524288;
constexpr size_t O_WVT = O_WKT + 524288;
constexpr size_t O_WOT = O_WVT + 524288;
constexpr size_t O_WLRUT = O_WOT + 524288;
constexpr size_t O_BINR = O_WLRUT + 1048576;
constexpr size_t O_WXC = O_BINR + 36864;
constexpr size_t O_WXM = O_WXC + 32768;
constexpr size_t O_GATES = O_WXM + 32768;
constexpr size_t O_BC = O_GATES + (size_t)T * 32 * 4;
constexpr size_t O_AV = O_BC + (size_t)T * 4 * 4;
constexpr size_t O_MT = O_AV + (size_t)T * 4 * 4;
constexpr size_t O_DENP = O_MT + (size_t)T * 4 * 4;
constexpr size_t O_NKLOC = O_DENP + 1048576;
constexpr size_t O_NPREV = O_NKLOC + 262144;
constexpr size_t O_KMEM = O_NPREV + 262144;
constexpr size_t O_VMEMT = O_KMEM + 1048576;
constexpr size_t O_MEMN = O_VMEMT + 1048576;
constexpr size_t O_HEND = O_MEMN + 1048576;
constexpr size_t O_SLOG = O_HEND + 1048576;
constexpr size_t O_CARRY = O_SLOG + 1048576;
constexpr size_t O_BAR = O_CARRY + 1048576;
constexpr size_t O_CNT = O_BAR + 16384;
constexpr size_t O_XCH = O_CNT + 16384;
constexpr size_t O_WGT = O_XCH + 262144;
constexpr size_t O_SMALL_END = O_WGT + 65536;
constexpr size_t O_SLOTS = (size_t)46 * 1024 * 1024;
static_assert(O_SMALL_END <= O_SLOTS, "small region overflow");
constexpr size_t WS_NEED = O_SLOTS + 6 * SLOT;

struct Params { const float* in[28]; float* out; unsigned char* ws; };

__device__ __forceinline__ unsigned pk2(float lo, float hi) { unsigned r; asm volatile("v_cvt_pk_bf16_f32 %0, %1, %2" : "=v"(r) : "v"(lo), "v"(hi)); return r; }
__device__ __forceinline__ float bf_lo(unsigned w) { return __uint_as_float(w << 16); }
__device__ __forceinline__ float bf_hi(unsigned w) { return __uint_as_float(w & 0xffff0000u); }
__device__ __forceinline__ float bf2f(bf16_t b) { return __uint_as_float(((unsigned)b) << 16); }
__device__ __forceinline__ float sigm(float x) { return 1.0f / (1.0f + __expf(-x)); }
__device__ __forceinline__ float sigmf(float x) { return __builtin_amdgcn_rcpf(1.0f + __expf(-x)); }
__device__ __forceinline__ float logsigm(float x) { return fminf(x, 0.f) - log1pf(expf(-fabsf(x))); }
__device__ __forceinline__ float wave_sum(float v) {
#pragma unroll
  for (int o = 1; o < 64; o <<= 1) v += __shfl_xor(v, o);
  return v;
}

constexpr int BM = 256, BK = 64, HALF = 128, HTB = HALF * BK * 2, STAGE_BYTES = 8 * HTB;
__device__ __forceinline__ int lds_byte(int r, int c) { const int st = (r >> 4) * 2 + (c >> 5), rr = r & 15, cc = c & 31, ob = rr * 64 + cc * 2; return st * 1024 + (ob ^ (((ob >> 9) & 1) << 5)); }
__device__ __forceinline__ void stage_rc(int b, int& R, int& C) { const int st = b / 1024, sb = b % 1024, swz = sb ^ (((sb >> 9) & 1) << 5); R = (st >> 1) * 16 + swz / 64; C = (st & 1) * 32 + (swz % 64) / 2; }

__device__ __forceinline__ int perm32(int rho) { const int n = rho >> 4, i = rho & 15; return 8 * (i >> 2) + 4 * n + (i & 3); }
struct UnitD { const char* A0; const char* A1; const char* B0; const char* B1; char* out; const float* bias; int ldc, sub, row0, col0, aux0, aux1; };

__device__ __forceinline__ bool static_tile(long L, int nM, int nN, int& pm, int& pn) {
  const int nwg = nM * nN; if (L >= nwg) return false;
  int wgid = (int)L; { const int q = nwg / 8, r = nwg % 8, xcd = wgid % 8, off = wgid / 8; wgid = (xcd < r ? xcd * (q + 1) : r * (q + 1) + (xcd - r) * q) + off; }
  const int nig = 8 * nN, gid = wgid / nig, fm = gid * 8, gsz = (nM - fm) < 8 ? (nM - fm) : 8;
  pm = fm + ((wgid % nig) % gsz); pn = (wgid % nig) / gsz; return true;
}

#define ROWOF(ai, m) (128 * (ai) + 64 * wr + 16 * (m) + fr)
#define COLOF(bj, n) (128 * (bj) + 32 * wc + 8 * fq + 4 * (n))
#define UNR _Pragma("unroll")

#ifndef GP_SP2
#define GP_SP2 0
#endif
#ifndef GP_ALIGN
#define GP_ALIGN 1
#endif
template <class Sched, class Epi, bool DRAIN>
__device__ __forceinline__ void gemm_phase(LAS unsigned char* lds, const int lda, const int ldb, const int nt, const int nt0, const Sched& S, const Epi& E) {
  int tid = threadIdx.x; asm volatile("" : "+v"(tid));
  const int wid = __builtin_amdgcn_readfirstlane(tid >> 6), lane = tid & 63, wr = wid >> 2, wc = wid & 3, fr = lane & 15, fq = lane >> 4;
  unsigned voffA, voffB;
  { int R, C; stage_rc(tid * 16, R, C); const int Rb = (R & ~31) + perm32(R & 31); voffA = (unsigned)(R * lda + C) * 2u; voffB = (unsigned)(Rb * ldb + C) * 2u; }
  const size_t qstepA = (size_t)64 * lda * 2, qstepB = (size_t)64 * ldb * 2;
  const size_t kstep = (size_t)(BK * 2);
  const size_t hstepA = (size_t)HALF * lda * 2, hstepB = (size_t)HALF * ldb * 2;
  const unsigned ldsw = (unsigned)wid * 1024u;
  const int aoff = lds_byte(wr * 64 + fr, fq * 8), boff = lds_byte(wc * 32 + fr, fq * 8);
#define G_SA(b, h) (((b) * 2 + (h)) * HTB)
#define G_SB(b, h) ((4 + (b) * 2 + (h)) * HTB)
#define qoffA qstepA
#define qoffB qstepB
#define voffA_ voffA
#define G_STAGE(bufoff, gbase, voff) do { _Pragma("unroll") for (int _i = 0; _i < 2; ++_i) \
    __builtin_amdgcn_global_load_lds((const unsigned*)((const char*)(gbase) + (size_t)_i * q##voff + v##voff), (LAS unsigned*)(lds + (bufoff) + ldsw + _i * 8192), 16, 0, 0); } while (0)
#define G_LDA(dst, b, h) do { _Pragma("unroll") for (int m = 0; m < 4; ++m) _Pragma("unroll") for (int k = 0; k < 2; ++k) dst[m][k] = *(const LAS bf16x8*)(lds + G_SA(b, h) + aoff + m * 2048 + k * 1024); } while (0)
#define G_LDB(dst, b, h) do { _Pragma("unroll") for (int n = 0; n < 2; ++n) _Pragma("unroll") for (int k = 0; k < 2; ++k) dst[n][k] = *(const LAS bf16x8*)(lds + G_SB(b, h) + boff + n * 2048 + k * 1024); } while (0)
#define G_MMA(ai, bj, At, Bt) do { __builtin_amdgcn_s_setprio(1); _Pragma("unroll") for (int m = 0; m < 4; ++m) _Pragma("unroll") for (int n = 0; n < 2; ++n) _Pragma("unroll") for (int k = 0; k < 2; ++k) \
    acc[ai][bj][m][n] = __builtin_amdgcn_mfma_f32_16x16x32_bf16(Bt[n][k], At[m][k], acc[ai][bj][m][n], 0, 0, 0); __builtin_amdgcn_s_setprio(0); } while (0)
#define G_WAIT_V(n) asm volatile("s_waitcnt vmcnt(" #n ")" ::: "memory")
#define G_WAIT_L(n) asm volatile("s_waitcnt lgkmcnt(" #n ")" ::: "memory")
#define G_BAR __builtin_amdgcn_s_barrier()
#define G_SCHED __builtin_amdgcn_sched_barrier(0)
  UnitD cur, nxt; int ui = 0;
  if (!S.next(0, cur)) return;
  f32x4 acc[2][2][4][2];
#pragma unroll
  for (int a = 0; a < 2; ++a)
#pragma unroll
    for (int b = 0; b < 2; ++b)
#pragma unroll
      for (int m = 0; m < 4; ++m)
#pragma unroll
        for (int n = 0; n < 2; ++n) acc[a][b][m][n] = (f32x4){0.f, 0.f, 0.f, 0.f};
  bf16x8 At[4][2], B0[2][2], B1[2][2];
  {
    const char* cA = cur.A0; const char* cB = cur.B0;
#if GP_SP2
    G_STAGE(G_SB(0, 0), cB, offB); G_STAGE(G_SB(0, 1), cB + hstepB, offB); G_STAGE(G_SA(0, 0), cA, offA); G_STAGE(G_SA(0, 1), cA + hstepA, offA);
    if (wr == 1) G_BAR;
    G_WAIT_V(2); G_BAR;
    G_STAGE(G_SB(1, 0), cB + kstep, offB); G_STAGE(G_SA(1, 0), cA + kstep, offA); G_STAGE(G_SB(1, 1), cB + hstepB + kstep, offB);
    G_WAIT_V(6); G_BAR;
#else
    G_STAGE(G_SB(0, 0), cB, offB); G_STAGE(G_SA(0, 0), cA, offA); G_STAGE(G_SB(0, 1), cB + hstepB, offB); G_STAGE(G_SA(0, 1), cA + hstepA, offA);
    if (wr == 1) G_BAR;
    G_WAIT_V(4); G_BAR;
    G_STAGE(G_SB(1, 0), cB + kstep, offB); G_STAGE(G_SA(1, 0), cA + kstep, offA); G_STAGE(G_SB(1, 1), cB + hstepB + kstep, offB);
    G_WAIT_V(6); G_BAR;
#endif
  }
  for (;;) {
    const bool has_next = S.next(ui + 1, nxt);
    const char* nA = has_next ? nxt.A0 : cur.A0; const char* nB = has_next ? nxt.B0 : cur.B0;
    for (int t = 0; t < nt; t += 2) {
      const bool last = (t == nt - 2);
      const char* a1 = (t + 1 < nt0) ? cur.A0 + (size_t)(t + 1) * kstep : cur.A1 + (size_t)(t + 1 - nt0) * kstep;
      const char* a2; const char* b2;
      if (last) { a2 = nA; b2 = nB; }
      else if (t + 2 < nt0) { a2 = cur.A0 + (size_t)(t + 2) * kstep; b2 = cur.B0 + (size_t)(t + 2) * kstep; }
      else { a2 = cur.A1 + (size_t)(t + 2 - nt0) * kstep; b2 = cur.B1 + (size_t)(t + 2 - nt0) * kstep; }
      const char* a3 = a2 + kstep; const char* b3 = b2 + kstep;
#if GP_SP2
      G_LDB(B0, 0, 0); G_LDB(B1, 0, 1); G_SCHED; G_LDA(At, 0, 0); G_STAGE(G_SA(1, 1), a1 + hstepA, offA);
      G_WAIT_V(8); G_WAIT_L(0); G_BAR; G_MMA(0, 0, At, B0); G_MMA(0, 1, At, B1); G_BAR; G_SCHED;
      G_LDA(At, 0, 1); G_STAGE(G_SB(0, 0), b2, offB); G_STAGE(G_SB(0, 1), b2 + hstepB, offB); G_STAGE(G_SA(0, 0), a2, offA);
      G_WAIT_V(8); G_WAIT_L(0); G_BAR; G_MMA(1, 0, At, B0); G_MMA(1, 1, At, B1); G_BAR; G_SCHED;
      G_LDB(B0, 1, 0); G_LDB(B1, 1, 1); G_SCHED; G_LDA(At, 1, 0); G_STAGE(G_SA(0, 1), a2 + hstepA, offA);
      G_WAIT_V(8); G_WAIT_L(0); G_BAR; G_MMA(0, 0, At, B0); G_MMA(0, 1, At, B1); G_BAR; G_SCHED;
      G_LDA(At, 1, 1); G_STAGE(G_SB(1, 0), b3, offB); G_STAGE(G_SB(1, 1), b3 + hstepB, offB); G_STAGE(G_SA(1, 0), a3, offA);
      G_WAIT_V(8); G_WAIT_L(0); G_BAR; G_MMA(1, 0, At, B0); G_MMA(1, 1, At, B1); G_BAR; G_SCHED;
#else
      G_LDB(B0, 0, 0); G_SCHED; G_LDA(At, 0, 0); G_STAGE(G_SA(1, 1), a1 + hstepA, offA);
      G_WAIT_L(8); G_BAR; G_WAIT_L(0); G_MMA(0, 0, At, B0); G_BAR; G_SCHED;
      G_LDB(B1, 0, 1); G_STAGE(G_SB(0, 0), b2, offB);
      G_BAR; G_WAIT_L(0); G_MMA(0, 1, At, B1); G_BAR;
      G_LDA(At, 0, 1); G_STAGE(G_SA(0, 0), a2, offA);
      G_BAR; G_WAIT_L(0); G_MMA(1, 0, At, B0); G_BAR; G_SCHED;
      G_STAGE(G_SB(0, 1), b2 + hstepB, offB);
      G_WAIT_V(6); G_BAR; G_MMA(1, 1, At, B1); G_BAR;
      G_LDB(B0, 1, 0); G_SCHED; G_LDA(At, 1, 0); G_STAGE(G_SA(0, 1), a2 + hstepA, offA);
      G_WAIT_L(8); G_BAR; G_WAIT_L(0); G_MMA(0, 0, At, B0); G_BAR; G_SCHED;
      G_LDB(B1, 1, 1); G_STAGE(G_SB(1, 0), b3, offB);
      G_BAR; G_WAIT_L(0); G_MMA(0, 1, At, B1); G_BAR;
      G_LDA(At, 1, 1); G_STAGE(G_SA(1, 0), a3, offA);
      G_BAR; G_WAIT_L(0); G_MMA(1, 0, At, B0); G_BAR; G_SCHED;
      G_STAGE(G_SB(1, 1), b3 + hstepB, offB);
      G_WAIT_V(6); G_BAR; G_MMA(1, 1, At, B1); G_BAR;
#endif
    }
#if GP_ALIGN
    if (wr == 0) G_BAR;
#endif
    if constexpr (!DRAIN) { int fr2 = fr, fq2 = fq; asm volatile("" : "+v"(fr2), "+v"(fq2)); E.run(acc, cur, wr, wc, fr2, fq2); }
    if (!has_next) break;
#pragma unroll
    for (int a = 0; a < 2; ++a)
#pragma unroll
      for (int b = 0; b < 2; ++b)
#pragma unroll
        for (int m = 0; m < 4; ++m)
#pragma unroll
          for (int n = 0; n < 2; ++n) acc[a][b][m][n] = (f32x4){0.f, 0.f, 0.f, 0.f};
    cur = nxt; ++ui;
#if GP_ALIGN
    if (wr == 1) G_BAR;
#endif
  }
  G_WAIT_V(0);
#if !GP_ALIGN
  if (wr == 0) G_BAR;
#endif
  G_BAR;
  if constexpr (DRAIN) { int fr2 = fr, fq2 = fq; asm volatile("" : "+v"(fr2), "+v"(fq2)); E.run(acc, cur, wr, wc, fr2, fq2); }
#undef G_SA
#undef G_SB
#undef G_STAGE
#undef G_LDA
#undef G_LDB
#undef G_MMA
#undef G_WAIT_V
#undef G_WAIT_L
#undef G_BAR
#undef G_SCHED
}

typedef f32x4 Acc[2][2][4][2];

template <bool MAX>
__device__ __forceinline__ void row_allreduce(float (&v)[2][4], LAS float* P, int wr, int wc, int fr, int fq) {
  UNR for (int ai = 0; ai < 2; ++ai) UNR for (int m = 0; m < 4; ++m) {
    float x = v[ai][m];
    float y = __shfl_xor(x, 16); x = MAX ? fmaxf(x, y) : x + y;
    y = __shfl_xor(x, 32); x = MAX ? fmaxf(x, y) : x + y;
    if (fq == 0) P[ROWOF(ai, m) * 4 + wc] = x;
  }
  __syncthreads();
  UNR for (int ai = 0; ai < 2; ++ai) UNR for (int m = 0; m < 4; ++m) {
    const f32x4 q = *(const LAS f32x4*)(P + ROWOF(ai, m) * 4);
    v[ai][m] = MAX ? fmaxf(fmaxf(q.x, q.y), fmaxf(q.z, q.w)) : (q.x + q.y) + (q.z + q.w);
  }
  __syncthreads();
}

struct EpiBf16 {
  const float* m_Av; const float* m_Mt;
  __device__ __forceinline__ void run(Acc& acc, const UnitD& u, int wr, int wc, int fr, int fq) const {
    bf16_t* base = (bf16_t*)u.out + (size_t)(64 * wr + fr) * u.ldc + 32 * wc + 8 * fq;
    UNR for (int bj = 0; bj < 2; ++bj) {
      f32x4 b0 = u.bias ? *(const f32x4*)(u.bias + COLOF(bj, 0)) : (f32x4){0.f, 0.f, 0.f, 0.f};
      f32x4 b1 = u.bias ? *(const f32x4*)(u.bias + COLOF(bj, 1)) : (f32x4){0.f, 0.f, 0.f, 0.f};
      if (u.sub == 2) { const float me = m_Mt[(size_t)(u.row0 + 255) * 4 + u.aux0];
        UNR for (int j = 0; j < 4; ++j) { b0[j] = __expf(m_Av[(size_t)(u.row0 + COLOF(bj, 0) + j) * 4 + u.aux0] - me); b1[j] = __expf(m_Av[(size_t)(u.row0 + COLOF(bj, 1) + j) * 4 + u.aux0] - me); } }
      UNR for (int ai = 0; ai < 2; ++ai) UNR for (int m = 0; m < 4; ++m) {
        f32x4 v0 = acc[ai][bj][m][0], v1 = acc[ai][bj][m][1];
        if (u.sub == 2) { v0 = v0 * b0; v1 = v1 * b1; } else { v0 = v0 + b0; v1 = v1 + b1; }
        if (u.sub == 1) { v0.x = sigmf(v0.x); v0.y = sigmf(v0.y); v0.z = sigmf(v0.z); v0.w = sigmf(v0.w); v1.x = sigmf(v1.x); v1.y = sigmf(v1.y); v1.z = sigmf(v1.z); v1.w = sigmf(v1.w); }
        u32x4 w; w.x = pk2(v0.x, v0.y); w.y = pk2(v0.z, v0.w); w.z = pk2(v1.x, v1.y); w.w = pk2(v1.z, v1.w);
        *(u32x4*)(base + (size_t)(128 * ai + 16 * m) * u.ldc + 128 * bj) = w;
      }
      asm volatile("" ::: "memory");
    }
  }
};
struct EpiU1 {
  const float* m_Av; const float* m_Mt; float* m_denp;
  __device__ __forceinline__ void run(Acc& acc, const UnitD& u, int wr, int wc, int fr, int fq) const {
    const int h = u.aux0, unit = u.aux1, tok0 = u.row0;
    float av[2][8];
    UNR for (int bj = 0; bj < 2; ++bj) UNR for (int j = 0; j < 8; ++j) av[bj][j] = m_Av[(size_t)(tok0 + COLOF(bj, 0) + j) * 4 + h];
    float mtv[2][4];
    UNR for (int ai = 0; ai < 2; ++ai) UNR for (int m = 0; m < 4; ++m) mtv[ai][m] = m_Mt[(size_t)(tok0 + ROWOF(ai, m)) * 4 + h];
    UNR for (int ai = 0; ai < 2; ++ai) UNR for (int m = 0; m < 4; ++m) {
      const int r = ROWOF(ai, m);
      const float mt = mtv[ai][m];
      bf16_t* rowp = (bf16_t*)u.out + (size_t)r * u.ldc;
      float rs = 0.f;
      UNR for (int bj = 0; bj < 2; ++bj) {
        float v[8];
        UNR for (int j = 0; j < 8; ++j) { const int c = COLOF(bj, 0) + j; const float w = (c <= r) ? __expf(av[bj][j] - mt) : 0.f; v[j] = acc[ai][bj][m][j >> 2][j & 3] * w; rs += v[j]; }
        u32x4 w2; w2.x = pk2(v[0], v[1]); w2.y = pk2(v[2], v[3]); w2.z = pk2(v[4], v[5]); w2.w = pk2(v[6], v[7]);
        *(u32x4*)(rowp + COLOF(bj, 0)) = w2;
      }
      rs += __shfl_xor(rs, 16); rs += __shfl_xor(rs, 32);
      if (fq == 0) m_denp[((size_t)unit * 256 + r) * 4 + wc] = rs;
      asm volatile("" ::: "memory");
    }
  }
};
struct EpiLru {
  const float* b_a; const float* b_x; const float* lam; const bf16_t* u; bf16_t* loga; bf16_t* bb;
  __device__ __forceinline__ void run(Acc& acc, const UnitD& ud, int wr, int wc, int fr, int fq) const {
    const int chb = ud.col0;
    UNR for (int bj = 0; bj < 2; ++bj) {
      const int ch = chb + 64 * bj + 16 * wc + 4 * fq;
      const f32x4 ba = *(const f32x4*)(b_a + ch), bx = *(const f32x4*)(b_x + ch), l = *(const f32x4*)(lam + ch);
      f32x4 ls;
      UNR for (int j = 0; j < 4; ++j) ls[j] = 8.0f * logsigm(l[j]);
      const size_t o0 = ((size_t)ud.row0 + 64 * wr + fr) * 1024 + ch;
      UNR for (int ai = 0; ai < 2; ++ai) { u32x2 uq[4];
      UNR for (int m = 0; m < 4; ++m) uq[m] = *(const u32x2*)(u + o0 + (size_t)(128 * ai + 16 * m) * 1024);
      UNR for (int m = 0; m < 4; ++m) {
        const size_t o = o0 + (size_t)(128 * ai + 16 * m) * 1024;
        const u32x2 uw = uq[m];
        const float uu[4] = {bf_lo(uw.x), bf_hi(uw.x), bf_lo(uw.y), bf_hi(uw.y)};
        float la[4], bv[4];
        UNR for (int j = 0; j < 4; ++j) {
          const float rg = sigmf(acc[ai][bj][m][0][j] + ba[j]);
          const float ig = sigmf(acc[ai][bj][m][1][j] + bx[j]);
          la[j] = rg * ls[j];
          const float x2 = 2.0f * la[j];
          const float om = (x2 > -0.02f) ? -(x2 * (1.0f + x2 * (0.5f + x2 * (1.0f / 6.0f)))) : 1.0f - __expf(x2);
          bv[j] = __builtin_amdgcn_sqrtf(fmaxf(om, 0.f)) * ig * uu[j];
        }
        u32x2 w1; w1.x = pk2(la[0], la[1]); w1.y = pk2(la[2], la[3]);
        u32x2 w2; w2.x = pk2(bv[0], bv[1]); w2.y = pk2(bv[2], bv[3]);
        *(u32x2*)(loga + o) = w1; *(u32x2*)(bb + o) = w2;
      }
      asm volatile("" ::: "memory"); }
    }
  }
};
struct EpiZ {
  __device__ __forceinline__ void run(Acc& acc, const UnitD& u, int wr, int wc, int fr, int fq) const {
    bf16_t* base = (bf16_t*)u.out + (size_t)(64 * wr + fr) * u.ldc + 32 * wc + 8 * fq;
    UNR for (int bj = 0; bj < 2; ++bj) {
      const f32x4 b0 = *(const f32x4*)(u.bias + COLOF(bj, 0)), b1 = *(const f32x4*)(u.bias + COLOF(bj, 1));
      u32x4 o[2][4];
      UNR for (int ai = 0; ai < 2; ++ai) UNR for (int m = 0; m < 4; ++m) o[ai][m] = *(const u32x4*)(base + (size_t)(128 * ai + 16 * m) * u.ldc + 128 * bj);
      UNR for (int ai = 0; ai < 2; ++ai) UNR for (int m = 0; m < 4; ++m) {
        const f32x4 z0 = acc[ai][bj][m][0] + b0, z1 = acc[ai][bj][m][1] + b1; const u32x4 ov = o[ai][m];
        u32x4 w; w.x = pk2(bf_lo(ov.x) * z0.x * sigmf(z0.x), bf_hi(ov.x) * z0.y * sigmf(z0.y)); w.y = pk2(bf_lo(ov.y) * z0.z * sigmf(z0.z), bf_hi(ov.y) * z0.w * sigmf(z0.w));
        w.z = pk2(bf_lo(ov.z) * z1.x * sigmf(z1.x), bf_hi(ov.z) * z1.y * sigmf(z1.y)); w.w = pk2(bf_lo(ov.w) * z1.z * sigmf(z1.z), bf_hi(ov.w) * z1.w * sigmf(z1.w));
        *(u32x4*)(base + (size_t)(128 * ai + 16 * m) * u.ldc + 128 * bj) = w;
      }
      asm volatile("" ::: "memory");
    }
  }
};
struct EpiMerge {
  bf16_t* gsc; float* macc; bf16_t* merged;
  __device__ __forceinline__ void run(Acc& acc, const UnitD& u, int wr, int wc, int fr, int fq) const {
    const size_t org = (size_t)(u.row0 + 64 * wr + fr) * 1024 + u.col0 + 32 * wc + 8 * fq;
    if ((u.sub & 1) == 0) {
      UNR for (int bj = 0; bj < 2; ++bj) {
        const f32x4 b0 = *(const f32x4*)(u.bias + COLOF(bj, 0)), b1 = *(const f32x4*)(u.bias + COLOF(bj, 1));
        UNR for (int ai = 0; ai < 2; ++ai) UNR for (int m = 0; m < 4; ++m) {
          const f32x4 v0 = acc[ai][bj][m][0] + b0, v1 = acc[ai][bj][m][1] + b1;
          u32x4 w; w.x = pk2(sigm(v0.x), sigm(v0.y)); w.y = pk2(sigm(v0.z), sigm(v0.w)); w.z = pk2(sigm(v1.x), sigm(v1.y)); w.w = pk2(sigm(v1.z), sigm(v1.w));
          *(u32x4*)(gsc + org + (size_t)(128 * ai + 16 * m) * 1024 + 128 * bj) = w;
        }
      }
    } else {
      UNR for (int bj = 0; bj < 2; ++bj) {
        u32x4 g[2][4], a[2][4];
        UNR for (int ai = 0; ai < 2; ++ai) UNR for (int m = 0; m < 4; ++m) { const size_t o = org + (size_t)(128 * ai + 16 * m) * 1024 + 128 * bj; g[ai][m] = *(const u32x4*)(gsc + o); if (u.sub != 1) a[ai][m] = *(const u32x4*)(merged + o); }
        UNR for (int ai = 0; ai < 2; ++ai) UNR for (int m = 0; m < 4; ++m) {
          const size_t o = org + (size_t)(128 * ai + 16 * m) * 1024 + 128 * bj;
          const u32x4 gg = g[ai][m];
          f32x4 v0 = acc[ai][bj][m][0], v1 = acc[ai][bj][m][1];
          v0.x *= bf_lo(gg.x); v0.y *= bf_hi(gg.x); v0.z *= bf_lo(gg.y); v0.w *= bf_hi(gg.y); v1.x *= bf_lo(gg.z); v1.y *= bf_hi(gg.z); v1.z *= bf_lo(gg.w); v1.w *= bf_hi(gg.w);
          if (u.sub != 1) { const u32x4 aa = a[ai][m]; v0.x += bf_lo(aa.x); v0.y += bf_hi(aa.x); v0.z += bf_lo(aa.y); v0.w += bf_hi(aa.y); v1.x += bf_lo(aa.z); v1.y += bf_hi(aa.z); v1.z += bf_lo(aa.w); v1.w += bf_hi(aa.w); }
          u32x4 w; w.x = pk2(v0.x, v0.y); w.y = pk2(v0.z, v0.w); w.z = pk2(v1.x, v1.y); w.w = pk2(v1.z, v1.w); *(u32x4*)(merged + o) = w;
        }
        asm volatile("" ::: "memory");
      }
    }
  }
};
struct EpiOut {
  const float* x; float* out;
  __device__ __forceinline__ void run(Acc& acc, const UnitD& u, int wr, int wc, int fr, int fq) const {
    const size_t org = (size_t)(u.row0 + 64 * wr + fr) * 1024 + u.col0 + 32 * wc + 8 * fq;
    UNR for (int bj = 0; bj < 2; ++bj) {
      f32x4 xv[2][4][2];
      UNR for (int ai = 0; ai < 2; ++ai) UNR for (int m = 0; m < 4; ++m) { const size_t o = org + (size_t)(128 * ai + 16 * m) * 1024 + 128 * bj; xv[ai][m][0] = *(const f32x4*)(x + o); xv[ai][m][1] = *(const f32x4*)(x + o + 4); }
      UNR for (int ai = 0; ai < 2; ++ai) UNR for (int m = 0; m < 4; ++m) { const size_t o = org + (size_t)(128 * ai + 16 * m) * 1024 + 128 * bj;
        *(f32x4*)(out + o) = xv[ai][m][0] + acc[ai][bj][m][0]; *(f32x4*)(out + o + 4) = xv[ai][m][1] + acc[ai][bj][m][1]; }
      asm volatile("" ::: "memory");
    }
  }
};
struct EpiSoftmax {
  LAS float* P;
  __device__ __forceinline__ void run(Acc& acc, const UnitD& u, int wr, int wc, int fr, int fq) const {
    float mx[2][4], sm[2][4];
    UNR for (int ai = 0; ai < 2; ++ai) UNR for (int m = 0; m < 4; ++m) { float x = -3.0e38f;
      UNR for (int bj = 0; bj < 2; ++bj) UNR for (int n = 0; n < 2; ++n) UNR for (int j = 0; j < 4; ++j) { acc[ai][bj][m][n][j] *= 0.0625f; x = fmaxf(x, acc[ai][bj][m][n][j]); }
      mx[ai][m] = x; }
    row_allreduce<true>(mx, P, wr, wc, fr, fq);
    UNR for (int ai = 0; ai < 2; ++ai) UNR for (int m = 0; m < 4; ++m) { float s = 0.f;
      UNR for (int bj = 0; bj < 2; ++bj) UNR for (int n = 0; n < 2; ++n) UNR for (int j = 0; j < 4; ++j) { const float e = __expf(acc[ai][bj][m][n][j] - mx[ai][m]); acc[ai][bj][m][n][j] = e; s += e; }
      sm[ai][m] = s; }
    row_allreduce<false>(sm, P, wr, wc, fr, fq);
    UNR for (int ai = 0; ai < 2; ++ai) UNR for (int m = 0; m < 4; ++m) {
      const float inv = __builtin_amdgcn_rcpf(sm[ai][m]);
      bf16_t* rowp = (bf16_t*)u.out + (size_t)ROWOF(ai, m) * u.ldc;
      UNR for (int bj = 0; bj < 2; ++bj) { const f32x4 v0 = acc[ai][bj][m][0] * inv, v1 = acc[ai][bj][m][1] * inv;
        u32x4 w; w.x = pk2(v0.x, v0.y); w.y = pk2(v0.z, v0.w); w.z = pk2(v1.x, v1.y); w.w = pk2(v1.z, v1.w); *(u32x4*)(rowp + COLOF(bj, 0)) = w; }
    }
  }
};
struct EpiU2 {
  LAS float* P; LAS float* deni; const float* m_denp; const float* m_Bc; const float* m_Mt; const bf16_t* og; const float* norm_g; const float* skip; bf16_t* xc;
  __device__ __forceinline__ void run(Acc& acc, const UnitD& u, int wr, int wc, int fr, int fq) const {
    const int h = u.aux0, unit = u.aux1, tok0 = u.row0;
    float s1[2][4], s2[2][4];
    UNR for (int ai = 0; ai < 2; ++ai) UNR for (int m = 0; m < 4; ++m) {
      const int r = ROWOF(ai, m); const size_t tok = (size_t)tok0 + r;
      const f32x4 dp = *(const f32x4*)(m_denp + ((size_t)unit * 256 + r) * 4);
      const float den = (dp.x + dp.y) + (dp.z + dp.w) + deni[r];
      const float mt = m_Bc[tok * 4 + h];
      const float inv = __builtin_amdgcn_rcpf(fmaxf(fabsf(den), __expf(-mt)));
      float s = 0.f;
      const bf16_t* ogp = og + tok * 1024 + h * 256 + 32 * wc + 8 * fq;
      UNR for (int bj = 0; bj < 2; ++bj) {
        const u32x4 o = *(const u32x4*)(ogp + 128 * bj);
        f32x4 v0 = acc[ai][bj][m][0] * inv, v1 = acc[ai][bj][m][1] * inv;
        v0.x *= bf_lo(o.x); v0.y *= bf_hi(o.x); v0.z *= bf_lo(o.y); v0.w *= bf_hi(o.y); v1.x *= bf_lo(o.z); v1.y *= bf_hi(o.z); v1.z *= bf_lo(o.w); v1.w *= bf_hi(o.w);
        acc[ai][bj][m][0] = v0; acc[ai][bj][m][1] = v1; s += ((v0.x + v0.y) + (v0.z + v0.w)) + ((v1.x + v1.y) + (v1.z + v1.w));
      }
      s1[ai][m] = s;
      if (m == 3) asm volatile("" ::: "memory");
    }
    row_allreduce<false>(s1, P, wr, wc, fr, fq);
    UNR for (int ai = 0; ai < 2; ++ai) UNR for (int m = 0; m < 4; ++m) { const float mu = s1[ai][m] * (1.0f / 256.0f); float s = 0.f;
      UNR for (int bj = 0; bj < 2; ++bj) UNR for (int n = 0; n < 2; ++n) { f32x4 v = acc[ai][bj][m][n] - mu; acc[ai][bj][m][n] = v; s += (v.x * v.x + v.y * v.y) + (v.z * v.z + v.w * v.w); }
      s2[ai][m] = s; }
    row_allreduce<false>(s2, P, wr, wc, fr, fq);
    UNR for (int ai = 0; ai < 2; ++ai) UNR for (int m = 0; m < 4; ++m) s2[ai][m] = __builtin_amdgcn_rsqf(s2[ai][m] * (1.0f / 256.0f) + 1e-6f);
    bf16_t* xb = xc + (size_t)(tok0 + 64 * wr + fr) * 1024 + h * 256 + 32 * wc + 8 * fq;
    UNR for (int bj = 0; bj < 2; ++bj) {
      const int ch = h * 256 + COLOF(bj, 0);
      const f32x4 g0 = *(const f32x4*)(norm_g + ch), g1 = *(const f32x4*)(norm_g + ch + 4), k0 = *(const f32x4*)(skip + ch), k1 = *(const f32x4*)(skip + ch + 4);
      UNR for (int ai = 0; ai < 2; ++ai) {
        u32x4 xq[4];
        UNR for (int m = 0; m < 4; ++m) xq[m] = *(const u32x4*)(xb + (size_t)(128 * ai + 16 * m) * 1024 + 128 * bj);
        UNR for (int m = 0; m < 4; ++m) {
          const u32x4 xv = xq[m];
          const f32x4 v0 = acc[ai][bj][m][0] * s2[ai][m], v1 = acc[ai][bj][m][1] * s2[ai][m];
          u32x4 w; w.x = pk2(v0.x * g0.x + k0.x * bf_lo(xv.x), v0.y * g0.y + k0.y * bf_hi(xv.x)); w.y = pk2(v0.z * g0.z + k0.z * bf_lo(xv.y), v0.w * g0.w + k0.w * bf_hi(xv.y));
          w.z = pk2(v1.x * g1.x + k1.x * bf_lo(xv.z), v1.y * g1.y + k1.y * bf_hi(xv.z)); w.w = pk2(v1.z * g1.z + k1.z * bf_lo(xv.w), v1.w * g1.w + k1.w * bf_hi(xv.w));
          *(u32x4*)(xb + (size_t)(128 * ai + 16 * m) * 1024 + 128 * bj) = w;
        }
        asm volatile("" ::: "memory");
      }
    }
  }
};

struct EpiOutNorm {
  const float* x; float* out; const float* g; LAS float* P; float* xch; unsigned* cnt;
  __device__ __forceinline__ void run(Acc& acc, const UnitD& u, int wr, int wc, int fr, int fq) const {
    const int pm = u.aux0, pn = u.aux1;
    const size_t org = (size_t)(u.row0 + 64 * wr + fr) * 1024 + u.col0 + 32 * wc + 8 * fq;
    UNR for (int bj = 0; bj < 2; ++bj) UNR for (int ai = 0; ai < 2; ++ai) {
      f32x4 xv[4][2];
      UNR for (int m = 0; m < 4; ++m) { const size_t o = org + (size_t)(128 * ai + 16 * m) * 1024 + 128 * bj; xv[m][0] = *(const f32x4*)(x + o); xv[m][1] = *(const f32x4*)(x + o + 4); }
      UNR for (int m = 0; m < 4; ++m) { acc[ai][bj][m][0] += xv[m][0]; acc[ai][bj][m][1] += xv[m][1]; }
      asm volatile("" ::: "memory");
    }
    float ss[2][4];
    UNR for (int ai = 0; ai < 2; ++ai) UNR for (int m = 0; m < 4; ++m) { float s = 0.f;
      UNR for (int bj = 0; bj < 2; ++bj) UNR for (int n = 0; n < 2; ++n) { const f32x4 v = acc[ai][bj][m][n]; s += (v.x * v.x + v.y * v.y) + (v.z * v.z + v.w * v.w); }
      ss[ai][m] = s; }
    row_allreduce<false>(ss, P, wr, wc, fr, fq);
    if (wc == 0 && fq == 0) {
      UNR for (int ai = 0; ai < 2; ++ai) UNR for (int m = 0; m < 4; ++m)
        __hip_atomic_store(xch + ((size_t)(pm * 256 + ROWOF(ai, m))) * 4 + pn, ss[ai][m], __ATOMIC_RELAXED, __HIP_MEMORY_SCOPE_AGENT);
    }
    asm volatile("s_waitcnt vmcnt(0)" ::: "memory");
    __syncthreads();
    if (threadIdx.x == 0) {
      unsigned* c = cnt + 64 * pm;
      __hip_atomic_fetch_add(c, 1u, __ATOMIC_RELAXED, __HIP_MEMORY_SCOPE_AGENT);
      unsigned sp = 0;
      while (__hip_atomic_load(c, __ATOMIC_RELAXED, __HIP_MEMORY_SCOPE_AGENT) < 4u) { __builtin_amdgcn_s_sleep(1); if (++sp > (1u << 22)) break; }
      __builtin_amdgcn_fence(__ATOMIC_ACQUIRE, "agent");
      asm volatile("s_waitcnt vmcnt(0)" ::: "memory");
    }
    __syncthreads();
    UNR for (int ai = 0; ai < 2; ++ai) UNR for (int m = 0; m < 4; ++m) {
      const float* sl = xch + ((size_t)(pm * 256 + ROWOF(ai, m))) * 4;
      const float t = (__hip_atomic_load(sl, __ATOMIC_RELAXED, __HIP_MEMORY_SCOPE_AGENT) + __hip_atomic_load(sl + 1, __ATOMIC_RELAXED, __HIP_MEMORY_SCOPE_AGENT))
                    + (__hip_atomic_load(sl + 2, __ATOMIC_RELAXED, __HIP_MEMORY_SCOPE_AGENT) + __hip_atomic_load(sl + 3, __ATOMIC_RELAXED, __HIP_MEMORY_SCOPE_AGENT));
      ss[ai][m] = 1.0f / sqrtf(t * (1.0f / 1024.0f) + 1e-6f);
    }
    int fr3 = fr, fq3 = fq; asm volatile("" : "+v"(fr3), "+v"(fq3));
    const size_t org2 = (size_t)(u.row0 + 64 * wr + fr3) * 1024 + u.col0 + 32 * wc + 8 * fq3;
    UNR for (int bj = 0; bj < 2; ++bj) {
      const f32x4 g0 = *(const f32x4*)(g + u.col0 + COLOF(bj, 0)), g1 = *(const f32x4*)(g + u.col0 + COLOF(bj, 1));
      UNR for (int ai = 0; ai < 2; ++ai) UNR for (int m = 0; m < 4; ++m) { const size_t o = org2 + (size_t)(128 * ai + 16 * m) * 1024 + 128 * bj;
        *(f32x4*)(out + o) = acc[ai][bj][m][0] * ss[ai][m] * g0; *(f32x4*)(out + o + 4) = acc[ai][bj][m][1] * ss[ai][m] * g1; }
    }
  }
};

struct SchedTiles {
  const char* A; const char* Bt; char* out0; char* out1; const float* bias; int nN, G, c;
  __device__ __forceinline__ bool next(int i, UnitD& u) const {
    int pm, pn; if (!static_tile((long)i * G + c, 64, nN, pm, pn)) return false;
    u.A0 = u.A1 = A + (size_t)pm * 256 * 1024 * 2; u.B0 = u.B1 = Bt + (size_t)pn * 256 * 1024 * 2;
    u.out = ((pn >> 2) ? out1 : out0) + ((size_t)pm * 256 * 1024 + (pn & 3) * 256) * 2; u.bias = bias ? bias + pn * 256 : nullptr; u.ldc = 1024; u.sub = 0;
    u.row0 = pm * 256; u.col0 = (pn & 3) * 256; u.aux0 = 0; u.aux1 = 0; return true;
  }
};
struct SchedOne { UnitD u; bool has; __device__ __forceinline__ bool next(int i, UnitD& o) const { if (i != 0 || !has) return false; o = u; return true; } };
struct SchedP3X {
  const char* xc; const char* mx; const char* wq; const char* wk; const char* wo; char* q; char* k; char* og; const float* b_o; int G, c;
  __device__ __forceinline__ bool next(int i, UnitD& u) const {
    const int L = i * G + c; if (L >= 768) return false;
    const int kind = L >> 8, idx = L & 255, pm = idx >> 2, h = idx & 3;
    const size_t to = ((size_t)pm * 256 * 1024 + h * 256) * 2;
    u.A0 = u.A1 = (kind == 2 ? mx : xc) + to; u.B0 = u.B1 = wq + (size_t)(kind == 0 ? 0 : kind == 1 ? 524288 : 1572864) + (size_t)h * 131072;
    u.out = q + (size_t)kind * SLOT + to; u.bias = kind == 2 ? b_o + h * 256 : nullptr; u.ldc = 1024; u.sub = kind == 2 ? 1 : 0;
    u.row0 = pm * 256; u.col0 = h * 256; u.aux0 = h; u.aux1 = 0; return true;
  }
};
struct SchedP3Y {
  const char* xc; const char* mx; const char* wk; const char* wv; char* vt; char* ktw; int G, c, base, count;
  __device__ __forceinline__ bool next(int i, UnitD& u) const {
    const int Lr = i * G + c; if (Lr >= count) return false;
    const int L = base + Lr;
    const int kind = L >> 8, unit = L & 255, bh = unit >> 5, ci = unit & 31, b = bh >> 2, h = bh & 3, tok0 = b * SEQ + ci * 256;
    u.A0 = u.A1 = (kind ? wk : wv) + (size_t)h * 131072; u.B0 = u.B1 = (kind ? xc : mx) + ((size_t)tok0 * 1024 + h * 256) * 2;
    u.out = (kind ? ktw : vt) + (size_t)unit * 131072; u.bias = nullptr; u.ldc = 256; u.sub = kind ? 2 : 0; u.row0 = tok0; u.col0 = 0; u.aux0 = h; u.aux1 = unit; return true;
  }
};
struct SchedZ {
  const char* hn; const char* wint; char* y0; char* y1; char* y2; const float* binr; int G, c;
  __device__ __forceinline__ bool next(int i, UnitD& u) const {
    const int L = i * G + c; if (L >= 768) return false;
    const int br = L >> 8, r = L & 255, pm = (r & 7) * 8 + (r >> 5), pn = (r >> 3) & 3;
    u.A0 = u.A1 = hn + (size_t)pm * 256 * 1024 * 2; u.B0 = u.B1 = wint + (size_t)(3072 + br * 1024 + pn * 256) * 1024 * 2;
    u.out = (char*)((size_t)y0 * (size_t)(br == 0) + (size_t)y1 * (size_t)(br == 1) + (size_t)y2 * (size_t)(br == 2)) + ((size_t)pm * 256 * 1024 + pn * 256) * 2; u.bias = binr + 3072 + br * 1024 + pn * 256; u.ldc = 1024; u.sub = 0; u.row0 = pm * 256; u.col0 = pn * 256; u.aux0 = 0; u.aux1 = 0; return true;
  }
};
struct SchedMerge {
  const char* hn; const char* wint; const char* wbt; const char* y0; const char* y1; const char* y2; const float* binr; int G, c;
  __device__ __forceinline__ bool next(int i, UnitD& u) const {
    const int tile = (i / 6) * G + c; if (tile >= 256) return false;
    const int kind = i % 6, n = kind >> 1, pm = (tile & 7) * 8 + (tile >> 5), pn = (tile >> 3) & 3;
    if ((kind & 1) == 0) { u.A0 = u.A1 = hn + (size_t)pm * 256 * 1024 * 2; u.B0 = u.B1 = wint + (size_t)(6144 + n * 1024 + pn * 256) * 1024 * 2; u.bias = binr + 6144 + n * 1024 + pn * 256; }
    else { u.A0 = u.A1 = (const char*)((size_t)y0 * (size_t)(n == 0) + (size_t)y1 * (size_t)(n == 1) + (size_t)y2 * (size_t)(n == 2)) + (size_t)pm * 256 * 1024 * 2; u.B0 = u.B1 = wbt + (size_t)(n * 1024 + pn * 256) * 1024 * 2; u.bias = nullptr; }
    u.out = nullptr; u.ldc = 1024; u.sub = kind; u.row0 = pm * 256; u.col0 = pn * 256; u.aux0 = 0; u.aux1 = 0; return true;
  }
};
struct SchedLru {
  const char* u_; const char* wl; int G, c;
  __device__ __forceinline__ bool next(int i, UnitD& u) const {
    const int L = i * G + c; if (L >= 512) return false;
    const int pm = (L & 7) * 8 + (L >> 6), pn = (L >> 3) & 7;
    u.A0 = u.A1 = u_ + ((size_t)pm * 256 * 1024 + (pn >> 1) * 256) * 2; u.B0 = u.B1 = wl + (size_t)pn * 131072;
    u.out = nullptr; u.bias = nullptr; u.ldc = 1024; u.sub = 0; u.row0 = pm * 256; u.col0 = (pn >> 1) * 256 + (pn & 1) * 128; u.aux0 = 0; u.aux1 = 0; return true;
  }
};

template <int NR>
__device__ __forceinline__ void rmsnorm_rows_bf16(const float* xr, const float* g, bf16_t* o, int lane) {
  f32x4 v[NR][4]; float s[NR];
#pragma unroll
  for (int r = 0; r < NR; ++r)
#pragma unroll
    for (int j = 0; j < 4; ++j) v[r][j] = ((const f32x4*)(xr + (size_t)r * 1024))[lane + 64 * j];
#pragma unroll
  for (int r = 0; r < NR; ++r) { float t = 0.f;
#pragma unroll
    for (int j = 0; j < 4; ++j) t += (v[r][j].x * v[r][j].x + v[r][j].y * v[r][j].y) + (v[r][j].z * v[r][j].z + v[r][j].w * v[r][j].w);
    s[r] = 1.0f / sqrtf(wave_sum(t) * (1.0f / 1024.0f) + 1e-6f); }
#pragma unroll
  for (int j = 0; j < 4; ++j) { const f32x4 gg = ((const f32x4*)g)[lane + 64 * j];
#pragma unroll
    for (int r = 0; r < NR; ++r) { u32x2 w; w.x = pk2(v[r][j].x * s[r] * gg.x, v[r][j].y * s[r] * gg.y); w.y = pk2(v[r][j].z * s[r] * gg.z, v[r][j].w * s[r] * gg.w); ((u32x2*)(o + (size_t)r * 1024))[lane + 64 * j] = w; } }
}
__device__ __forceinline__ void rmsnorm_row_bf16(const float* xr, const float* g, bf16_t* o, int lane) { rmsnorm_rows_bf16<1>(xr, g, o, lane); }

template <class RowMap>
__device__ __forceinline__ void transpose_tile(const float* __restrict__ src, int N, int K, int k0, int n0, bf16_t* dst, RowMap rm, float scale, LAS float* scr) {
  const int tid = threadIdx.x;
  { const int n4 = tid & 15, kk = tid >> 4;
    f32x4 a[4], b[4];
#pragma unroll
    for (int cb = 0; cb < 4; ++cb) { a[cb] = *(const f32x4*)(src + (size_t)(k0 + kk) * N + n0 + cb * 64 + 4 * n4); b[cb] = *(const f32x4*)(src + (size_t)(k0 + kk + 32) * N + n0 + cb * 64 + 4 * n4); }
#pragma unroll
    for (int cb = 0; cb < 4; ++cb) { LAS float* s0 = scr + kk * 261 + cb * 64 + 4 * n4; LAS float* s1 = s0 + 32 * 261;
      s0[0] = a[cb].x; s0[1] = a[cb].y; s0[2] = a[cb].z; s0[3] = a[cb].w; s1[0] = b[cb].x; s1[1] = b[cb].y; s1[2] = b[cb].z; s1[3] = b[cb].w; } }
  __syncthreads();
#pragma unroll
  for (int cb = 0; cb < 4; ++cb) { const int nn = cb * 64 + (tid >> 3), kc = tid & 7; const LAS float* s = scr + (kc * 8) * 261 + nn;
    u32x4 o; o.x = pk2(s[0] * scale, s[261] * scale); o.y = pk2(s[522] * scale, s[783] * scale); o.z = pk2(s[1044] * scale, s[1305] * scale); o.w = pk2(s[1566] * scale, s[1827] * scale);
    *(u32x4*)(dst + (size_t)rm(n0 + nn) * K + k0 + kc * 8) = o; }
  __syncthreads();
}
struct RmId { __device__ __forceinline__ int operator()(int n) const { return n; } };
struct RmWin { __device__ __forceinline__ int operator()(int n) const { const int b = n >> 10; const int mb = b == 0 ? 1 : b == 1 ? 3 : b == 2 ? 0 : b == 3 ? 4 : b == 4 ? 2 : b; return mb * 1024 + (n & 1023); } };
struct RmLru { int mat; __device__ __forceinline__ int operator()(int o) const { const int pnl = o >> 7, cl = o & 127; return pnl * 256 + 128 * (cl >> 6) + 32 * ((cl >> 4) & 3) + 8 * ((cl >> 2) & 3) + 4 * mat + (cl & 3); } };

template <bool MAX>
__device__ __forceinline__ float block_excl_scan(float v, LAS float* tmp) {
  const int lane = threadIdx.x & 63, wid = threadIdx.x >> 6;
  const float ident = MAX ? -3.0e38f : 0.f;
  float inc = v;
#pragma unroll
  for (int o = 1; o < 64; o <<= 1) { const float y = __shfl_up(inc, o); if (lane >= o) inc = MAX ? fmaxf(inc, y) : inc + y; }
  if (lane == 63) tmp[wid] = inc;
  __syncthreads();
  float base = ident;
  for (int w = 0; w < wid; ++w) base = MAX ? fmaxf(base, tmp[w]) : base + tmp[w];
  float ex = __shfl_up(inc, 1); if (lane == 0) ex = ident;
  __syncthreads();
  return MAX ? fmaxf(base, ex) : base + ex;
}

template <bool MLSTM>
__device__ __forceinline__ void conv_rows(const Params& p, const bf16_t* src, bf16_t* dst, const float* cw, const float* cb, float* gates, const float* b_if, LAS float* wxc, LAS float* wxm, int gw, int NW, int lane) {
  for (int t = gw; t < T; t += NW) {
    const int tl = t & (SEQ - 1);
    float g[8];
#pragma unroll
    for (int j = 0; j < 8; ++j) g[j] = 0.f;
#pragma unroll
    for (int i = 0; i < 2; ++i) { const int c0 = i * 512 + lane * 8;
      float o[8], xm[8];
      { const f32x4 a = *(const f32x4*)(cb + c0), b = *(const f32x4*)(cb + c0 + 4);
        o[0] = a.x; o[1] = a.y; o[2] = a.z; o[3] = a.w; o[4] = b.x; o[5] = b.y; o[6] = b.z; o[7] = b.w; }
#pragma unroll
      for (int e = 0; e < 8; ++e) xm[e] = 0.f;
#pragma unroll
      for (int k = 0; k < 4; ++k) {
        if (tl - 3 + k >= 0) {
          const u32x4 v = *(const u32x4*)(src + (size_t)(t - 3 + k) * 1024 + c0);
          const f32x4 wa = *(const f32x4*)(cw + k * 1024 + c0), wb = *(const f32x4*)(cw + k * 1024 + c0 + 4);
          const float xv[8] = {bf_lo(v.x), bf_hi(v.x), bf_lo(v.y), bf_hi(v.y), bf_lo(v.z), bf_hi(v.z), bf_lo(v.w), bf_hi(v.w)};
          const float wv[8] = {wa.x, wa.y, wa.z, wa.w, wb.x, wb.y, wb.z, wb.w};
#pragma unroll
          for (int e = 0; e < 8; ++e) { o[e] += wv[e] * xv[e]; if (k == 3) xm[e] = xv[e]; }
        }
      }
      if (MLSTM) {
#pragma unroll
        for (int e = 0; e < 8; ++e) o[e] = o[e] * sigm(o[e]);
#pragma unroll
        for (int e = 0; e < 8; ++e) { const int c = c0 + e;
          const f32x4 a0 = *(const LAS f32x4*)(wxc + c * 8), a1 = *(const LAS f32x4*)(wxc + c * 8 + 4), m0 = *(const LAS f32x4*)(wxm + c * 8), m1 = *(const LAS f32x4*)(wxm + c * 8 + 4);
          g[0] += o[e] * a0.x + xm[e] * m0.x; g[1] += o[e] * a0.y + xm[e] * m0.y; g[2] += o[e] * a0.z + xm[e] * m0.z; g[3] += o[e] * a0.w + xm[e] * m0.w;
          g[4] += o[e] * a1.x + xm[e] * m1.x; g[5] += o[e] * a1.y + xm[e] * m1.y; g[6] += o[e] * a1.z + xm[e] * m1.z; g[7] += o[e] * a1.w + xm[e] * m1.w; }
      }
      u32x4 ov; ov.x = pk2(o[0], o[1]); ov.y = pk2(o[2], o[3]); ov.z = pk2(o[4], o[5]); ov.w = pk2(o[6], o[7]);
      *(u32x4*)(dst + (size_t)t * 1024 + c0) = ov;
    }
    if (MLSTM) {
#pragma unroll
      for (int j = 0; j < 8; ++j) g[j] = wave_sum(g[j]);
      if (lane == 0) {
        f32x4 o0, o1;
        o0.x = g[0] + b_if[0]; o0.y = g[1] + b_if[1]; o0.z = g[2] + b_if[2]; o0.w = g[3] + b_if[3];
        o1.x = logsigm(g[4] + b_if[4]); o1.y = logsigm(g[5] + b_if[5]); o1.z = logsigm(g[6] + b_if[6]); o1.w = logsigm(g[7] + b_if[7]);
        *(f32x4*)(gates + (size_t)t * 8) = o0; *(f32x4*)(gates + (size_t)t * 8 + 4) = o1;
      }
    }
  }
}

template <bool SILU>
__device__ __forceinline__ void conv_item(const bf16_t* src, bf16_t* dst, const float* cw, const float* cb, int c0, int t0) {
  const bool first = ((t0 & (SEQ - 1)) == 0);
  u32x4 xr[19];
#pragma unroll
  for (int i = 0; i < 19; ++i) { if (i < 3 && first) xr[i] = (u32x4){0u, 0u, 0u, 0u}; else xr[i] = *(const u32x4*)(src + (size_t)(t0 - 3 + i) * 1024 + c0); }
  float w[4][8], bs[8];
#pragma unroll
  for (int k = 0; k < 4; ++k) { const f32x4 a = *(const f32x4*)(cw + k * 1024 + c0), b = *(const f32x4*)(cw + k * 1024 + c0 + 4);
    w[k][0] = a.x; w[k][1] = a.y; w[k][2] = a.z; w[k][3] = a.w; w[k][4] = b.x; w[k][5] = b.y; w[k][6] = b.z; w[k][7] = b.w; }
  { const f32x4 a = *(const f32x4*)(cb + c0), b = *(const f32x4*)(cb + c0 + 4); bs[0] = a.x; bs[1] = a.y; bs[2] = a.z; bs[3] = a.w; bs[4] = b.x; bs[5] = b.y; bs[6] = b.z; bs[7] = b.w; }
#pragma unroll
  for (int t = 0; t < 16; ++t) {
    float o[8];
#pragma unroll
    for (int e = 0; e < 8; ++e) o[e] = bs[e];
#pragma unroll
    for (int k = 0; k < 4; ++k) { const u32x4 v = xr[t + k];
      o[0] += w[k][0] * bf_lo(v.x); o[1] += w[k][1] * bf_hi(v.x); o[2] += w[k][2] * bf_lo(v.y); o[3] += w[k][3] * bf_hi(v.y);
      o[4] += w[k][4] * bf_lo(v.z); o[5] += w[k][5] * bf_hi(v.z); o[6] += w[k][6] * bf_lo(v.w); o[7] += w[k][7] * bf_hi(v.w); }
    if (SILU) {
#pragma unroll
      for (int e = 0; e < 8; ++e) o[e] = o[e] * sigmf(o[e]); }
    u32x4 ov; ov.x = pk2(o[0], o[1]); ov.y = pk2(o[2], o[3]); ov.z = pk2(o[4], o[5]); ov.w = pk2(o[6], o[7]);
    *(u32x4*)(dst + (size_t)(t0 + t) * 1024 + c0) = ov;
  }
}
template <bool SILU>
__device__ __forceinline__ void conv_stream(const bf16_t* src, bf16_t* dst, const float* cw, const float* cb, int gtid, int GT) {
  for (int g = gtid; g < 131072; g += GT) conv_item<SILU>(src, dst, cw, cb, (g & 127) * 8, (g >> 7) * 16);
}
__device__ __forceinline__ void gates_tile(const bf16_t* xc, const bf16_t* xm, const bf16_t* wgT, float* part, int tok0, int h, int wid, int lane) {
  const int i16 = lane & 15, kg = lane >> 4;
#pragma unroll 1
  for (int tt = wid; tt < 16; tt += 8) {
    const int t16 = tok0 + tt * 16;
    f32x4 acc = {0.f, 0.f, 0.f, 0.f};
    const bf16_t* ap = xc + (size_t)(t16 + i16) * 1024 + h * 256 + kg * 8;
    const bf16_t* bp = wgT + (size_t)i16 * 2048 + h * 256 + kg * 8;
#pragma unroll
    for (int ks = 0; ks < 8; ++ks) { const bf16x8 a = *(const bf16x8*)(ap + ks * 32), b = *(const bf16x8*)(bp + ks * 32); acc = __builtin_amdgcn_mfma_f32_16x16x32_bf16(a, b, acc, 0, 0, 0); }
    ap = xm + (size_t)(t16 + i16) * 1024 + h * 256 + kg * 8; bp += 1024;
#pragma unroll
    for (int ks = 0; ks < 8; ++ks) { const bf16x8 a = *(const bf16x8*)(ap + ks * 32), b = *(const bf16x8*)(bp + ks * 32); acc = __builtin_amdgcn_mfma_f32_16x16x32_bf16(a, b, acc, 0, 0, 0); }
    if (i16 < 8) *(f32x4*)(part + ((size_t)h * 8 + i16) * T + t16 + 4 * kg) = acc;
  }
}

__device__ __forceinline__ void gates_gemm(const bf16_t* xc, const bf16_t* xm, const bf16_t* wgT, float* part, int gw, int NW, int lane) {
  const int i16 = lane & 15, kg = lane >> 4;
  for (int item = gw; item < 2048; item += NW) {
    const int tile = item >> 1, half = item & 1, tok0 = tile * 16;
    f32x4 acc = {0.f, 0.f, 0.f, 0.f};
    const bf16_t* ap = (half ? xm : xc) + (size_t)(tok0 + i16) * 1024 + kg * 8;
    const bf16_t* bp = wgT + (size_t)i16 * 2048 + half * 1024 + kg * 8;
#pragma unroll 16
    for (int ks = 0; ks < 32; ++ks) { const bf16x8 a = *(const bf16x8*)(ap + ks * 32), b = *(const bf16x8*)(bp + ks * 32); acc = __builtin_amdgcn_mfma_f32_16x16x32_bf16(a, b, acc, 0, 0, 0); }
    if (i16 < 8) *(f32x4*)(part + ((size_t)half * 8 + i16) * T + tok0 + 4 * kg) = acc;
  }
}

#define XB_TMO      128
#define XB_XCNT(j)  (256  + 64 * (j))
#define XB_XSUB(j)  (1280 + 64 * (j))
#define XB_XGEN(j)  (2304 + 64 * (j))
#define XB_TOP      3328
#define XB_TOPGEN   3392
#define XCD_BAR_WORDS 3456
#define XB_SPIN_CAP (1u << 18)
__device__ __forceinline__ unsigned xb_ld(unsigned* p)              { return __hip_atomic_load(p, __ATOMIC_RELAXED, __HIP_MEMORY_SCOPE_AGENT); }
__device__ __forceinline__ unsigned xb_add(unsigned* p, unsigned v) { return __hip_atomic_fetch_add(p, v, __ATOMIC_RELAXED, __HIP_MEMORY_SCOPE_AGENT); }
__device__ __forceinline__ unsigned xb_xcc_id() { return (unsigned)__builtin_amdgcn_s_getreg((3 << 11) | 20) & 0xFu; }
#define XB_SPIN(cond, bar) do { unsigned _sp = 0; while (cond) { __builtin_amdgcn_s_sleep(1); \
    if ((++_sp & 255u) == 0u) { if (xb_ld(&(bar)[XB_TMO])) break; if (_sp > XB_SPIN_CAP) { atomicAdd(&(bar)[XB_TMO], 1u); break; } } } } while (0)
struct XcdBarrier { unsigned* bar; unsigned x; volatile LAS unsigned* st; };
__device__ __forceinline__ XcdBarrier xcd_barrier_post(unsigned* bar, volatile LAS unsigned* st) {
    XcdBarrier b; b.bar = bar; b.x = xb_xcc_id(); b.st = st;
    if (threadIdx.x == 0) (void)xb_add(&bar[XB_XCNT(b.x)], 1u);
    return b;
}
__device__ __forceinline__ void xcd_barrier_complete(unsigned* bar, unsigned x, unsigned& nloc, unsigned& nx) {
    const unsigned G = gridDim.x * gridDim.y * gridDim.z;
    unsigned sum, cnt, mine, sp = 0u;
    for (;;) {
        sum = 0u; cnt = 0u; mine = 0u;
#pragma unroll
        for (unsigned j = 0; j < 16; ++j) { const unsigned c = xb_ld(&bar[XB_XCNT(j)]); sum += c; cnt += (c > 0u) ? 1u : 0u; mine = (j == x) ? c : mine; }
        if (sum == G) break;
        __builtin_amdgcn_s_sleep(1);
        if ((++sp & 255u) == 0u) { if (xb_ld(&bar[XB_TMO])) break; if (sp > XB_SPIN_CAP) { atomicAdd(&bar[XB_TMO], 1u); break; } }
    }
    nloc = mine > 0u ? mine : 1u; nx = cnt > 0u ? cnt : 1u;
}
__device__ __forceinline__ void xcd_barrier(const XcdBarrier& b) {
    asm volatile("s_waitcnt vmcnt(0)" ::: "memory");
    __syncthreads();
    if (threadIdx.x == 0) {
        unsigned* bar = b.bar;
        __builtin_amdgcn_s_waitcnt(0);
        unsigned nloc = b.st[0], nx = b.st[1];
        if (nloc == 0u) { xcd_barrier_complete(bar, b.x, nloc, nx); b.st[0] = nloc; b.st[1] = nx; }
        const unsigned old = xb_add(&bar[XB_XSUB(b.x)], 1u);
        const unsigned gen = old / nloc;
        if (old + 1u == (gen + 1u) * nloc) {
            __builtin_amdgcn_fence(__ATOMIC_RELEASE, "agent");
            asm volatile("s_waitcnt vmcnt(0)" ::: "memory");
            const unsigned og = xb_add(&bar[XB_TOP], 1u);
            const unsigned tg = og / nx;
            if (og + 1u == (tg + 1u) * nx) xb_add(&bar[XB_TOPGEN], 1u);
            else XB_SPIN(xb_ld(&bar[XB_TOPGEN]) == tg, bar);
            __builtin_amdgcn_fence(__ATOMIC_ACQUIRE, "agent");
            xb_add(&bar[XB_XGEN(b.x)], 1u);
            asm volatile("s_waitcnt vmcnt(0)" ::: "memory");
        } else {
            XB_SPIN(xb_ld(&bar[XB_XGEN(b.x)]) == gen, bar);
            __builtin_amdgcn_fence(__ATOMIC_ACQUIRE, "agent");
            asm volatile("s_waitcnt vmcnt(0)" ::: "memory");
        }
    }
    __syncthreads();
}

#define W0 ((char*)p.ws + O_SLOTS)
#define W1 ((char*)p.ws + O_SLOTS + SLOT)
#define W2 ((char*)p.ws + O_SLOTS + 2 * SLOT)
#define W3 ((char*)p.ws + O_SLOTS + 3 * SLOT)
#define W4 ((char*)p.ws + O_SLOTS + 4 * SLOT)
#define W5 ((char*)p.ws + O_SLOTS + 5 * SLOT)
#define D0 ((char*)p.out)
#define D1 ((char*)p.out + SLOT)
#define WinT ((const char*)p.ws + O_WINT)
#define WbT ((const char*)p.ws + O_WBT)
#define WoutT ((const char*)p.ws + O_WOUTT)
#define WkvT ((const char*)p.ws + O_WKVT)
#define WqT ((const char*)p.ws + O_WQT)
#define WkT ((const char*)p.ws + O_WKT)
#define WvT ((const char*)p.ws + O_WVT)
#define WoT ((const char*)p.ws + O_WOT)
#define WlruT ((const char*)p.ws + O_WLRUT)
#define binR ((float*)(p.ws + O_BINR))
#define Wxc ((float*)(p.ws + O_WXC))
#define Wxm ((float*)(p.ws + O_WXM))
#define gates ((float*)(p.ws + O_GATES))
#define Bc ((float*)(p.ws + O_BC))
#define Av ((float*)(p.ws + O_AV))
#define Mt ((float*)(p.ws + O_MT))
#define denp ((float*)(p.ws + O_DENP))
#define nkloc ((float*)(p.ws + O_NKLOC))
#define nprev ((float*)(p.ws + O_NPREV))
#define Kmem ((char*)p.ws + O_KMEM)
#define VmemT ((char*)p.ws + O_VMEMT)
#define memN ((char*)p.ws + O_MEMN)
#define hend ((float*)(p.ws + O_HEND))
#define slog ((float*)(p.ws + O_SLOG))
#define carry ((float*)(p.ws + O_CARRY))
__device__ __forceinline__ void transpose_item(const Params& p, int it, LAS float* ldsf) {
  int r = it;
  if (r < 576) { transpose_tile(p.in[3], 9216, 1024, (r / 36) * 64, (r % 36) * 256, (bf16_t*)WinT, RmWin(), 1.0f, ldsf); return; } r -= 576;
  if (r < 192) { const int n_ = r >> 6, q = r & 63; transpose_tile(p.in[25] + (size_t)n_ * 1048576, 1024, 1024, (q >> 2) * 64, (q & 3) * 256, (bf16_t*)WbT + (size_t)n_ * 1048576, RmId(), 1.0f, ldsf); return; } r -= 192;
  if (r < 64) { transpose_tile(p.in[26], 1024, 1024, (r >> 2) * 64, (r & 3) * 256, (bf16_t*)WoutT, RmId(), 1.0f, ldsf); return; } r -= 64;
  if (r < 128) { transpose_tile(p.in[24], 2048, 1024, (r >> 3) * 64, (r & 7) * 256, (bf16_t*)WkvT, RmId(), 1.0f, ldsf); return; } r -= 128;
  if (r < 64) { const int mat = r >> 4, q = r & 15, h = q >> 2, kb = q & 3;
    const float* srcp = (mat == 0 ? p.in[14] : mat == 1 ? p.in[15] : mat == 2 ? p.in[16] : p.in[17]) + (size_t)h * 65536;
    bf16_t* dstp = (bf16_t*)WqT + (size_t)mat * 262144 + (size_t)h * 65536;
    transpose_tile(srcp, 256, 256, kb * 64, 0, dstp, RmId(), mat == 1 ? 0.0625f : 1.0f, ldsf); return; } r -= 64;
  { const int mat = r >> 4, q = r & 15, g = q >> 2, kb = q & 3; RmLru rm; rm.mat = mat;
    transpose_tile((mat == 0 ? p.in[7] : p.in[9]) + (size_t)g * 65536, 256, 256, kb * 64, 0, (bf16_t*)WlruT + (size_t)g * 131072, rm, 1.0f, ldsf); }
}

constexpr unsigned ALLPH = (1u << 18) - 1u;
template <unsigned MASK>
__global__ void __launch_bounds__(512) mk_fwd(Params p) {
  extern __shared__ __attribute__((aligned(16))) unsigned char smem[];
  LAS unsigned char* lds = (LAS unsigned char*)smem;
  LAS float* ldsf = (LAS float*)lds;
  LAS float* xP = (LAS float*)(lds + STAGE_BYTES);
  LAS float* xD = (LAS float*)(lds + STAGE_BYTES + 4096);
  LAS float* xW = (LAS float*)(lds + STAGE_BYTES + 5120);
  LAS float* xT = (LAS float*)(lds + STAGE_BYTES + 7168);
  cg::grid_group grid = cg::this_grid();
  volatile LAS unsigned* xst = (volatile LAS unsigned*)(lds + STAGE_BYTES + 8192);
  if (threadIdx.x == 0) { xst[0] = 0u; xst[1] = 0u; }
  __syncthreads();
  XcdBarrier xb; if constexpr (MASK == ALLPH) xb = xcd_barrier_post((unsigned*)(p.ws + O_BAR), xst);
  const int G = gridDim.x, wg = blockIdx.x, NW = G * 8, GT = G * 512;
  const float* x = p.in[0];

  if constexpr ((MASK >> 0) & 1) {
  int tid = threadIdx.x; asm volatile("" : "+v"(tid)); const int lane = tid & 63, wid = tid >> 6, gw = wg * 8 + wid, gtid = wg * 512 + tid; (void)lane; (void)gw; (void)gtid;
  {
    for (int e = wg; e < 256; e += G) {
      const int it = e < 64 ? (e >> 2) * 36 + 8 + (e & 3) : e < 192 ? 832 + (e - 64) : 960 + (e - 192);
      transpose_item(p, it, ldsf);
    }
    for (int row = gw * 4; row < T; row += NW * 4) rmsnorm_rows_bf16<4>(x + (size_t)row * 1024, p.in[2], (bf16_t*)W0 + (size_t)row * 1024, lane);
    for (int row = gw; row < 512; row += NW) rmsnorm_row_bf16(p.in[1] + (size_t)row * 1024, p.in[23], (bf16_t*)memN + (size_t)row * 1024, lane);
    for (int w = gw; w < 2048; w += NW) {
      const int which = w >> 10, i = w & 1023, h = i >> 8, ii = i & 255;
      float a[8];
#pragma unroll
      for (int j = 0; j < 8; ++j) a[j] = 0.f;
      const float* wif = p.in[19];
#pragma unroll
      for (int jj = 0; jj < 4; ++jj) { const int o = lane + 64 * jj;
        if (which == 0) {
          const float wq = p.in[14][(size_t)h * 65536 + ii * 256 + o], wk = p.in[15][(size_t)h * 65536 + ii * 256 + o];
          const f32x4 q0 = *(const f32x4*)(wif + (size_t)(h * 256 + o) * 8), q1 = *(const f32x4*)(wif + (size_t)(h * 256 + o) * 8 + 4);
          const f32x4 k0 = *(const f32x4*)(wif + (size_t)(1024 + h * 256 + o) * 8), k1 = *(const f32x4*)(wif + (size_t)(1024 + h * 256 + o) * 8 + 4);
          a[0] += wq * q0.x + wk * k0.x; a[1] += wq * q0.y + wk * k0.y; a[2] += wq * q0.z + wk * k0.z; a[3] += wq * q0.w + wk * k0.w;
          a[4] += wq * q1.x + wk * k1.x; a[5] += wq * q1.y + wk * k1.y; a[6] += wq * q1.z + wk * k1.z; a[7] += wq * q1.w + wk * k1.w;
        } else {
          const float wv = p.in[16][(size_t)h * 65536 + ii * 256 + o];
          const f32x4 v0 = *(const f32x4*)(wif + (size_t)(2048 + h * 256 + o) * 8), v1 = *(const f32x4*)(wif + (size_t)(2048 + h * 256 + o) * 8 + 4);
          a[0] += wv * v0.x; a[1] += wv * v0.y; a[2] += wv * v0.z; a[3] += wv * v0.w; a[4] += wv * v1.x; a[5] += wv * v1.y; a[6] += wv * v1.z; a[7] += wv * v1.w;
        } }
#pragma unroll
      for (int j = 0; j < 8; ++j) a[j] = wave_sum(a[j]);
      if (lane == 0) { bf16_t* d = (bf16_t*)(p.ws + O_WGT) + which * 1024 + i;
#pragma unroll
        for (int j = 0; j < 8; ++j) { d[(size_t)j * 2048] = (bf16_t)(pk2(a[j], 0.f) & 0xffffu); d[(size_t)(8 + j) * 2048] = 0; } }
    }
    for (int n = gtid; n < 9216; n += GT) binR[RmWin()((int)n)] = p.in[4][n];
  }
  }
  if constexpr (MASK == ALLPH) xcd_barrier(xb);

  if constexpr ((MASK >> 1) & 1) {
  int tid = threadIdx.x; asm volatile("" : "+v"(tid)); const int lane = tid & 63, wid = tid >> 6, gw = wg * 8 + wid, gtid = wg * 512 + tid; (void)lane; (void)gw; (void)gtid;
  {
    SchedTiles S; S.A = W0; S.Bt = WinT; S.out0 = W1; S.out1 = W1; S.bias = binR; S.nN = 4; S.G = G; S.c = wg;
    EpiBf16 E; E.m_Av = Av; E.m_Mt = Mt;
    gemm_phase<SchedTiles, EpiBf16, false>(lds, 1024, 1024, 16, 16, S, E);
  }
  }
  if constexpr (MASK == ALLPH) xcd_barrier(xb);

  if constexpr ((MASK >> 2) & 1) {
  int tid = threadIdx.x; asm volatile("" : "+v"(tid)); const int lane = tid & 63, wid = tid >> 6, gw = wg * 8 + wid, gtid = wg * 512 + tid; (void)lane; (void)gw; (void)gtid;
  {
    const int pm = wg >> 2, h = wg & 3, tok0 = pm * 256;
    conv_item<true>((const bf16_t*)W1, (bf16_t*)W2, p.in[12], p.in[13], h * 256 + (tid & 31) * 8, tok0 + (tid >> 5) * 16);
    asm volatile("s_waitcnt vmcnt(0)" ::: "memory"); __syncthreads();
    EpiBf16 E; E.m_Av = Av; E.m_Mt = Mt;
    SchedP3X SX; SX.xc = W2; SX.mx = W1; SX.wq = WqT; SX.wk = WkT; SX.wo = WoT; SX.q = W3; SX.k = W4; SX.og = W5; SX.b_o = p.in[18]; SX.G = G; SX.c = wg;
    gemm_phase<SchedP3X, EpiBf16, false>(lds, 1024, 256, 4, 4, SX, E);
    gates_tile((const bf16_t*)W2, (const bf16_t*)W1, (const bf16_t*)(p.ws + O_WGT), gates, tok0, h, wid, lane);
  }
  }
  if constexpr (MASK == ALLPH) xcd_barrier(xb);

  if constexpr ((MASK >> 3) & 1) {
  int tid = threadIdx.x; asm volatile("" : "+v"(tid)); const int lane = tid & 63, wid = tid >> 6, gw = wg * 8 + wid, gtid = wg * 512 + tid; (void)lane; (void)gw; (void)gtid;
  }


  if constexpr ((MASK >> 4) & 1) {
  int tid = threadIdx.x; asm volatile("" : "+v"(tid)); const int lane = tid & 63, wid = tid >> 6, gw = wg * 8 + wid, gtid = wg * 512 + tid; (void)lane; (void)gw; (void)gtid;
  if (wg < 8) {
    const int b = wg >> 2, h = wg & 3;
    const size_t t0 = (size_t)b * SEQ + (size_t)tid * 16;
    float c[16], ig[16];
    float run = 0.f;
    { const float bi = p.in[20][h], bf = p.in[20][4 + h];
      const float* gi = gates + (size_t)h * T + t0; const float* gf = gates + (size_t)(4 + h) * T + t0;
#pragma unroll
      for (int k4 = 0; k4 < 4; ++k4) {
        f32x4 a = *(const f32x4*)(gi + 4 * k4), f = *(const f32x4*)(gf + 4 * k4);
#pragma unroll
        for (int hh = 1; hh < 4; ++hh) { a = a + *(const f32x4*)(gi + (size_t)hh * 8 * T + 4 * k4); f = f + *(const f32x4*)(gf + (size_t)hh * 8 * T + 4 * k4); }
#pragma unroll
        for (int e = 0; e < 4; ++e) { ig[4 * k4 + e] = a[e] + bi; run += logsigm(f[e] + bf); c[4 * k4 + e] = run; } } }
    const float off = block_excl_scan<false>(run, xT);
    float pmx = -3.0e38f;
#pragma unroll
    for (int k = 0; k < 16; ++k) { c[k] += off; ig[k] = ig[k] - c[k]; pmx = fmaxf(pmx, ig[k]); }
    const float offm = block_excl_scan<true>(pmx, xT);
    float rm = offm;
#pragma unroll
    for (int k = 0; k < 16; ++k) { rm = fmaxf(rm, ig[k]); const float mtv = fmaxf(rm, 0.f); Bc[(t0 + k) * 4 + h] = c[k] + mtv;   Av[(t0 + k) * 4 + h] = ig[k]; Mt[(t0 + k) * 4 + h] = mtv; }
  } else if (wg < 24) {
    const int idx = wg - 8; SchedOne S; S.has = true;
    if (idx < 8) { const int pm = idx >> 2, pn = idx & 3;
      S.u.A0 = S.u.A1 = memN + (size_t)pm * 256 * 1024 * 2; S.u.B0 = S.u.B1 = WkvT + (size_t)pn * 256 * 1024 * 2; S.u.out = Kmem + ((size_t)pm * 256 * 1024 + pn * 256) * 2; S.u.ldc = 1024; }
    else { const int pm = (idx - 8) >> 1, b = (idx - 8) & 1;
      S.u.A0 = S.u.A1 = WkvT + (size_t)(1024 + pm * 256) * 1024 * 2; S.u.B0 = S.u.B1 = memN + (size_t)b * 256 * 1024 * 2; S.u.out = VmemT + (size_t)(b * 1024 + pm * 256) * 256 * 2; S.u.ldc = 256; }
    S.u.bias = nullptr; S.u.sub = 0; S.u.row0 = 0; S.u.col0 = 0; S.u.aux0 = 0; S.u.aux1 = 0;
    EpiBf16 E; E.m_Av = Av; E.m_Mt = Mt;
    gemm_phase<SchedOne, EpiBf16, false>(lds, 1024, 1024, 16, 16, S, E);
  } else {
    for (int l = wg - 24; l < 800; l += G - 24) {
      int it;
      if (l < 512) { const int j = l & 31; it = (l >> 5) * 36 + (j < 8 ? j : j + 4); }
      else if (l < 704) it = 576 + (l - 512); else if (l < 768) it = 768 + (l - 704); else it = 1024 + (l - 768);
      transpose_item(p, it, ldsf);
    }
    EpiBf16 E; E.m_Av = Av; E.m_Mt = Mt;
    SchedP3Y SY; SY.xc = W2; SY.mx = W1; SY.wk = WkT; SY.wv = WvT; SY.vt = D0; SY.ktw = D1; SY.G = G - 24; SY.c = wg - 24; SY.base = 0; SY.count = 256;
    gemm_phase<SchedP3Y, EpiBf16, false>(lds, 256, 1024, 4, 4, SY, E);
  }
  }
  if constexpr (MASK == ALLPH) xcd_barrier(xb);

  if constexpr ((MASK >> 5) & 1) {
  int tid = threadIdx.x; asm volatile("" : "+v"(tid)); const int lane = tid & 63, wid = tid >> 6, gw = wg * 8 + wid, gtid = wg * 512 + tid; (void)lane; (void)gw; (void)gtid;
  { EpiBf16 E; E.m_Av = Av; E.m_Mt = Mt;
    SchedP3Y SY; SY.xc = W2; SY.mx = W1; SY.wk = WkT; SY.wv = WvT; SY.vt = D0; SY.ktw = D1; SY.G = G; SY.c = wg; SY.base = 256; SY.count = 256;
    gemm_phase<SchedP3Y, EpiBf16, false>(lds, 256, 1024, 4, 4, SY, E);
    asm volatile("s_waitcnt vmcnt(0)" ::: "memory"); __syncthreads(); }
  if (wg < 256) { const int unit = wg;
    const int bh = unit >> 5, ci = unit & 31, b = bh >> 2, h = bh & 3, tok0 = b * SEQ + ci * 256;
    { SchedOne S; S.has = true; S.u.A0 = S.u.A1 = D0 + (size_t)unit * 131072; S.u.B0 = S.u.B1 = D1 + (size_t)unit * 131072; S.u.out = W1 + (size_t)unit * 131072; S.u.bias = nullptr; S.u.ldc = 256; S.u.sub = 0;
      S.u.row0 = tok0; S.u.col0 = 0; S.u.aux0 = h; S.u.aux1 = unit;
      EpiBf16 E; E.m_Av = Av; E.m_Mt = Mt;
      gemm_phase<SchedOne, EpiBf16, false>(lds, 256, 256, 4, 4, S, E); }
    { SchedOne S; S.has = true; const size_t to = ((size_t)tok0 * 1024 + h * 256) * 2;
      S.u.A0 = S.u.A1 = W3 + to; S.u.B0 = S.u.B1 = W4 + to; S.u.out = W0 + to; S.u.bias = nullptr; S.u.ldc = 1024; S.u.sub = 0; S.u.row0 = tok0; S.u.col0 = 0; S.u.aux0 = h; S.u.aux1 = unit;
      EpiU1 E; E.m_Av = Av; E.m_Mt = Mt; E.m_denp = denp;
      gemm_phase<SchedOne, EpiU1, false>(lds, 1024, 1024, 4, 4, S, E); }
    { const float mprev = ci == 0 ? 0.f : Mt[(size_t)(tok0 - 1) * 4 + h];
      const int r = tid >> 1, hf = tid & 1;
      const float sc = __expf(mprev - Mt[(size_t)(tok0 + r) * 4 + h]);
      u32x4* qp = (u32x4*)((bf16_t*)W3 + (size_t)(tok0 + r) * 1024 + h * 256 + hf * 128);
      u32x4 v[16];
#pragma unroll
      for (int i = 0; i < 16; ++i) v[i] = qp[i];
#pragma unroll
      for (int i = 0; i < 16; ++i) { u32x4 o;
        o.x = pk2(bf_lo(v[i].x) * sc, bf_hi(v[i].x) * sc); o.y = pk2(bf_lo(v[i].y) * sc, bf_hi(v[i].y) * sc); o.z = pk2(bf_lo(v[i].z) * sc, bf_hi(v[i].z) * sc); o.w = pk2(bf_lo(v[i].w) * sc, bf_hi(v[i].w) * sc); qp[i] = o; } }
    { const float me = Mt[(size_t)(tok0 + 255) * 4 + h];
      if (tid < 256) xW[tid] = __expf(Av[(size_t)(tok0 + tid) * 4 + h] - me);
      __syncthreads();
      const int cg8 = tid & 31, sg = tid >> 5;
      const bf16_t* kp = (const bf16_t*)W4 + (size_t)(tok0 + sg * 16) * 1024 + h * 256 + cg8 * 8;
      u32x4 v[16];
#pragma unroll
      for (int i = 0; i < 16; ++i) v[i] = *(const u32x4*)(kp + (size_t)i * 1024);
      float a[8];
#pragma unroll
      for (int j = 0; j < 8; ++j) a[j] = 0.f;
#pragma unroll
      for (int i = 0; i < 16; ++i) { const float w = xW[sg * 16 + i];
        a[0] += w * bf_lo(v[i].x); a[1] += w * bf_hi(v[i].x); a[2] += w * bf_lo(v[i].y); a[3] += w * bf_hi(v[i].y); a[4] += w * bf_lo(v[i].z); a[5] += w * bf_hi(v[i].z); a[6] += w * bf_lo(v[i].w); a[7] += w * bf_hi(v[i].w); }
#pragma unroll
      for (int j = 0; j < 8; ++j) ldsf[sg * 256 + cg8 * 8 + j] = a[j];
      __syncthreads();
      if (tid < 256) { float s = 0.f;
#pragma unroll
        for (int g2 = 0; g2 < 16; ++g2) s += ldsf[g2 * 256 + tid];
        nkloc[(size_t)unit * 256 + tid] = s; }
      __syncthreads(); }
  }
  }
  if constexpr (MASK == ALLPH) xcd_barrier(xb);

  if constexpr ((MASK >> 6) & 1) {
  int tid = threadIdx.x; asm volatile("" : "+v"(tid)); const int lane = tid & 63, wid = tid >> 6, gw = wg * 8 + wid, gtid = wg * 512 + tid; (void)lane; (void)gw; (void)gtid;
  {
    for (int g = gtid; g < 131072; g += GT) {
      const int bh = (int)(g >> 14), e4 = (int)(g & 16383), b = bh >> 2, h = bh & 3;
      u32x2* base = (u32x2*)((bf16_t*)W1 + (size_t)bh * 32 * 65536 + (size_t)e4 * 4);
      u32x2 kv[32]; float me[32];
#pragma unroll
      for (int c = 0; c < 32; ++c) { kv[c] = base[(size_t)c * 16384]; me[c] = Mt[(size_t)(b * SEQ + c * 256 + 255) * 4 + h]; }
      float C0 = 0.f, C1 = 0.f, C2 = 0.f, C3 = 0.f; float mprev = 0.f;
#pragma unroll
      for (int c = 0; c < 32; ++c) {
        const float dec = __expf(mprev - me[c]); mprev = me[c];
        u32x2 w; w.x = pk2(C0, C1); w.y = pk2(C2, C3); base[(size_t)c * 16384] = w;
        C0 = dec * C0 + bf_lo(kv[c].x); C1 = dec * C1 + bf_hi(kv[c].x); C2 = dec * C2 + bf_lo(kv[c].y); C3 = dec * C3 + bf_hi(kv[c].y);
      }
    }
    for (int g = gtid; g < 2048; g += GT) {
      const int bh = (int)(g >> 8), col = (int)(g & 255), b = bh >> 2, h = bh & 3;
      float nk[32], me[32];
#pragma unroll
      for (int c = 0; c < 32; ++c) { nk[c] = nkloc[(size_t)(bh * 32 + c) * 256 + col]; me[c] = Mt[(size_t)(b * SEQ + c * 256 + 255) * 4 + h]; }
      float n = 0.f, mprev = 0.f;
#pragma unroll
      for (int c = 0; c < 32; ++c) { const float dec = __expf(mprev - me[c]); mprev = me[c]; nprev[(size_t)(bh * 32 + c) * 256 + col] = n; n = dec * n + nk[c]; }
    }
    for (int row = gw * 4; row < T; row += NW * 4) rmsnorm_rows_bf16<4>(x + (size_t)row * 1024, p.in[2], (bf16_t*)W4 + (size_t)row * 1024, lane);
  }
  }
  if constexpr (MASK == ALLPH) xcd_barrier(xb);

  if constexpr ((MASK >> 7) & 1) {
  int tid = threadIdx.x; asm volatile("" : "+v"(tid)); const int lane = tid & 63, wid = tid >> 6, gw = wg * 8 + wid, gtid = wg * 512 + tid; (void)lane; (void)gw; (void)gtid;
  if (wg < 256) { const int unit = wg;
    const int bh = unit >> 5, ci = unit & 31, b = bh >> 2, h = bh & 3, tok0 = b * SEQ + ci * 256;
    { if (tid < 256) xW[tid] = nprev[(size_t)unit * 256 + tid];
      __syncthreads();
      const int r = tid >> 1, hf = tid & 1;
      const u32x4* qp = (const u32x4*)((const bf16_t*)W3 + (size_t)(tok0 + r) * 1024 + h * 256 + hf * 128);
      u32x4 v[16];
#pragma unroll
      for (int i = 0; i < 16; ++i) v[i] = qp[i];
      float s = 0.f;
#pragma unroll
      for (int i = 0; i < 16; ++i) { const LAS float* nv = xW + hf * 128 + i * 8;
        const f32x4 n0 = *(const LAS f32x4*)nv, n1 = *(const LAS f32x4*)(nv + 4);
        s += bf_lo(v[i].x) * n0.x + bf_hi(v[i].x) * n0.y + bf_lo(v[i].y) * n0.z + bf_hi(v[i].y) * n0.w + bf_lo(v[i].z) * n1.x + bf_hi(v[i].z) * n1.y + bf_lo(v[i].w) * n1.z + bf_hi(v[i].w) * n1.w; }
      s += __shfl_xor(s, 1);
      if (hf == 0) xD[r] = s;
      __syncthreads(); }
    SchedOne S; S.has = true; const size_t to = ((size_t)tok0 * 1024 + h * 256) * 2;
    S.u.A0 = W0 + to; S.u.A1 = W3 + to; S.u.B0 = D0 + (size_t)unit * 131072; S.u.B1 = W1 + (size_t)unit * 131072;
    S.u.out = nullptr; S.u.bias = nullptr; S.u.ldc = 1024; S.u.sub = 0; S.u.row0 = tok0; S.u.col0 = 0; S.u.aux0 = h; S.u.aux1 = unit;
    EpiU2 E; E.P = xP; E.deni = xD; E.m_denp = denp; E.m_Bc = Bc; E.m_Mt = Mt; E.og = (const bf16_t*)W5; E.norm_g = p.in[21]; E.skip = p.in[22]; E.xc = (bf16_t*)W2;
    gemm_phase<SchedOne, EpiU2, true>(lds, 1024, 256, 8, 4, S, E);
    __syncthreads();
  }
  }
  if constexpr (MASK == ALLPH) xcd_barrier(xb);

  if constexpr ((MASK >> 8) & 1) {
  int tid = threadIdx.x; asm volatile("" : "+v"(tid)); const int lane = tid & 63, wid = tid >> 6, gw = wg * 8 + wid, gtid = wg * 512 + tid; (void)lane; (void)gw; (void)gtid;
  {
    SchedTiles S; S.A = W4; S.Bt = WinT + (size_t)1024 * 1024 * 2; S.out0 = W0; S.out1 = W1; S.bias = binR + 1024; S.nN = 8; S.G = G; S.c = wg;
    EpiBf16 E; E.m_Av = Av; E.m_Mt = Mt;
    gemm_phase<SchedTiles, EpiBf16, false>(lds, 1024, 1024, 16, 16, S, E);
  }
  }
  if constexpr (MASK == ALLPH) xcd_barrier(xb);

  if constexpr ((MASK >> 9) & 1) {
  int tid = threadIdx.x; asm volatile("" : "+v"(tid)); const int lane = tid & 63, wid = tid >> 6, gw = wg * 8 + wid, gtid = wg * 512 + tid; (void)lane; (void)gw; (void)gtid;
  {
    conv_stream<false>((const bf16_t*)W0, (bf16_t*)W3, p.in[5], p.in[6], gtid, GT);
    if (wg < 256) { const int L = wg;
      const int pm = L >> 2, h = L & 3, b = pm >> 5;
      { SchedOne S; S.has = true;
        S.u.A0 = S.u.A1 = W1 + ((size_t)pm * 256 * 1024 + h * 256) * 2; S.u.B0 = S.u.B1 = Kmem + ((size_t)b * 256 * 1024 + h * 256) * 2; S.u.out = W5 + (size_t)L * 131072; S.u.bias = nullptr; S.u.ldc = 256; S.u.sub = 0;
        S.u.row0 = 0; S.u.col0 = 0; S.u.aux0 = 0; S.u.aux1 = 0;
        EpiSoftmax E; E.P = xP;
        gemm_phase<SchedOne, EpiSoftmax, true>(lds, 1024, 1024, 4, 4, S, E); }
      asm volatile("s_waitcnt vmcnt(0)" ::: "memory"); __syncthreads();
      { SchedOne S; S.has = true;
        S.u.A0 = S.u.A1 = W5 + (size_t)L * 131072; S.u.B0 = S.u.B1 = VmemT + (size_t)(b * 1024 + h * 256) * 256 * 2; S.u.out = D0 + ((size_t)pm * 256 * 1024 + h * 256) * 2; S.u.bias = nullptr; S.u.ldc = 1024; S.u.sub = 0;
        S.u.row0 = 0; S.u.col0 = 0; S.u.aux0 = 0; S.u.aux1 = 0;
        EpiBf16 E; E.m_Av = Av; E.m_Mt = Mt;
        gemm_phase<SchedOne, EpiBf16, false>(lds, 256, 256, 4, 4, S, E); }
      __syncthreads();
    }
  }
  }
  if constexpr (MASK == ALLPH) xcd_barrier(xb);

  if constexpr ((MASK >> 10) & 1) {
  int tid = threadIdx.x; asm volatile("" : "+v"(tid)); const int lane = tid & 63, wid = tid >> 6, gw = wg * 8 + wid, gtid = wg * 512 + tid; (void)lane; (void)gw; (void)gtid;
  {
    SchedLru S; S.u_ = W3; S.wl = WlruT; S.G = G; S.c = wg;
    EpiLru E; E.b_a = p.in[8]; E.b_x = p.in[10]; E.lam = p.in[11]; E.u = (const bf16_t*)W3; E.loga = (bf16_t*)W0; E.bb = (bf16_t*)W1;
    gemm_phase<SchedLru, EpiLru, false>(lds, 1024, 256, 4, 4, S, E);
    asm volatile("s_waitcnt vmcnt(0)" ::: "memory"); __syncthreads();
#pragma unroll 1
    for (int i = 0; i < 2; ++i) { const int L = i * G + wg; if (L < 512) {
      const int pm = (L & 7) * 8 + (L >> 6), pn = (L >> 3) & 7;
      const int ch = (pn >> 1) * 256 + (pn & 1) * 128 + (tid & 127), j = pm * 4 + (tid >> 7);
      const bf16_t* la = (const bf16_t*)W0 + (size_t)j * 64 * 1024 + ch; const bf16_t* bp = (const bf16_t*)W1 + (size_t)j * 64 * 1024 + ch;
      float h = 0.f, s = 0.f;
#pragma unroll 16
      for (int t = 0; t < 64; ++t) { const float l = bf2f(la[(size_t)t * 1024]); h = __expf(l) * h + bf2f(bp[(size_t)t * 1024]); s += l; }
      hend[(size_t)j * 1024 + ch] = h; slog[(size_t)j * 1024 + ch] = s; } }
  }
  }
  if constexpr (MASK == ALLPH) xcd_barrier(xb);

  if constexpr ((MASK >> 11) & 1) {
  int tid = threadIdx.x; asm volatile("" : "+v"(tid)); const int lane = tid & 63, wid = tid >> 6, gw = wg * 8 + wid, gtid = wg * 512 + tid; (void)lane; (void)gw; (void)gtid;
  }

  if constexpr ((MASK >> 12) & 1) {
  int tid = threadIdx.x; asm volatile("" : "+v"(tid)); const int lane = tid & 63, wid = tid >> 6, gw = wg * 8 + wid, gtid = wg * 512 + tid; (void)lane; (void)gw; (void)gtid;
  }

  if constexpr ((MASK >> 13) & 1) {
  int tid = threadIdx.x; asm volatile("" : "+v"(tid)); const int lane = tid & 63, wid = tid >> 6, gw = wg * 8 + wid, gtid = wg * 512 + tid; (void)lane; (void)gw; (void)gtid;
  for (int g = gtid; g < 131072; g += GT) {
    const int cp = (int)(g & 511), j = (int)(g >> 9);
    const unsigned* la = (const unsigned*)((const bf16_t*)W0 + (size_t)j * 64 * 1024 + cp * 2);
    const unsigned* bp = (const unsigned*)((const bf16_t*)W1 + (size_t)j * 64 * 1024 + cp * 2);
    unsigned* yo = (unsigned*)((bf16_t*)W3 + (size_t)j * 64 * 1024 + cp * 2);
    float h0 = 0.f, h1 = 0.f;
    { const int jb = (j >> 7) * 128, jl = j & 127;
#pragma unroll 8
      for (int jj = 0; jj < jl; ++jj) { const size_t o = (size_t)(jb + jj) * 1024 + cp * 2;
        const float sx = slog[o], sy = slog[o + 1], ex = hend[o], ey = hend[o + 1];
        h0 = __expf(sx) * h0 + ex; h1 = __expf(sy) * h1 + ey; } }
#pragma unroll 1
    for (int tb = 0; tb < 64; tb += 16) {
      unsigned av[16], bw[16];
#pragma unroll
      for (int t = 0; t < 16; ++t) { av[t] = la[(size_t)(tb + t) * 512]; bw[t] = bp[(size_t)(tb + t) * 512]; }
#pragma unroll
      for (int t = 0; t < 16; ++t) { h0 = __expf(bf_lo(av[t])) * h0 + bf_lo(bw[t]); h1 = __expf(bf_hi(av[t])) * h1 + bf_hi(bw[t]); yo[(size_t)(tb + t) * 512] = pk2(h0, h1); }
    }
  }
  }
  if constexpr (MASK == ALLPH) xcd_barrier(xb);

  if constexpr ((MASK >> 14) & 1) {
  int tid = threadIdx.x; asm volatile("" : "+v"(tid)); const int lane = tid & 63, wid = tid >> 6, gw = wg * 8 + wid, gtid = wg * 512 + tid; (void)lane; (void)gw; (void)gtid;
  {
    SchedZ S; S.hn = W4; S.wint = WinT; S.y0 = W3; S.y1 = W2; S.y2 = D0; S.binr = binR; S.G = G; S.c = wg;
    EpiZ E;
    gemm_phase<SchedZ, EpiZ, false>(lds, 1024, 1024, 16, 16, S, E);
  }
  }
  if constexpr (MASK == ALLPH) xcd_barrier(xb);

  if constexpr ((MASK >> 15) & 1) {
  int tid = threadIdx.x; asm volatile("" : "+v"(tid)); const int lane = tid & 63, wid = tid >> 6, gw = wg * 8 + wid, gtid = wg * 512 + tid; (void)lane; (void)gw; (void)gtid;
  {
    SchedMerge S; S.hn = W4; S.wint = WinT; S.wbt = WbT; S.y0 = W3; S.y1 = W2; S.y2 = D0; S.binr = binR; S.G = G; S.c = wg;
    EpiMerge E; E.gsc = (bf16_t*)D1; E.macc = (float*)W0; E.merged = (bf16_t*)W5;
    gemm_phase<SchedMerge, EpiMerge, false>(lds, 1024, 1024, 16, 16, S, E);
  }
  }
  if constexpr (MASK == ALLPH) xcd_barrier(xb);

  if constexpr ((MASK >> 16) & 1) {
  int tid = threadIdx.x; asm volatile("" : "+v"(tid)); const int lane = tid & 63, wid = tid >> 6, gw = wg * 8 + wid, gtid = wg * 512 + tid; (void)lane; (void)gw; (void)gtid;
  {
    int pm, pn; SchedOne S; S.has = static_tile((long)wg, 64, 4, pm, pn);
    S.u.A0 = S.u.A1 = W5 + (size_t)pm * 256 * 1024 * 2; S.u.B0 = S.u.B1 = WoutT + (size_t)pn * 256 * 1024 * 2; S.u.out = nullptr; S.u.bias = nullptr; S.u.ldc = 1024; S.u.sub = 0;
    S.u.row0 = pm * 256; S.u.col0 = pn * 256; S.u.aux0 = pm; S.u.aux1 = pn;
    EpiOutNorm E; E.x = x; E.out = p.out; E.g = p.in[27]; E.P = xP; E.xch = (float*)(p.ws + O_XCH); E.cnt = (unsigned*)(p.ws + O_CNT);
    gemm_phase<SchedOne, EpiOutNorm, true>(lds, 1024, 1024, 16, 16, S, E);
  }
  }


  if constexpr ((MASK >> 17) & 1) {
  int tid = threadIdx.x; asm volatile("" : "+v"(tid)); const int lane = tid & 63, wid = tid >> 6, gw = wg * 8 + wid, gtid = wg * 512 + tid; (void)lane; (void)gw; (void)gtid;
  }
}

#ifndef MK_SINGLE
#define MK_SINGLE 1
#endif
template <unsigned MASK>
static void launch_phase(const Params& p, int grid, size_t lds, hipStream_t stream) {
  static bool attr = false;
  if (!attr) { (void)hipFuncSetAttribute((const void*)mk_fwd<MASK>, hipFuncAttributeMaxDynamicSharedMemorySize, (int)lds); attr = true; }
  hipLaunchKernelGGL(mk_fwd<MASK>, dim3(grid), dim3(512), lds, stream, p);
}
extern "C" void kernel_launch(void* const* d_in, const int* in_sizes, int n_in, void* d_out, int out_size, void* d_ws, size_t ws_size, hipStream_t stream) {
  constexpr size_t kDynLds = STAGE_BYTES + 16384;
  static int grid_blocks = 0;
  if (!grid_blocks) {
    int dev = 0, cus = 0, per_cu = 0;
    (void)hipGetDevice(&dev);
    (void)hipDeviceGetAttribute(&cus, hipDeviceAttributeMultiprocessorCount, dev);
#if MK_SINGLE
    (void)hipFuncSetAttribute((const void*)mk_fwd<ALLPH>, hipFuncAttributeMaxDynamicSharedMemorySize, (int)kDynLds);
    (void)hipOccupancyMaxActiveBlocksPerMultiprocessor(&per_cu, (const void*)mk_fwd<ALLPH>, 512, kDynLds);
    if (per_cu < 1) fprintf(stderr, "occupancy query says %d blocks/CU\n", per_cu);
#endif
    if (ws_size < WS_NEED) fprintf(stderr, "workspace too small: %zu < %zu\n", ws_size, (size_t)WS_NEED);
    grid_blocks = 256; if (cus < 256) fprintf(stderr, "this kernel needs 256 CUs, device has %d\n", cus);
  }
  Params p{};
  for (int i = 0; i < 28; ++i) p.in[i] = (const float*)d_in[i];
  p.out = (float*)d_out; p.ws = (unsigned char*)d_ws;
#if MK_SINGLE
  (void)hipMemsetAsync((unsigned char*)d_ws + O_BAR, 0, 32768, stream);
  void* args[] = {&p};
  hipError_t e = hipLaunchCooperativeKernel((void*)mk_fwd<ALLPH>, dim3(grid_blocks), dim3(512), args, kDynLds, stream);
  if (e != hipSuccess) fprintf(stderr, "cooperative launch failed: %s (grid %d)\n", hipGetErrorString(e), grid_blocks);
#else
  const int g = grid_blocks;
  launch_phase<1u << 0>(p, g, kDynLds, stream); launch_phase<1u << 1>(p, g, kDynLds, stream); launch_phase<1u << 2>(p, g, kDynLds, stream); launch_phase<1u << 3>(p, g, kDynLds, stream);
  launch_phase<1u << 4>(p, g, kDynLds, stream); launch_phase<1u << 5>(p, g, kDynLds, stream); launch_phase<1u << 6>(p, g, kDynLds, stream); launch_phase<1u << 7>(p, g, kDynLds, stream);
  launch_phase<1u << 8>(p, g, kDynLds, stream); launch_phase<1u << 9>(p, g, kDynLds, stream); launch_phase<1u << 10>(p, g, kDynLds, stream); launch_phase<1u << 11>(p, g, kDynLds, stream);
  launch_phase<1u << 12>(p, g, kDynLds, stream); launch_phase<1u << 13>(p, g, kDynLds, stream); launch_phase<1u << 14>(p, g, kDynLds, stream); launch_phase<1u << 15>(p, g, kDynLds, stream);
  launch_phase<1u << 16>(p, g, kDynLds, stream); launch_phase<1u << 17>(p, g, kDynLds, stream);
#endif
}
```

```cpp
#include <hip/hip_runtime.h>
#include <hip/hip_cooperative_groups.h>
#include <cstdio>
namespace cg = cooperative_groups;

#define LAS __attribute__((address_space(3)))
typedef unsigned short bf16_t;
typedef short bf16x8 __attribute__((ext_vector_type(8)));
typedef float f32x4 __attribute__((ext_vector_type(4)));
typedef unsigned u32x4 __attribute__((ext_vector_type(4)));
typedef unsigned u32x2 __attribute__((ext_vector_type(2)));

constexpr int T = 16384, DM = 1024, SEQ = 8192;
constexpr size_t SLOT = (size_t)T * DM * 2;

constexpr size_t O_WINT = 0;
constexpr size_t O_WBT = O_WINT + (size_t)9216 * 1024 * 2;
constexpr size_t O_WOUTT = O_WBT + (size_t)3 * 1024 * 1024 * 2;
constexpr size_t O_WKVT = O_WOUTT + (size_t)1024 * 1024 * 2;
constexpr size_t O_WQT = O_WKVT + (size_t)2048 * 1024 * 2;
constexpr size_t O_WKT = O_WQT + 524288;
constexpr size_t O_WVT = O_WKT + 524288;
constexpr size_t O_WOT = O_WVT + 524288;
constexpr size_t O_WLRUT = O_WOT + 524288;
constexpr size_t O_BINR = O_WLRUT + 1048576;
constexpr size_t O_WXC = O_BINR + 36864;
constexpr size_t O_WXM = O_WXC + 32768;
constexpr size_t O_GATES = O_WXM + 32768;
constexpr size_t O_BC = O_GATES + (size_t)T * 32 * 4;
constexpr size_t O_AV = O_BC + (size_t)T * 4 * 4;
constexpr size_t O_MT = O_AV + (size_t)T * 4 * 4;
constexpr size_t O_DENP = O_MT + (size_t)T * 4 * 4;
constexpr size_t O_NKLOC = O_DENP + 1048576;
constexpr size_t O_NPREV = O_NKLOC + 262144;
constexpr size_t O_KMEM = O_NPREV + 262144;
constexpr size_t O_VMEMT = O_KMEM + 1048576;
constexpr size_t O_MEMN = O_VMEMT + 1048576;
constexpr size_t O_HEND = O_MEMN + 1048576;
constexpr size_t O_SLOG = O_HEND + 1048576;
constexpr size_t O_CARRY = O_SLOG + 1048576;
constexpr size_t O_BAR = O_CARRY + 1048576;
constexpr size_t O_CNT = O_BAR + 16384;
constexpr size_t O_XCH = O_CNT + 16384;
constexpr size_t O_WGT = O_XCH + 262144;
constexpr size_t O_SMALL_END = O_WGT + 65536;
constexpr size_t O_SLOTS = (size_t)46 * 1024 * 1024;
static_assert(O_SMALL_END <= O_SLOTS, "small region overflow");
constexpr size_t WS_NEED = O_SLOTS + 6 * SLOT;

struct Params { const float* in[28]; float* out; unsigned char* ws; };

__device__ __forceinline__ unsigned pk2(float lo, float hi) { unsigned r; asm volatile("v_cvt_pk_bf16_f32 %0, %1, %2" : "=v"(r) : "v"(lo), "v"(hi)); return r; }
__device__ __forceinline__ float bf_lo(unsigned w) { return __uint_as_float(w << 16); }
__device__ __forceinline__ float bf_hi(unsigned w) { return __uint_as_float(w & 0xffff0000u); }
__device__ __forceinline__ float bf2f(bf16_t b) { return __uint_as_float(((unsigned)b) << 16); }
__device__ __forceinline__ float sigm(float x) { return 1.0f / (1.0f + __expf(-x)); }
__device__ __forceinline__ float sigmf(float x) { return __builtin_amdgcn_rcpf(1.0f + __expf(-x)); }
__device__ __forceinline__ float sigmn(float x) { const float d = 1.0f + __expf(fminf(-x, 80.0f)); float r = __builtin_amdgcn_rcpf(d); return fmaf(fmaf(-d, r, 1.0f), r, r); }
__device__ __forceinline__ float logsigm(float x) { return fminf(x, 0.f) - log1pf(expf(-fabsf(x))); }
__device__ __forceinline__ float wave_sum(float v) {
#pragma unroll
  for (int o = 1; o < 64; o <<= 1) v += __shfl_xor(v, o);
  return v;
}

constexpr int BM = 256, BK = 64, HALF = 128, HTB = HALF * BK * 2, STAGE_BYTES = 8 * HTB;
__device__ __forceinline__ int lds_byte(int r, int c) { const int st = (r >> 4) * 2 + (c >> 5), rr = r & 15, cc = c & 31, ob = rr * 64 + cc * 2; return st * 1024 + (ob ^ (((ob >> 9) & 1) << 5)); }
__device__ __forceinline__ void stage_rc(int b, int& R, int& C) { const int st = b / 1024, sb = b % 1024, swz = sb ^ (((sb >> 9) & 1) << 5); R = (st >> 1) * 16 + swz / 64; C = (st & 1) * 32 + (swz % 64) / 2; }

__device__ __forceinline__ int perm32(int rho) { const int n = rho >> 4, i = rho & 15; return 8 * (i >> 2) + 4 * n + (i & 3); }
struct UnitD { const char* A0; const char* A1; const char* B0; const char* B1; char* out; const float* bias; int ldc, sub, row0, col0, aux0, aux1; };

__device__ __forceinline__ bool static_tile(long L, int nM, int nN, int& pm, int& pn) {
  const int nwg = nM * nN; if (L >= nwg) return false;
  int wgid = (int)L; { const int q = nwg / 8, r = nwg % 8, xcd = wgid % 8, off = wgid / 8; wgid = (xcd < r ? xcd * (q + 1) : r * (q + 1) + (xcd - r) * q) + off; }
  const int nig = 8 * nN, gid = wgid / nig, fm = gid * 8, gsz = (nM - fm) < 8 ? (nM - fm) : 8;
  pm = fm + ((wgid % nig) % gsz); pn = (wgid % nig) / gsz; return true;
}

#define ROWOF(ai, m) (128 * (ai) + 64 * wr + 16 * (m) + fr)
#define COLOF(bj, n) (128 * (bj) + 32 * wc + 8 * fq + 4 * (n))
#define UNR _Pragma("unroll")

#ifndef GP_SP2
#define GP_SP2 0
#endif
#ifndef GP_ALIGN
#define GP_ALIGN 1
#endif
template <class Sched, class Epi, bool DRAIN>
__device__ __forceinline__ void gemm_phase(LAS unsigned char* lds, const int lda, const int ldb, const int nt, const int nt0, const Sched& S, const Epi& E) {
  int tid = threadIdx.x; asm volatile("" : "+v"(tid));
  const int wid = __builtin_amdgcn_readfirstlane(tid >> 6), lane = tid & 63, wr = wid >> 2, wc = wid & 3, fr = lane & 15, fq = lane >> 4;
  unsigned voffA, voffB;
  { int R, C; stage_rc(tid * 16, R, C); const int Rb = (R & ~31) + perm32(R & 31); voffA = (unsigned)(R * lda + C) * 2u; voffB = (unsigned)(Rb * ldb + C) * 2u; }
  const size_t qstepA = (size_t)64 * lda * 2, qstepB = (size_t)64 * ldb * 2;
  const size_t kstep = (size_t)(BK * 2);
  const size_t hstepA = (size_t)HALF * lda * 2, hstepB = (size_t)HALF * ldb * 2;
  const unsigned ldsw = (unsigned)wid * 1024u;
  const int aoff = lds_byte(wr * 64 + fr, fq * 8), boff = lds_byte(wc * 32 + fr, fq * 8);
#define G_SA(b, h) (((b) * 2 + (h)) * HTB)
#define G_SB(b, h) ((4 + (b) * 2 + (h)) * HTB)
#define qoffA qstepA
#define qoffB qstepB
#define voffA_ voffA
#define G_STAGE(bufoff, gbase, voff) do { _Pragma("unroll") for (int _i = 0; _i < 2; ++_i) \
    __builtin_amdgcn_global_load_lds((const unsigned*)((const char*)(gbase) + (size_t)_i * q##voff + v##voff), (LAS unsigned*)(lds + (bufoff) + ldsw + _i * 8192), 16, 0, 0); } while (0)
#define G_LDA(dst, b, h) do { _Pragma("unroll") for (int m = 0; m < 4; ++m) _Pragma("unroll") for (int k = 0; k < 2; ++k) dst[m][k] = *(const LAS bf16x8*)(lds + G_SA(b, h) + aoff + m * 2048 + k * 1024); } while (0)
#define G_LDB(dst, b, h) do { _Pragma("unroll") for (int n = 0; n < 2; ++n) _Pragma("unroll") for (int k = 0; k < 2; ++k) dst[n][k] = *(const LAS bf16x8*)(lds + G_SB(b, h) + boff + n * 2048 + k * 1024); } while (0)
#define G_MMA(ai, bj, At, Bt) do { __builtin_amdgcn_s_setprio(1); _Pragma("unroll") for (int m = 0; m < 4; ++m) _Pragma("unroll") for (int n = 0; n < 2; ++n) _Pragma("unroll") for (int k = 0; k < 2; ++k) \
    acc[ai][bj][m][n] = __builtin_amdgcn_mfma_f32_16x16x32_bf16(Bt[n][k], At[m][k], acc[ai][bj][m][n], 0, 0, 0); __builtin_amdgcn_s_setprio(0); } while (0)
#define G_WAIT_V(n) asm volatile("s_waitcnt vmcnt(" #n ")" ::: "memory")
#define G_WAIT_L(n) asm volatile("s_waitcnt lgkmcnt(" #n ")" ::: "memory")
#define G_BAR __builtin_amdgcn_s_barrier()
#define G_SCHED __builtin_amdgcn_sched_barrier(0)
  UnitD cur, nxt; int ui = 0;
  if (!S.next(0, cur)) return;
  f32x4 acc[2][2][4][2];
#pragma unroll
  for (int a = 0; a < 2; ++a)
#pragma unroll
    for (int b = 0; b < 2; ++b)
#pragma unroll
      for (int m = 0; m < 4; ++m)
#pragma unroll
        for (int n = 0; n < 2; ++n) acc[a][b][m][n] = (f32x4){0.f, 0.f, 0.f, 0.f};
  bf16x8 At[4][2], B0[2][2], B1[2][2];
  {
    const char* cA = cur.A0; const char* cB = cur.B0;
#if GP_SP2
    G_STAGE(G_SB(0, 0), cB, offB); G_STAGE(G_SB(0, 1), cB + hstepB, offB); G_STAGE(G_SA(0, 0), cA, offA); G_STAGE(G_SA(0, 1), cA + hstepA, offA);
    if (wr == 1) G_BAR;
    G_WAIT_V(2); G_BAR;
    G_STAGE(G_SB(1, 0), cB + kstep, offB); G_STAGE(G_SA(1, 0), cA + kstep, offA); G_STAGE(G_SB(1, 1), cB + hstepB + kstep, offB);
    G_WAIT_V(6); G_BAR;
#else
    G_STAGE(G_SB(0, 0), cB, offB); G_STAGE(G_SA(0, 0), cA, offA); G_STAGE(G_SB(0, 1), cB + hstepB, offB); G_STAGE(G_SA(0, 1), cA + hstepA, offA);
    if (wr == 1) G_BAR;
    G_WAIT_V(4); G_BAR;
    G_STAGE(G_SB(1, 0), cB + kstep, offB); G_STAGE(G_SA(1, 0), cA + kstep, offA); G_STAGE(G_SB(1, 1), cB + hstepB + kstep, offB);
    G_WAIT_V(6); G_BAR;
#endif
  }
  for (;;) {
    const bool has_next = S.next(ui + 1, nxt);
    const char* nA = has_next ? nxt.A0 : cur.A0; const char* nB = has_next ? nxt.B0 : cur.B0;
    for (int t = 0; t < nt; t += 2) {
      const bool last = (t == nt - 2);
      const char* a1 = (t + 1 < nt0) ? cur.A0 + (size_t)(t + 1) * kstep : cur.A1 + (size_t)(t + 1 - nt0) * kstep;
      const char* a2; const char* b2;
      if (last) { a2 = nA; b2 = nB; }
      else if (t + 2 < nt0) { a2 = cur.A0 + (size_t)(t + 2) * kstep; b2 = cur.B0 + (size_t)(t + 2) * kstep; }
      else { a2 = cur.A1 + (size_t)(t + 2 - nt0) * kstep; b2 = cur.B1 + (size_t)(t + 2 - nt0) * kstep; }
      const char* a3 = a2 + kstep; const char* b3 = b2 + kstep;
#if GP_SP2
      G_LDB(B0, 0, 0); G_LDB(B1, 0, 1); G_SCHED; G_LDA(At, 0, 0); G_STAGE(G_SA(1, 1), a1 + hstepA, offA);
      G_WAIT_V(8); G_WAIT_L(0); G_BAR; G_MMA(0, 0, At, B0); G_MMA(0, 1, At, B1); G_BAR; G_SCHED;
      G_LDA(At, 0, 1); G_STAGE(G_SB(0, 0), b2, offB); G_STAGE(G_SB(0, 1), b2 + hstepB, offB); G_STAGE(G_SA(0, 0), a2, offA);
      G_WAIT_V(8); G_WAIT_L(0); G_BAR; G_MMA(1, 0, At, B0); G_MMA(1, 1, At, B1); G_BAR; G_SCHED;
      G_LDB(B0, 1, 0); G_LDB(B1, 1, 1); G_SCHED; G_LDA(At, 1, 0); G_STAGE(G_SA(0, 1), a2 + hstepA, offA);
      G_WAIT_V(8); G_WAIT_L(0); G_BAR; G_MMA(0, 0, At, B0); G_MMA(0, 1, At, B1); G_BAR; G_SCHED;
      G_LDA(At, 1, 1); G_STAGE(G_SB(1, 0), b3, offB); G_STAGE(G_SB(1, 1), b3 + hstepB, offB); G_STAGE(G_SA(1, 0), a3, offA);
      G_WAIT_V(8); G_WAIT_L(0); G_BAR; G_MMA(1, 0, At, B0); G_MMA(1, 1, At, B1); G_BAR; G_SCHED;
#else
      G_LDB(B0, 0, 0); G_SCHED; G_LDA(At, 0, 0); G_STAGE(G_SA(1, 1), a1 + hstepA, offA);
      G_WAIT_L(8); G_BAR; G_WAIT_L(0); G_MMA(0, 0, At, B0); G_BAR; G_SCHED;
      G_LDB(B1, 0, 1); G_STAGE(G_SB(0, 0), b2, offB);
      G_BAR; G_WAIT_L(0); G_MMA(0, 1, At, B1); G_BAR;
      G_LDA(At, 0, 1); G_STAGE(G_SA(0, 0), a2, offA);
      G_BAR; G_WAIT_L(0); G_MMA(1, 0, At, B0); G_BAR; G_SCHED;
      G_STAGE(G_SB(0, 1), b2 + hstepB, offB);
      G_WAIT_V(6); G_BAR; G_MMA(1, 1, At, B1); G_BAR;
      G_LDB(B0, 1, 0); G_SCHED; G_LDA(At, 1, 0); G_STAGE(G_SA(0, 1), a2 + hstepA, offA);
      G_WAIT_L(8); G_BAR; G_WAIT_L(0); G_MMA(0, 0, At, B0); G_BAR; G_SCHED;
      G_LDB(B1, 1, 1); G_STAGE(G_SB(1, 0), b3, offB);
      G_BAR; G_WAIT_L(0); G_MMA(0, 1, At, B1); G_BAR;
      G_LDA(At, 1, 1); G_STAGE(G_SA(1, 0), a3, offA);
      G_BAR; G_WAIT_L(0); G_MMA(1, 0, At, B0); G_BAR; G_SCHED;
      G_STAGE(G_SB(1, 1), b3 + hstepB, offB);
      G_WAIT_V(6); G_BAR; G_MMA(1, 1, At, B1); G_BAR;
#endif
    }
#if GP_ALIGN
    if (wr == 0) G_BAR;
#endif
    if constexpr (!DRAIN) { int fr2 = fr, fq2 = fq; asm volatile("" : "+v"(fr2), "+v"(fq2)); E.run(acc, cur, wr, wc, fr2, fq2); }
    if (!has_next) break;
#pragma unroll
    for (int a = 0; a < 2; ++a)
#pragma unroll
      for (int b = 0; b < 2; ++b)
#pragma unroll
        for (int m = 0; m < 4; ++m)
#pragma unroll
          for (int n = 0; n < 2; ++n) acc[a][b][m][n] = (f32x4){0.f, 0.f, 0.f, 0.f};
    cur = nxt; ++ui;
#if GP_ALIGN
    if (wr == 1) G_BAR;
#endif
  }
  G_WAIT_V(0);
#if !GP_ALIGN
  if (wr == 0) G_BAR;
#endif
  G_BAR;
  if constexpr (DRAIN) { int fr2 = fr, fq2 = fq; asm volatile("" : "+v"(fr2), "+v"(fq2)); E.run(acc, cur, wr, wc, fr2, fq2); }
#undef G_SA
#undef G_SB
#undef G_STAGE
#undef G_LDA
#undef G_LDB
#undef G_MMA
#undef G_WAIT_V
#undef G_WAIT_L
#undef G_BAR
#undef G_SCHED
}

typedef f32x4 Acc[2][2][4][2];

template <bool MAX>
__device__ __forceinline__ void row_allreduce(float (&v)[2][4], LAS float* P, int wr, int wc, int fr, int fq) {
  UNR for (int ai = 0; ai < 2; ++ai) UNR for (int m = 0; m < 4; ++m) {
    float x = v[ai][m];
    float y = __shfl_xor(x, 16); x = MAX ? fmaxf(x, y) : x + y;
    y = __shfl_xor(x, 32); x = MAX ? fmaxf(x, y) : x + y;
    if (fq == 0) P[ROWOF(ai, m) * 4 + wc] = x;
  }
  __syncthreads();
  UNR for (int ai = 0; ai < 2; ++ai) UNR for (int m = 0; m < 4; ++m) {
    const f32x4 q = *(const LAS f32x4*)(P + ROWOF(ai, m) * 4);
    v[ai][m] = MAX ? fmaxf(fmaxf(q.x, q.y), fmaxf(q.z, q.w)) : (q.x + q.y) + (q.z + q.w);
  }
  __syncthreads();
}

struct EpiBf16 {
  const float* m_Av; const float* m_Mt;
  __device__ __forceinline__ void run(Acc& acc, const UnitD& u, int wr, int wc, int fr, int fq) const {
    bf16_t* base = (bf16_t*)u.out + (size_t)(64 * wr + fr) * u.ldc + 32 * wc + 8 * fq;
    UNR for (int bj = 0; bj < 2; ++bj) {
      f32x4 b0 = u.bias ? *(const f32x4*)(u.bias + COLOF(bj, 0)) : (f32x4){0.f, 0.f, 0.f, 0.f};
      f32x4 b1 = u.bias ? *(const f32x4*)(u.bias + COLOF(bj, 1)) : (f32x4){0.f, 0.f, 0.f, 0.f};
      if (u.sub == 2) { const float me = m_Mt[(size_t)(u.row0 + 255) * 4 + u.aux0];
        UNR for (int j = 0; j < 4; ++j) { b0[j] = __expf(m_Av[(size_t)(u.row0 + COLOF(bj, 0) + j) * 4 + u.aux0] - me); b1[j] = __expf(m_Av[(size_t)(u.row0 + COLOF(bj, 1) + j) * 4 + u.aux0] - me); } }
      UNR for (int ai = 0; ai < 2; ++ai) UNR for (int m = 0; m < 4; ++m) {
        f32x4 v0 = acc[ai][bj][m][0], v1 = acc[ai][bj][m][1];
        if (u.sub == 2) { v0 = v0 * b0; v1 = v1 * b1; } else { v0 = v0 + b0; v1 = v1 + b1; }
        if (u.sub == 1) { v0.x = sigmf(v0.x); v0.y = sigmf(v0.y); v0.z = sigmf(v0.z); v0.w = sigmf(v0.w); v1.x = sigmf(v1.x); v1.y = sigmf(v1.y); v1.z = sigmf(v1.z); v1.w = sigmf(v1.w); }
        u32x4 w; w.x = pk2(v0.x, v0.y); w.y = pk2(v0.z, v0.w); w.z = pk2(v1.x, v1.y); w.w = pk2(v1.z, v1.w);
        *(u32x4*)(base + (size_t)(128 * ai + 16 * m) * u.ldc + 128 * bj) = w;
      }
      asm volatile("" ::: "memory");
    }
  }
};
struct EpiU1 {
  const float* m_Av; const float* m_Mt; float* m_denp;
  __device__ __forceinline__ void run(Acc& acc, const UnitD& u, int wr, int wc, int fr, int fq) const {
    const int h = u.aux0, unit = u.aux1, tok0 = u.row0;
    float av[2][8];
    UNR for (int bj = 0; bj < 2; ++bj) UNR for (int j = 0; j < 8; ++j) av[bj][j] = m_Av[(size_t)(tok0 + COLOF(bj, 0) + j) * 4 + h];
    float mtv[2][4];
    UNR for (int ai = 0; ai < 2; ++ai) UNR for (int m = 0; m < 4; ++m) mtv[ai][m] = m_Mt[(size_t)(tok0 + ROWOF(ai, m)) * 4 + h];
    UNR for (int ai = 0; ai < 2; ++ai) UNR for (int m = 0; m < 4; ++m) {
      const int r = ROWOF(ai, m);
      const float mt = mtv[ai][m];
      bf16_t* rowp = (bf16_t*)u.out + (size_t)r * u.ldc;
      float rs = 0.f;
      UNR for (int bj = 0; bj < 2; ++bj) {
        float v[8];
        UNR for (int j = 0; j < 8; ++j) { const int c = COLOF(bj, 0) + j; const float w = (c <= r) ? __expf(av[bj][j] - mt) : 0.f; v[j] = acc[ai][bj][m][j >> 2][j & 3] * w; rs += v[j]; }
        u32x4 w2; w2.x = pk2(v[0], v[1]); w2.y = pk2(v[2], v[3]); w2.z = pk2(v[4], v[5]); w2.w = pk2(v[6], v[7]);
        *(u32x4*)(rowp + COLOF(bj, 0)) = w2;
      }
      rs += __shfl_xor(rs, 16); rs += __shfl_xor(rs, 32);
      if (fq == 0) m_denp[((size_t)unit * 256 + r) * 4 + wc] = rs;
      asm volatile("" ::: "memory");
    }
  }
};
struct EpiLru {
  const float* b_a; const float* b_x; const float* lam; const bf16_t* u; bf16_t* loga; bf16_t* bb;
  __device__ __forceinline__ void run(Acc& acc, const UnitD& ud, int wr, int wc, int fr, int fq) const {
    const int chb = ud.col0;
    UNR for (int bj = 0; bj < 2; ++bj) {
      const int ch = chb + 64 * bj + 16 * wc + 4 * fq;
      const f32x4 ba = *(const f32x4*)(b_a + ch), bx = *(const f32x4*)(b_x + ch), l = *(const f32x4*)(lam + ch);
      f32x4 ls;
      UNR for (int j = 0; j < 4; ++j) ls[j] = 8.0f * logsigm(l[j]);
      const size_t o0 = ((size_t)ud.row0 + 64 * wr + fr) * 1024 + ch;
      UNR for (int ai = 0; ai < 2; ++ai) { u32x2 uq[4];
      UNR for (int m = 0; m < 4; ++m) uq[m] = *(const u32x2*)(u + o0 + (size_t)(128 * ai + 16 * m) * 1024);
      UNR for (int m = 0; m < 4; ++m) {
        const size_t o = o0 + (size_t)(128 * ai + 16 * m) * 1024;
        const u32x2 uw = uq[m];
        const float uu[4] = {bf_lo(uw.x), bf_hi(uw.x), bf_lo(uw.y), bf_hi(uw.y)};
        float la[4], bv[4];
        UNR for (int j = 0; j < 4; ++j) {
          const float rg = sigmf(acc[ai][bj][m][0][j] + ba[j]);
          const float ig = sigmf(acc[ai][bj][m][1][j] + bx[j]);
          la[j] = rg * ls[j];
          const float x2 = 2.0f * la[j];
          const float om = (x2 > -0.02f) ? -(x2 * (1.0f + x2 * (0.5f + x2 * (1.0f / 6.0f)))) : 1.0f - __expf(x2);
          bv[j] = __builtin_amdgcn_sqrtf(fmaxf(om, 0.f)) * ig * uu[j];
        }
        u32x2 w1; w1.x = pk2(la[0], la[1]); w1.y = pk2(la[2], la[3]);
        u32x2 w2; w2.x = pk2(bv[0], bv[1]); w2.y = pk2(bv[2], bv[3]);
        *(u32x2*)(loga + o) = w1; *(u32x2*)(bb + o) = w2;
      }
      asm volatile("" ::: "memory"); }
    }
  }
};
struct EpiZ {
  __device__ __forceinline__ void run(Acc& acc, const UnitD& u, int wr, int wc, int fr, int fq) const {
    bf16_t* base = (bf16_t*)u.out + (size_t)(64 * wr + fr) * u.ldc + 32 * wc + 8 * fq;
    UNR for (int bj = 0; bj < 2; ++bj) {
      const f32x4 b0 = *(const f32x4*)(u.bias + COLOF(bj, 0)), b1 = *(const f32x4*)(u.bias + COLOF(bj, 1));
      u32x4 o[2][4];
      UNR for (int ai = 0; ai < 2; ++ai) UNR for (int m = 0; m < 4; ++m) o[ai][m] = *(const u32x4*)(base + (size_t)(128 * ai + 16 * m) * u.ldc + 128 * bj);
      UNR for (int ai = 0; ai < 2; ++ai) UNR for (int m = 0; m < 4; ++m) {
        const f32x4 z0 = acc[ai][bj][m][0] + b0, z1 = acc[ai][bj][m][1] + b1; const u32x4 ov = o[ai][m];
        u32x4 w; w.x = pk2(bf_lo(ov.x) * z0.x * sigmf(z0.x), bf_hi(ov.x) * z0.y * sigmf(z0.y)); w.y = pk2(bf_lo(ov.y) * z0.z * sigmf(z0.z), bf_hi(ov.y) * z0.w * sigmf(z0.w));
        w.z = pk2(bf_lo(ov.z) * z1.x * sigmf(z1.x), bf_hi(ov.z) * z1.y * sigmf(z1.y)); w.w = pk2(bf_lo(ov.w) * z1.z * sigmf(z1.z), bf_hi(ov.w) * z1.w * sigmf(z1.w));
        *(u32x4*)(base + (size_t)(128 * ai + 16 * m) * u.ldc + 128 * bj) = w;
      }
      asm volatile("" ::: "memory");
    }
  }
};
struct EpiMerge {
  bf16_t* gsc; float* macc; bf16_t* merged;
  __device__ __forceinline__ void run(Acc& acc, const UnitD& u, int wr, int wc, int fr, int fq) const {
    const size_t org = (size_t)(u.row0 + 64 * wr + fr) * 1024 + u.col0 + 32 * wc + 8 * fq;
    if ((u.sub & 1) == 0) {
      UNR for (int bj = 0; bj < 2; ++bj) {
        const f32x4 b0 = *(const f32x4*)(u.bias + COLOF(bj, 0)), b1 = *(const f32x4*)(u.bias + COLOF(bj, 1));
        UNR for (int ai = 0; ai < 2; ++ai) UNR for (int m = 0; m < 4; ++m) {
          const f32x4 v0 = acc[ai][bj][m][0] + b0, v1 = acc[ai][bj][m][1] + b1;
          u32x4 w; w.x = pk2(sigmn(v0.x), sigmn(v0.y)); w.y = pk2(sigmn(v0.z), sigmn(v0.w)); w.z = pk2(sigmn(v1.x), sigmn(v1.y)); w.w = pk2(sigmn(v1.z), sigmn(v1.w));
          *(u32x4*)(gsc + org + (size_t)(128 * ai + 16 * m) * 1024 + 128 * bj) = w;
        }
      }
    } else {
      UNR for (int bj = 0; bj < 2; ++bj) {
        u32x4 g[2][4], a[2][4];
        UNR for (int ai = 0; ai < 2; ++ai) UNR for (int m = 0; m < 4; ++m) { const size_t o = org + (size_t)(128 * ai + 16 * m) * 1024 + 128 * bj; g[ai][m] = *(const u32x4*)(gsc + o); if (u.sub != 1) a[ai][m] = *(const u32x4*)(merged + o); }
        UNR for (int ai = 0; ai < 2; ++ai) UNR for (int m = 0; m < 4; ++m) {
          const size_t o = org + (size_t)(128 * ai + 16 * m) * 1024 + 128 * bj;
          const u32x4 gg = g[ai][m];
          f32x4 v0 = acc[ai][bj][m][0], v1 = acc[ai][bj][m][1];
          v0.x *= bf_lo(gg.x); v0.y *= bf_hi(gg.x); v0.z *= bf_lo(gg.y); v0.w *= bf_hi(gg.y); v1.x *= bf_lo(gg.z); v1.y *= bf_hi(gg.z); v1.z *= bf_lo(gg.w); v1.w *= bf_hi(gg.w);
          if (u.sub != 1) { const u32x4 aa = a[ai][m]; v0.x += bf_lo(aa.x); v0.y += bf_hi(aa.x); v0.z += bf_lo(aa.y); v0.w += bf_hi(aa.y); v1.x += bf_lo(aa.z); v1.y += bf_hi(aa.z); v1.z += bf_lo(aa.w); v1.w += bf_hi(aa.w); }
          u32x4 w; w.x = pk2(v0.x, v0.y); w.y = pk2(v0.z, v0.w); w.z = pk2(v1.x, v1.y); w.w = pk2(v1.z, v1.w); *(u32x4*)(merged + o) = w;
        }
        asm volatile("" ::: "memory");
      }
    }
  }
};
struct EpiOut {
  const float* x; float* out;
  __device__ __forceinline__ void run(Acc& acc, const UnitD& u, int wr, int wc, int fr, int fq) const {
    const size_t org = (size_t)(u.row0 + 64 * wr + fr) * 1024 + u.col0 + 32 * wc + 8 * fq;
    UNR for (int bj = 0; bj < 2; ++bj) {
      f32x4 xv[2][4][2];
      UNR for (int ai = 0; ai < 2; ++ai) UNR for (int m = 0; m < 4; ++m) { const size_t o = org + (size_t)(128 * ai + 16 * m) * 1024 + 128 * bj; xv[ai][m][0] = *(const f32x4*)(x + o); xv[ai][m][1] = *(const f32x4*)(x + o + 4); }
      UNR for (int ai = 0; ai < 2; ++ai) UNR for (int m = 0; m < 4; ++m) { const size_t o = org + (size_t)(128 * ai + 16 * m) * 1024 + 128 * bj;
        *(f32x4*)(out + o) = xv[ai][m][0] + acc[ai][bj][m][0]; *(f32x4*)(out + o + 4) = xv[ai][m][1] + acc[ai][bj][m][1]; }
      asm volatile("" ::: "memory");
    }
  }
};
struct EpiSoftmax {
  LAS float* P;
  __device__ __forceinline__ void run(Acc& acc, const UnitD& u, int wr, int wc, int fr, int fq) const {
    float mx[2][4], sm[2][4];
    UNR for (int ai = 0; ai < 2; ++ai) UNR for (int m = 0; m < 4; ++m) { float x = -3.0e38f;
      UNR for (int bj = 0; bj < 2; ++bj) UNR for (int n = 0; n < 2; ++n) UNR for (int j = 0; j < 4; ++j) { acc[ai][bj][m][n][j] *= 0.0625f; x = fmaxf(x, acc[ai][bj][m][n][j]); }
      mx[ai][m] = x; }
    row_allreduce<true>(mx, P, wr, wc, fr, fq);
    UNR for (int ai = 0; ai < 2; ++ai) UNR for (int m = 0; m < 4; ++m) { float s = 0.f;
      UNR for (int bj = 0; bj < 2; ++bj) UNR for (int n = 0; n < 2; ++n) UNR for (int j = 0; j < 4; ++j) { const float e = __expf(acc[ai][bj][m][n][j] - mx[ai][m]); acc[ai][bj][m][n][j] = e; s += e; }
      sm[ai][m] = s; }
    row_allreduce<false>(sm, P, wr, wc, fr, fq);
    UNR for (int ai = 0; ai < 2; ++ai) UNR for (int m = 0; m < 4; ++m) {
      const float inv = __builtin_amdgcn_rcpf(sm[ai][m]);
      bf16_t* rowp = (bf16_t*)u.out + (size_t)ROWOF(ai, m) * u.ldc;
      UNR for (int bj = 0; bj < 2; ++bj) { const f32x4 v0 = acc[ai][bj][m][0] * inv, v1 = acc[ai][bj][m][1] * inv;
        u32x4 w; w.x = pk2(v0.x, v0.y); w.y = pk2(v0.z, v0.w); w.z = pk2(v1.x, v1.y); w.w = pk2(v1.z, v1.w); *(u32x4*)(rowp + COLOF(bj, 0)) = w; }
    }
  }
};
struct EpiU2 {
  LAS float* P; LAS float* deni; const float* m_denp; const float* m_Bc; const float* m_Mt; const bf16_t* og; const float* norm_g; const float* skip; bf16_t* xc;
  __device__ __forceinline__ void run(Acc& acc, const UnitD& u, int wr, int wc, int fr, int fq) const {
    const int h = u.aux0, unit = u.aux1, tok0 = u.row0;
    float s1[2][4], s2[2][4];
    UNR for (int ai = 0; ai < 2; ++ai) UNR for (int m = 0; m < 4; ++m) {
      const int r = ROWOF(ai, m); const size_t tok = (size_t)tok0 + r;
      const f32x4 dp = *(const f32x4*)(m_denp + ((size_t)unit * 256 + r) * 4);
      const float den = (dp.x + dp.y) + (dp.z + dp.w) + deni[r];
      const float mt = m_Bc[tok * 4 + h];
      const float inv = __builtin_amdgcn_rcpf(fmaxf(fabsf(den), __expf(-mt)));
      float s = 0.f;
      const bf16_t* ogp = og + tok * 1024 + h * 256 + 32 * wc + 8 * fq;
      UNR for (int bj = 0; bj < 2; ++bj) {
        const u32x4 o = *(const u32x4*)(ogp + 128 * bj);
        f32x4 v0 = acc[ai][bj][m][0] * inv, v1 = acc[ai][bj][m][1] * inv;
        v0.x *= bf_lo(o.x); v0.y *= bf_hi(o.x); v0.z *= bf_lo(o.y); v0.w *= bf_hi(o.y); v1.x *= bf_lo(o.z); v1.y *= bf_hi(o.z); v1.z *= bf_lo(o.w); v1.w *= bf_hi(o.w);
        acc[ai][bj][m][0] = v0; acc[ai][bj][m][1] = v1; s += ((v0.x + v0.y) + (v0.z + v0.w)) + ((v1.x + v1.y) + (v1.z + v1.w));
      }
      s1[ai][m] = s;
      if (m == 3) asm volatile("" ::: "memory");
    }
    row_allreduce<false>(s1, P, wr, wc, fr, fq);
    UNR for (int ai = 0; ai < 2; ++ai) UNR for (int m = 0; m < 4; ++m) { const float mu = s1[ai][m] * (1.0f / 256.0f); float s = 0.f;
      UNR for (int bj = 0; bj < 2; ++bj) UNR for (int n = 0; n < 2; ++n) { f32x4 v = acc[ai][bj][m][n] - mu; acc[ai][bj][m][n] = v; s += (v.x * v.x + v.y * v.y) + (v.z * v.z + v.w * v.w); }
      s2[ai][m] = s; }
    row_allreduce<false>(s2, P, wr, wc, fr, fq);
    UNR for (int ai = 0; ai < 2; ++ai) UNR for (int m = 0; m < 4; ++m) s2[ai][m] = __builtin_amdgcn_rsqf(s2[ai][m] * (1.0f / 256.0f) + 1e-6f);
    bf16_t* xb = xc + (size_t)(tok0 + 64 * wr + fr) * 1024 + h * 256 + 32 * wc + 8 * fq;
    UNR for (int bj = 0; bj < 2; ++bj) {
      const int ch = h * 256 + COLOF(bj, 0);
      const f32x4 g0 = *(const f32x4*)(norm_g + ch), g1 = *(const f32x4*)(norm_g + ch + 4), k0 = *(const f32x4*)(skip + ch), k1 = *(const f32x4*)(skip + ch + 4);
      UNR for (int ai = 0; ai < 2; ++ai) {
        u32x4 xq[4];
        UNR for (int m = 0; m < 4; ++m) xq[m] = *(const u32x4*)(xb + (size_t)(128 * ai + 16 * m) * 1024 + 128 * bj);
        UNR for (int m = 0; m < 4; ++m) {
          const u32x4 xv = xq[m];
          const f32x4 v0 = acc[ai][bj][m][0] * s2[ai][m], v1 = acc[ai][bj][m][1] * s2[ai][m];
          u32x4 w; w.x = pk2(v0.x * g0.x + k0.x * bf_lo(xv.x), v0.y * g0.y + k0.y * bf_hi(xv.x)); w.y = pk2(v0.z * g0.z + k0.z * bf_lo(xv.y), v0.w * g0.w + k0.w * bf_hi(xv.y));
          w.z = pk2(v1.x * g1.x + k1.x * bf_lo(xv.z), v1.y * g1.y + k1.y * bf_hi(xv.z)); w.w = pk2(v1.z * g1.z + k1.z * bf_lo(xv.w), v1.w * g1.w + k1.w * bf_hi(xv.w));
          *(u32x4*)(xb + (size_t)(128 * ai + 16 * m) * 1024 + 128 * bj) = w;
        }
        asm volatile("" ::: "memory");
      }
    }
  }
};

struct EpiOutNorm {
  const float* x; float* out; const float* g; LAS float* P; float* xch; unsigned* cnt;
  __device__ __forceinline__ void run(Acc& acc, const UnitD& u, int wr, int wc, int fr, int fq) const {
    const int pm = u.aux0, pn = u.aux1;
    const size_t org = (size_t)(u.row0 + 64 * wr + fr) * 1024 + u.col0 + 32 * wc + 8 * fq;
    UNR for (int bj = 0; bj < 2; ++bj) UNR for (int ai = 0; ai < 2; ++ai) {
      f32x4 xv[4][2];
      UNR for (int m = 0; m < 4; ++m) { const size_t o = org + (size_t)(128 * ai + 16 * m) * 1024 + 128 * bj; xv[m][0] = *(const f32x4*)(x + o); xv[m][1] = *(const f32x4*)(x + o + 4); }
      UNR for (int m = 0; m < 4; ++m) { acc[ai][bj][m][0] += xv[m][0]; acc[ai][bj][m][1] += xv[m][1]; }
      asm volatile("" ::: "memory");
    }
    float ss[2][4];
    UNR for (int ai = 0; ai < 2; ++ai) UNR for (int m = 0; m < 4; ++m) { float s = 0.f;
      UNR for (int bj = 0; bj < 2; ++bj) UNR for (int n = 0; n < 2; ++n) { const f32x4 v = acc[ai][bj][m][n]; s += (v.x * v.x + v.y * v.y) + (v.z * v.z + v.w * v.w); }
      ss[ai][m] = s; }
    row_allreduce<false>(ss, P, wr, wc, fr, fq);
    if (wc == 0 && fq == 0) {
      UNR for (int ai = 0; ai < 2; ++ai) UNR for (int m = 0; m < 4; ++m)
        __hip_atomic_store(xch + ((size_t)(pm * 256 + ROWOF(ai, m))) * 4 + pn, ss[ai][m], __ATOMIC_RELAXED, __HIP_MEMORY_SCOPE_AGENT);
    }
    asm volatile("s_waitcnt vmcnt(0)" ::: "memory");
    __syncthreads();
    if (threadIdx.x == 0) {
      unsigned* c = cnt + 64 * pm;
      __hip_atomic_fetch_add(c, 1u, __ATOMIC_RELAXED, __HIP_MEMORY_SCOPE_AGENT);
      unsigned sp = 0;
      while (__hip_atomic_load(c, __ATOMIC_RELAXED, __HIP_MEMORY_SCOPE_AGENT) < 4u) { __builtin_amdgcn_s_sleep(1); if (++sp > (1u << 22)) break; }
      __builtin_amdgcn_fence(__ATOMIC_ACQUIRE, "agent");
      asm volatile("s_waitcnt vmcnt(0)" ::: "memory");
    }
    __syncthreads();
    UNR for (int ai = 0; ai < 2; ++ai) UNR for (int m = 0; m < 4; ++m) {
      const float* sl = xch + ((size_t)(pm * 256 + ROWOF(ai, m))) * 4;
      const float t = (__hip_atomic_load(sl, __ATOMIC_RELAXED, __HIP_MEMORY_SCOPE_AGENT) + __hip_atomic_load(sl + 1, __ATOMIC_RELAXED, __HIP_MEMORY_SCOPE_AGENT))
                    + (__hip_atomic_load(sl + 2, __ATOMIC_RELAXED, __HIP_MEMORY_SCOPE_AGENT) + __hip_atomic_load(sl + 3, __ATOMIC_RELAXED, __HIP_MEMORY_SCOPE_AGENT));
      ss[ai][m] = 1.0f / sqrtf(t * (1.0f / 1024.0f) + 1e-6f);
    }
    int fr3 = fr, fq3 = fq; asm volatile("" : "+v"(fr3), "+v"(fq3));
    const size_t org2 = (size_t)(u.row0 + 64 * wr + fr3) * 1024 + u.col0 + 32 * wc + 8 * fq3;
    UNR for (int bj = 0; bj < 2; ++bj) {
      const f32x4 g0 = *(const f32x4*)(g + u.col0 + COLOF(bj, 0)), g1 = *(const f32x4*)(g + u.col0 + COLOF(bj, 1));
      UNR for (int ai = 0; ai < 2; ++ai) UNR for (int m = 0; m < 4; ++m) { const size_t o = org2 + (size_t)(128 * ai + 16 * m) * 1024 + 128 * bj;
        *(f32x4*)(out + o) = acc[ai][bj][m][0] * ss[ai][m] * g0; *(f32x4*)(out + o + 4) = acc[ai][bj][m][1] * ss[ai][m] * g1; }
    }
  }
};

struct SchedTiles {
  const char* A; const char* Bt; char* out0; char* out1; const float* bias; int nN, G, c;
  __device__ __forceinline__ bool next(int i, UnitD& u) const {
    int pm, pn; if (!static_tile((long)i * G + c, 64, nN, pm, pn)) return false;
    u.A0 = u.A1 = A + (size_t)pm * 256 * 1024 * 2; u.B0 = u.B1 = Bt + (size_t)pn * 256 * 1024 * 2;
    u.out = ((pn >> 2) ? out1 : out0) + ((size_t)pm * 256 * 1024 + (pn & 3) * 256) * 2; u.bias = bias ? bias + pn * 256 : nullptr; u.ldc = 1024; u.sub = 0;
    u.row0 = pm * 256; u.col0 = (pn & 3) * 256; u.aux0 = 0; u.aux1 = 0; return true;
  }
};
struct SchedOne { UnitD u; bool has; __device__ __forceinline__ bool next(int i, UnitD& o) const { if (i != 0 || !has) return false; o = u; return true; } };
struct SchedP3X {
  const char* xc; const char* mx; const char* wq; const char* wk; const char* wo; char* q; char* k; char* og; const float* b_o; int G, c;
  __device__ __forceinline__ bool next(int i, UnitD& u) const {
    const int L = i * G + c; if (L >= 768) return false;
    const int kind = L >> 8, idx = L & 255, pm = idx >> 2, h = idx & 3;
    const size_t to = ((size_t)pm * 256 * 1024 + h * 256) * 2;
    u.A0 = u.A1 = (kind == 2 ? mx : xc) + to; u.B0 = u.B1 = wq + (size_t)(kind == 0 ? 0 : kind == 1 ? 524288 : 1572864) + (size_t)h * 131072;
    u.out = q + (size_t)kind * SLOT + to; u.bias = kind == 2 ? b_o + h * 256 : nullptr; u.ldc = 1024; u.sub = kind == 2 ? 1 : 0;
    u.row0 = pm * 256; u.col0 = h * 256; u.aux0 = h; u.aux1 = 0; return true;
  }
};
struct SchedP3Y {
  const char* xc; const char* mx; const char* wk; const char* wv; char* vt; char* ktw; int G, c, base, count;
  __device__ __forceinline__ bool next(int i, UnitD& u) const {
    const int Lr = i * G + c; if (Lr >= count) return false;
    const int L = base + Lr;
    const int kind = L >> 8, unit = L & 255, bh = unit >> 5, ci = unit & 31, b = bh >> 2, h = bh & 3, tok0 = b * SEQ + ci * 256;
    u.A0 = u.A1 = (kind ? wk : wv) + (size_t)h * 131072; u.B0 = u.B1 = (kind ? xc : mx) + ((size_t)tok0 * 1024 + h * 256) * 2;
    u.out = (kind ? ktw : vt) + (size_t)unit * 131072; u.bias = nullptr; u.ldc = 256; u.sub = kind ? 2 : 0; u.row0 = tok0; u.col0 = 0; u.aux0 = h; u.aux1 = unit; return true;
  }
};
struct SchedZ {
  const char* hn; const char* wint; char* y0; char* y1; char* y2; const float* binr; int G, c;
  __device__ __forceinline__ bool next(int i, UnitD& u) const {
    const int L = i * G + c; if (L >= 768) return false;
    const int br = L >> 8, r = L & 255, pm = (r & 7) * 8 + (r >> 5), pn = (r >> 3) & 3;
    u.A0 = u.A1 = hn + (size_t)pm * 256 * 1024 * 2; u.B0 = u.B1 = wint + (size_t)(3072 + br * 1024 + pn * 256) * 1024 * 2;
    u.out = (char*)((size_t)y0 * (size_t)(br == 0) + (size_t)y1 * (size_t)(br == 1) + (size_t)y2 * (size_t)(br == 2)) + ((size_t)pm * 256 * 1024 + pn * 256) * 2; u.bias = binr + 3072 + br * 1024 + pn * 256; u.ldc = 1024; u.sub = 0; u.row0 = pm * 256; u.col0 = pn * 256; u.aux0 = 0; u.aux1 = 0; return true;
  }
};
struct SchedMerge {
  const char* hn; const char* wint; const char* wbt; const char* y0; const char* y1; const char* y2; const float* binr; int G, c;
  __device__ __forceinline__ bool next(int i, UnitD& u) const {
    const int tile = (i / 6) * G + c; if (tile >= 256) return false;
    const int kind = i % 6, n = kind >> 1, pm = (tile & 7) * 8 + (tile >> 5), pn = (tile >> 3) & 3;
    if ((kind & 1) == 0) { u.A0 = u.A1 = hn + (size_t)pm * 256 * 1024 * 2; u.B0 = u.B1 = wint + (size_t)(6144 + n * 1024 + pn * 256) * 1024 * 2; u.bias = binr + 6144 + n * 1024 + pn * 256; }
    else { u.A0 = u.A1 = (const char*)((size_t)y0 * (size_t)(n == 0) + (size_t)y1 * (size_t)(n == 1) + (size_t)y2 * (size_t)(n == 2)) + (size_t)pm * 256 * 1024 * 2; u.B0 = u.B1 = wbt + (size_t)(n * 1024 + pn * 256) * 1024 * 2; u.bias = nullptr; }
    u.out = nullptr; u.ldc = 1024; u.sub = kind; u.row0 = pm * 256; u.col0 = pn * 256; u.aux0 = 0; u.aux1 = 0; return true;
  }
};
struct SchedLru {
  const char* u_; const char* wl; int G, c;
  __device__ __forceinline__ bool next(int i, UnitD& u) const {
    const int L = i * G + c; if (L >= 512) return false;
    const int pm = (L & 7) * 8 + (L >> 6), pn = (L >> 3) & 7;
    u.A0 = u.A1 = u_ + ((size_t)pm * 256 * 1024 + (pn >> 1) * 256) * 2; u.B0 = u.B1 = wl + (size_t)pn * 131072;
    u.out = nullptr; u.bias = nullptr; u.ldc = 1024; u.sub = 0; u.row0 = pm * 256; u.col0 = (pn >> 1) * 256 + (pn & 1) * 128; u.aux0 = 0; u.aux1 = 0; return true;
  }
};

template <int NR>
__device__ __forceinline__ void rmsnorm_rows_bf16(const float* xr, const float* g, bf16_t* o, int lane) {
  f32x4 v[NR][4]; float s[NR];
#pragma unroll
  for (int r = 0; r < NR; ++r)
#pragma unroll
    for (int j = 0; j < 4; ++j) v[r][j] = ((const f32x4*)(xr + (size_t)r * 1024))[lane + 64 * j];
#pragma unroll
  for (int r = 0; r < NR; ++r) { float t = 0.f;
#pragma unroll
    for (int j = 0; j < 4; ++j) t += (v[r][j].x * v[r][j].x + v[r][j].y * v[r][j].y) + (v[r][j].z * v[r][j].z + v[r][j].w * v[r][j].w);
    s[r] = 1.0f / sqrtf(wave_sum(t) * (1.0f / 1024.0f) + 1e-6f); }
#pragma unroll
  for (int j = 0; j < 4; ++j) { const f32x4 gg = ((const f32x4*)g)[lane + 64 * j];
#pragma unroll
    for (int r = 0; r < NR; ++r) { u32x2 w; w.x = pk2(v[r][j].x * s[r] * gg.x, v[r][j].y * s[r] * gg.y); w.y = pk2(v[r][j].z * s[r] * gg.z, v[r][j].w * s[r] * gg.w); ((u32x2*)(o + (size_t)r * 1024))[lane + 64 * j] = w; } }
}
__device__ __forceinline__ void rmsnorm_row_bf16(const float* xr, const float* g, bf16_t* o, int lane) { rmsnorm_rows_bf16<1>(xr, g, o, lane); }

template <class RowMap>
__device__ __forceinline__ void transpose_tile(const float* __restrict__ src, int N, int K, int k0, int n0, bf16_t* dst, RowMap rm, float scale, LAS float* scr) {
  const int tid = threadIdx.x;
  { const int n4 = tid & 15, kk = tid >> 4;
    f32x4 a[4], b[4];
#pragma unroll
    for (int cb = 0; cb < 4; ++cb) { a[cb] = *(const f32x4*)(src + (size_t)(k0 + kk) * N + n0 + cb * 64 + 4 * n4); b[cb] = *(const f32x4*)(src + (size_t)(k0 + kk + 32) * N + n0 + cb * 64 + 4 * n4); }
#pragma unroll
    for (int cb = 0; cb < 4; ++cb) { LAS float* s0 = scr + kk * 261 + cb * 64 + 4 * n4; LAS float* s1 = s0 + 32 * 261;
      s0[0] = a[cb].x; s0[1] = a[cb].y; s0[2] = a[cb].z; s0[3] = a[cb].w; s1[0] = b[cb].x; s1[1] = b[cb].y; s1[2] = b[cb].z; s1[3] = b[cb].w; } }
  __syncthreads();
#pragma unroll
  for (int cb = 0; cb < 4; ++cb) { const int nn = cb * 64 + (tid >> 3), kc = tid & 7; const LAS float* s = scr + (kc * 8) * 261 + nn;
    u32x4 o; o.x = pk2(s[0] * scale, s[261] * scale); o.y = pk2(s[522] * scale, s[783] * scale); o.z = pk2(s[1044] * scale, s[1305] * scale); o.w = pk2(s[1566] * scale, s[1827] * scale);
    *(u32x4*)(dst + (size_t)rm(n0 + nn) * K + k0 + kc * 8) = o; }
  __syncthreads();
}
struct RmId { __device__ __forceinline__ int operator()(int n) const { return n; } };
struct RmWin { __device__ __forceinline__ int operator()(int n) const { const int b = n >> 10; const int mb = b == 0 ? 1 : b == 1 ? 3 : b == 2 ? 0 : b == 3 ? 4 : b == 4 ? 2 : b; return mb * 1024 + (n & 1023); } };
struct RmLru { int mat; __device__ __forceinline__ int operator()(int o) const { const int pnl = o >> 7, cl = o & 127; return pnl * 256 + 128 * (cl >> 6) + 32 * ((cl >> 4) & 3) + 8 * ((cl >> 2) & 3) + 4 * mat + (cl & 3); } };

template <bool MAX>
__device__ __forceinline__ float block_excl_scan(float v, LAS float* tmp) {
  const int lane = threadIdx.x & 63, wid = threadIdx.x >> 6;
  const float ident = MAX ? -3.0e38f : 0.f;
  float inc = v;
#pragma unroll
  for (int o = 1; o < 64; o <<= 1) { const float y = __shfl_up(inc, o); if (lane >= o) inc = MAX ? fmaxf(inc, y) : inc + y; }
  if (lane == 63) tmp[wid] = inc;
  __syncthreads();
  float base = ident;
  for (int w = 0; w < wid; ++w) base = MAX ? fmaxf(base, tmp[w]) : base + tmp[w];
  float ex = __shfl_up(inc, 1); if (lane == 0) ex = ident;
  __syncthreads();
  return MAX ? fmaxf(base, ex) : base + ex;
}

template <bool MLSTM>
__device__ __forceinline__ void conv_rows(const Params& p, const bf16_t* src, bf16_t* dst, const float* cw, const float* cb, float* gates, const float* b_if, LAS float* wxc, LAS float* wxm, int gw, int NW, int lane) {
  for (int t = gw; t < T; t += NW) {
    const int tl = t & (SEQ - 1);
    float g[8];
#pragma unroll
    for (int j = 0; j < 8; ++j) g[j] = 0.f;
#pragma unroll
    for (int i = 0; i < 2; ++i) { const int c0 = i * 512 + lane * 8;
      float o[8], xm[8];
      { const f32x4 a = *(const f32x4*)(cb + c0), b = *(const f32x4*)(cb + c0 + 4);
        o[0] = a.x; o[1] = a.y; o[2] = a.z; o[3] = a.w; o[4] = b.x; o[5] = b.y; o[6] = b.z; o[7] = b.w; }
#pragma unroll
      for (int e = 0; e < 8; ++e) xm[e] = 0.f;
#pragma unroll
      for (int k = 0; k < 4; ++k) {
        if (tl - 3 + k >= 0) {
          const u32x4 v = *(const u32x4*)(src + (size_t)(t - 3 + k) * 1024 + c0);
          const f32x4 wa = *(const f32x4*)(cw + k * 1024 + c0), wb = *(const f32x4*)(cw + k * 1024 + c0 + 4);
          const float xv[8] = {bf_lo(v.x), bf_hi(v.x), bf_lo(v.y), bf_hi(v.y), bf_lo(v.z), bf_hi(v.z), bf_lo(v.w), bf_hi(v.w)};
          const float wv[8] = {wa.x, wa.y, wa.z, wa.w, wb.x, wb.y, wb.z, wb.w};
#pragma unroll
          for (int e = 0; e < 8; ++e) { o[e] += wv[e] * xv[e]; if (k == 3) xm[e] = xv[e]; }
        }
      }
      if (MLSTM) {
#pragma unroll
        for (int e = 0; e < 8; ++e) o[e] = o[e] * sigm(o[e]);
#pragma unroll
        for (int e = 0; e < 8; ++e) { const int c = c0 + e;
          const f32x4 a0 = *(const LAS f32x4*)(wxc + c * 8), a1 = *(const LAS f32x4*)(wxc + c * 8 + 4), m0 = *(const LAS f32x4*)(wxm + c * 8), m1 = *(const LAS f32x4*)(wxm + c * 8 + 4);
          g[0] += o[e] * a0.x + xm[e] * m0.x; g[1] += o[e] * a0.y + xm[e] * m0.y; g[2] += o[e] * a0.z + xm[e] * m0.z; g[3] += o[e] * a0.w + xm[e] * m0.w;
          g[4] += o[e] * a1.x + xm[e] * m1.x; g[5] += o[e] * a1.y + xm[e] * m1.y; g[6] += o[e] * a1.z + xm[e] * m1.z; g[7] += o[e] * a1.w + xm[e] * m1.w; }
      }
      u32x4 ov; ov.x = pk2(o[0], o[1]); ov.y = pk2(o[2], o[3]); ov.z = pk2(o[4], o[5]); ov.w = pk2(o[6], o[7]);
      *(u32x4*)(dst + (size_t)t * 1024 + c0) = ov;
    }
    if (MLSTM) {
#pragma unroll
      for (int j = 0; j < 8; ++j) g[j] = wave_sum(g[j]);
      if (lane == 0) {
        f32x4 o0, o1;
        o0.x = g[0] + b_if[0]; o0.y = g[1] + b_if[1]; o0.z = g[2] + b_if[2]; o0.w = g[3] + b_if[3];
        o1.x = logsigm(g[4] + b_if[4]); o1.y = logsigm(g[5] + b_if[5]); o1.z = logsigm(g[6] + b_if[6]); o1.w = logsigm(g[7] + b_if[7]);
        *(f32x4*)(gates + (size_t)t * 8) = o0; *(f32x4*)(gates + (size_t)t * 8 + 4) = o1;
      }
    }
  }
}

template <bool SILU>
__device__ __forceinline__ void conv_item(const bf16_t* src, bf16_t* dst, const float* cw, const float* cb, int c0, int t0) {
  const bool first = ((t0 & (SEQ - 1)) == 0);
  u32x4 xr[19];
#pragma unroll
  for (int i = 0; i < 19; ++i) { if (i < 3 && first) xr[i] = (u32x4){0u, 0u, 0u, 0u}; else xr[i] = *(const u32x4*)(src + (size_t)(t0 - 3 + i) * 1024 + c0); }
  float w[4][8], bs[8];
#pragma unroll
  for (int k = 0; k < 4; ++k) { const f32x4 a = *(const f32x4*)(cw + k * 1024 + c0), b = *(const f32x4*)(cw + k * 1024 + c0 + 4);
    w[k][0] = a.x; w[k][1] = a.y; w[k][2] = a.z; w[k][3] = a.w; w[k][4] = b.x; w[k][5] = b.y; w[k][6] = b.z; w[k][7] = b.w; }
  { const f32x4 a = *(const f32x4*)(cb + c0), b = *(const f32x4*)(cb + c0 + 4); bs[0] = a.x; bs[1] = a.y; bs[2] = a.z; bs[3] = a.w; bs[4] = b.x; bs[5] = b.y; bs[6] = b.z; bs[7] = b.w; }
#pragma unroll
  for (int t = 0; t < 16; ++t) {
    float o[8];
#pragma unroll
    for (int e = 0; e < 8; ++e) o[e] = bs[e];
#pragma unroll
    for (int k = 0; k < 4; ++k) { const u32x4 v = xr[t + k];
      o[0] += w[k][0] * bf_lo(v.x); o[1] += w[k][1] * bf_hi(v.x); o[2] += w[k][2] * bf_lo(v.y); o[3] += w[k][3] * bf_hi(v.y);
      o[4] += w[k][4] * bf_lo(v.z); o[5] += w[k][5] * bf_hi(v.z); o[6] += w[k][6] * bf_lo(v.w); o[7] += w[k][7] * bf_hi(v.w); }
    if (SILU) {
#pragma unroll
      for (int e = 0; e < 8; ++e) o[e] = o[e] * sigmf(o[e]); }
    u32x4 ov; ov.x = pk2(o[0], o[1]); ov.y = pk2(o[2], o[3]); ov.z = pk2(o[4], o[5]); ov.w = pk2(o[6], o[7]);
    *(u32x4*)(dst + (size_t)(t0 + t) * 1024 + c0) = ov;
  }
}
template <bool SILU>
__device__ __forceinline__ void conv_stream(const bf16_t* src, bf16_t* dst, const float* cw, const float* cb, int gtid, int GT) {
  for (int g = gtid; g < 131072; g += GT) conv_item<SILU>(src, dst, cw, cb, (g & 127) * 8, (g >> 7) * 16);
}
__device__ __forceinline__ void gates_tile(const bf16_t* xc, const bf16_t* xm, const bf16_t* wgT, float* part, int tok0, int h, int wid, int lane) {
  const int i16 = lane & 15, kg = lane >> 4;
#pragma unroll 1
  for (int tt = wid; tt < 16; tt += 8) {
    const int t16 = tok0 + tt * 16;
    f32x4 acc = {0.f, 0.f, 0.f, 0.f};
    const bf16_t* ap = xc + (size_t)(t16 + i16) * 1024 + h * 256 + kg * 8;
    const bf16_t* bp = wgT + (size_t)i16 * 2048 + h * 256 + kg * 8;
#pragma unroll
    for (int ks = 0; ks < 8; ++ks) { const bf16x8 a = *(const bf16x8*)(ap + ks * 32), b = *(const bf16x8*)(bp + ks * 32); acc = __builtin_amdgcn_mfma_f32_16x16x32_bf16(a, b, acc, 0, 0, 0); }
    ap = xm + (size_t)(t16 + i16) * 1024 + h * 256 + kg * 8; bp += 1024;
#pragma unroll
    for (int ks = 0; ks < 8; ++ks) { const bf16x8 a = *(const bf16x8*)(ap + ks * 32), b = *(const bf16x8*)(bp + ks * 32); acc = __builtin_amdgcn_mfma_f32_16x16x32_bf16(a, b, acc, 0, 0, 0); }
    if (i16 < 8) *(f32x4*)(part + ((size_t)h * 8 + i16) * T + t16 + 4 * kg) = acc;
  }
}

__device__ __forceinline__ void gates_gemm(const bf16_t* xc, const bf16_t* xm, const bf16_t* wgT, float* part, int gw, int NW, int lane) {
  const int i16 = lane & 15, kg = lane >> 4;
  for (int item = gw; item < 2048; item += NW) {
    const int tile = item >> 1, half = item & 1, tok0 = tile * 16;
    f32x4 acc = {0.f, 0.f, 0.f, 0.f};
    const bf16_t* ap = (half ? xm : xc) + (size_t)(tok0 + i16) * 1024 + kg * 8;
    const bf16_t* bp = wgT + (size_t)i16 * 2048 + half * 1024 + kg * 8;
#pragma unroll 16
    for (int ks = 0; ks < 32; ++ks) { const bf16x8 a = *(const bf16x8*)(ap + ks * 32), b = *(const bf16x8*)(bp + ks * 32); acc = __builtin_amdgcn_mfma_f32_16x16x32_bf16(a, b, acc, 0, 0, 0); }
    if (i16 < 8) *(f32x4*)(part + ((size_t)half * 8 + i16) * T + tok0 + 4 * kg) = acc;
  }
}

#define XB_TMO      128
#define XB_XCNT(j)  (256  + 64 * (j))
#define XB_XSUB(j)  (1280 + 64 * (j))
#define XB_XGEN(j)  (2304 + 64 * (j))
#define XB_TOP      3328
#define XB_TOPGEN   3392
#define XCD_BAR_WORDS 3456
#define XB_SPIN_CAP (1u << 18)
__device__ __forceinline__ unsigned xb_ld(unsigned* p)              { return __hip_atomic_load(p, __ATOMIC_RELAXED, __HIP_MEMORY_SCOPE_AGENT); }
__device__ __forceinline__ unsigned xb_add(unsigned* p, unsigned v) { return __hip_atomic_fetch_add(p, v, __ATOMIC_RELAXED, __HIP_MEMORY_SCOPE_AGENT); }
__device__ __forceinline__ unsigned xb_xcc_id() { return (unsigned)__builtin_amdgcn_s_getreg((3 << 11) | 20) & 0xFu; }
#define XB_SPIN(cond, bar) do { unsigned _sp = 0; while (cond) { __builtin_amdgcn_s_sleep(1); \
    if ((++_sp & 255u) == 0u) { if (xb_ld(&(bar)[XB_TMO])) break; if (_sp > XB_SPIN_CAP) { atomicAdd(&(bar)[XB_TMO], 1u); break; } } } } while (0)
struct XcdBarrier { unsigned* bar; unsigned x; volatile LAS unsigned* st; };
__device__ __forceinline__ XcdBarrier xcd_barrier_post(unsigned* bar, volatile LAS unsigned* st) {
    XcdBarrier b; b.bar = bar; b.x = xb_xcc_id(); b.st = st;
    if (threadIdx.x == 0) (void)xb_add(&bar[XB_XCNT(b.x)], 1u);
    return b;
}
__device__ __forceinline__ void xcd_barrier_complete(unsigned* bar, unsigned x, unsigned& nloc, unsigned& nx) {
    const unsigned G = gridDim.x * gridDim.y * gridDim.z;
    unsigned sum, cnt, mine, sp = 0u;
    for (;;) {
        sum = 0u; cnt = 0u; mine = 0u;
#pragma unroll
        for (unsigned j = 0; j < 16; ++j) { const unsigned c = xb_ld(&bar[XB_XCNT(j)]); sum += c; cnt += (c > 0u) ? 1u : 0u; mine = (j == x) ? c : mine; }
        if (sum == G) break;
        __builtin_amdgcn_s_sleep(1);
        if ((++sp & 255u) == 0u) { if (xb_ld(&bar[XB_TMO])) break; if (sp > XB_SPIN_CAP) { atomicAdd(&bar[XB_TMO], 1u); break; } }
    }
    nloc = mine > 0u ? mine : 1u; nx = cnt > 0u ? cnt : 1u;
}
__device__ __forceinline__ void xcd_barrier(const XcdBarrier& b) {
    asm volatile("s_waitcnt vmcnt(0)" ::: "memory");
    __syncthreads();
    if (threadIdx.x == 0) {
        unsigned* bar = b.bar;
        __builtin_amdgcn_s_waitcnt(0);
        unsigned nloc = b.st[0], nx = b.st[1];
        if (nloc == 0u) { xcd_barrier_complete(bar, b.x, nloc, nx); b.st[0] = nloc; b.st[1] = nx; }
        const unsigned old = xb_add(&bar[XB_XSUB(b.x)], 1u);
        const unsigned gen = old / nloc;
        if (old + 1u == (gen + 1u) * nloc) {
            __builtin_amdgcn_fence(__ATOMIC_RELEASE, "agent");
            asm volatile("s_waitcnt vmcnt(0)" ::: "memory");
            const unsigned og = xb_add(&bar[XB_TOP], 1u);
            const unsigned tg = og / nx;
            if (og + 1u == (tg + 1u) * nx) xb_add(&bar[XB_TOPGEN], 1u);
            else XB_SPIN(xb_ld(&bar[XB_TOPGEN]) == tg, bar);
            __builtin_amdgcn_fence(__ATOMIC_ACQUIRE, "agent");
            xb_add(&bar[XB_XGEN(b.x)], 1u);
            asm volatile("s_waitcnt vmcnt(0)" ::: "memory");
        } else {
            XB_SPIN(xb_ld(&bar[XB_XGEN(b.x)]) == gen, bar);
            __builtin_amdgcn_fence(__ATOMIC_ACQUIRE, "agent");
            asm volatile("s_waitcnt vmcnt(0)" ::: "memory");
        }
    }
    __syncthreads();
}

#define W0 ((char*)p.ws + O_SLOTS)
#define W1 ((char*)p.ws + O_SLOTS + SLOT)
#define W2 ((char*)p.ws + O_SLOTS + 2 * SLOT)
#define W3 ((char*)p.ws + O_SLOTS + 3 * SLOT)
#define W4 ((char*)p.ws + O_SLOTS + 4 * SLOT)
#define W5 ((char*)p.ws + O_SLOTS + 5 * SLOT)
#define D0 ((char*)p.out)
#define D1 ((char*)p.out + SLOT)
#define WinT ((const char*)p.ws + O_WINT)
#define WbT ((const char*)p.ws + O_WBT)
#define WoutT ((const char*)p.ws + O_WOUTT)
#define WkvT ((const char*)p.ws + O_WKVT)
#define WqT ((const char*)p.ws + O_WQT)
#define WkT ((const char*)p.ws + O_WKT)
#define WvT ((const char*)p.ws + O_WVT)
#define WoT ((const char*)p.ws + O_WOT)
#define WlruT ((const char*)p.ws + O_WLRUT)
#define binR ((float*)(p.ws + O_BINR))
#define Wxc ((float*)(p.ws + O_WXC))
#define Wxm ((float*)(p.ws + O_WXM))
#define gates ((float*)(p.ws + O_GATES))
#define Bc ((float*)(p.ws + O_BC))
#define Av ((float*)(p.ws + O_AV))
#define Mt ((float*)(p.ws + O_MT))
#define denp ((float*)(p.ws + O_DENP))
#define nkloc ((float*)(p.ws + O_NKLOC))
#define nprev ((float*)(p.ws + O_NPREV))
#define Kmem ((char*)p.ws + O_KMEM)
#define VmemT ((char*)p.ws + O_VMEMT)
#define memN ((char*)p.ws + O_MEMN)
#define hend ((float*)(p.ws + O_HEND))
#define slog ((float*)(p.ws + O_SLOG))
#define carry ((float*)(p.ws + O_CARRY))
__device__ __forceinline__ void transpose_item(const Params& p, int it, LAS float* ldsf) {
  int r = it;
  if (r < 576) { transpose_tile(p.in[3], 9216, 1024, (r / 36) * 64, (r % 36) * 256, (bf16_t*)WinT, RmWin(), 1.0f, ldsf); return; } r -= 576;
  if (r < 192) { const int n_ = r >> 6, q = r & 63; transpose_tile(p.in[25] + (size_t)n_ * 1048576, 1024, 1024, (q >> 2) * 64, (q & 3) * 256, (bf16_t*)WbT + (size_t)n_ * 1048576, RmId(), 1.0f, ldsf); return; } r -= 192;
  if (r < 64) { transpose_tile(p.in[26], 1024, 1024, (r >> 2) * 64, (r & 3) * 256, (bf16_t*)WoutT, RmId(), 1.0f, ldsf); return; } r -= 64;
  if (r < 128) { transpose_tile(p.in[24], 2048, 1024, (r >> 3) * 64, (r & 7) * 256, (bf16_t*)WkvT, RmId(), 1.0f, ldsf); return; } r -= 128;
  if (r < 64) { const int mat = r >> 4, q = r & 15, h = q >> 2, kb = q & 3;
    const float* srcp = (mat == 0 ? p.in[14] : mat == 1 ? p.in[15] : mat == 2 ? p.in[16] : p.in[17]) + (size_t)h * 65536;
    bf16_t* dstp = (bf16_t*)WqT + (size_t)mat * 262144 + (size_t)h * 65536;
    transpose_tile(srcp, 256, 256, kb * 64, 0, dstp, RmId(), mat == 1 ? 0.0625f : 1.0f, ldsf); return; } r -= 64;
  { const int mat = r >> 4, q = r & 15, g = q >> 2, kb = q & 3; RmLru rm; rm.mat = mat;
    transpose_tile((mat == 0 ? p.in[7] : p.in[9]) + (size_t)g * 65536, 256, 256, kb * 64, 0, (bf16_t*)WlruT + (size_t)g * 131072, rm, 1.0f, ldsf); }
}

constexpr unsigned ALLPH = (1u << 18) - 1u;
template <unsigned MASK>
__global__ void __launch_bounds__(512) mk_fwd(Params p) {
  extern __shared__ __attribute__((aligned(16))) unsigned char smem[];
  LAS unsigned char* lds = (LAS unsigned char*)smem;
  LAS float* ldsf = (LAS float*)lds;
  LAS float* xP = (LAS float*)(lds + STAGE_BYTES);
  LAS float* xD = (LAS float*)(lds + STAGE_BYTES + 4096);
  LAS float* xW = (LAS float*)(lds + STAGE_BYTES + 5120);
  LAS float* xT = (LAS float*)(lds + STAGE_BYTES + 7168);
  cg::grid_group grid = cg::this_grid();
  volatile LAS unsigned* xst = (volatile LAS unsigned*)(lds + STAGE_BYTES + 8192);
  if (threadIdx.x == 0) { xst[0] = 0u; xst[1] = 0u; }
  __syncthreads();
  XcdBarrier xb; if constexpr (MASK == ALLPH) xb = xcd_barrier_post((unsigned*)(p.ws + O_BAR), xst);
  const int G = gridDim.x, wg = blockIdx.x, NW = G * 8, GT = G * 512;
  const float* x = p.in[0];

  if constexpr ((MASK >> 0) & 1) {
  int tid = threadIdx.x; asm volatile("" : "+v"(tid)); const int lane = tid & 63, wid = tid >> 6, gw = wg * 8 + wid, gtid = wg * 512 + tid; (void)lane; (void)gw; (void)gtid;
  {
    for (int e = wg; e < 256; e += G) {
      const int it = e < 64 ? (e >> 2) * 36 + 8 + (e & 3) : e < 192 ? 832 + (e - 64) : 960 + (e - 192);
      transpose_item(p, it, ldsf);
    }
    for (int row = gw * 4; row < T; row += NW * 4) rmsnorm_rows_bf16<4>(x + (size_t)row * 1024, p.in[2], (bf16_t*)W0 + (size_t)row * 1024, lane);
    for (int row = gw; row < 512; row += NW) rmsnorm_row_bf16(p.in[1] + (size_t)row * 1024, p.in[23], (bf16_t*)memN + (size_t)row * 1024, lane);
    for (int w = gw; w < 2048; w += NW) {
      const int which = w >> 10, i = w & 1023, h = i >> 8, ii = i & 255;
      float a[8];
#pragma unroll
      for (int j = 0; j < 8; ++j) a[j] = 0.f;
      const float* wif = p.in[19];
#pragma unroll
      for (int jj = 0; jj < 4; ++jj) { const int o = lane + 64 * jj;
        if (which == 0) {
          const float wq = p.in[14][(size_t)h * 65536 + ii * 256 + o], wk = p.in[15][(size_t)h * 65536 + ii * 256 + o];
          const f32x4 q0 = *(const f32x4*)(wif + (size_t)(h * 256 + o) * 8), q1 = *(const f32x4*)(wif + (size_t)(h * 256 + o) * 8 + 4);
          const f32x4 k0 = *(const f32x4*)(wif + (size_t)(1024 + h * 256 + o) * 8), k1 = *(const f32x4*)(wif + (size_t)(1024 + h * 256 + o) * 8 + 4);
          a[0] += wq * q0.x + wk * k0.x; a[1] += wq * q0.y + wk * k0.y; a[2] += wq * q0.z + wk * k0.z; a[3] += wq * q0.w + wk * k0.w;
          a[4] += wq * q1.x + wk * k1.x; a[5] += wq * q1.y + wk * k1.y; a[6] += wq * q1.z + wk * k1.z; a[7] += wq * q1.w + wk * k1.w;
        } else {
          const float wv = p.in[16][(size_t)h * 65536 + ii * 256 + o];
          const f32x4 v0 = *(const f32x4*)(wif + (size_t)(2048 + h * 256 + o) * 8), v1 = *(const f32x4*)(wif + (size_t)(2048 + h * 256 + o) * 8 + 4);
          a[0] += wv * v0.x; a[1] += wv * v0.y; a[2] += wv * v0.z; a[3] += wv * v0.w; a[4] += wv * v1.x; a[5] += wv * v1.y; a[6] += wv * v1.z; a[7] += wv * v1.w;
        } }
#pragma unroll
      for (int j = 0; j < 8; ++j) a[j] = wave_sum(a[j]);
      if (lane == 0) { bf16_t* d = (bf16_t*)(p.ws + O_WGT) + which * 1024 + i;
#pragma unroll
        for (int j = 0; j < 8; ++j) { d[(size_t)j * 2048] = (bf16_t)(pk2(a[j], 0.f) & 0xffffu); d[(size_t)(8 + j) * 2048] = 0; } }
    }
    for (int n = gtid; n < 9216; n += GT) binR[RmWin()((int)n)] = p.in[4][n];
  }
  }
  if constexpr (MASK == ALLPH) xcd_barrier(xb);

  if constexpr ((MASK >> 1) & 1) {
  int tid = threadIdx.x; asm volatile("" : "+v"(tid)); const int lane = tid & 63, wid = tid >> 6, gw = wg * 8 + wid, gtid = wg * 512 + tid; (void)lane; (void)gw; (void)gtid;
  {
    SchedTiles S; S.A = W0; S.Bt = WinT; S.out0 = W1; S.out1 = W1; S.bias = binR; S.nN = 4; S.G = G; S.c = wg;
    EpiBf16 E; E.m_Av = Av; E.m_Mt = Mt;
    gemm_phase<SchedTiles, EpiBf16, false>(lds, 1024, 1024, 16, 16, S, E);
  }
  }
  if constexpr (MASK == ALLPH) xcd_barrier(xb);

  if constexpr ((MASK >> 2) & 1) {
  int tid = threadIdx.x; asm volatile("" : "+v"(tid)); const int lane = tid & 63, wid = tid >> 6, gw = wg * 8 + wid, gtid = wg * 512 + tid; (void)lane; (void)gw; (void)gtid;
  {
    const int pm = wg >> 2, h = wg & 3, tok0 = pm * 256;
    conv_item<true>((const bf16_t*)W1, (bf16_t*)W2, p.in[12], p.in[13], h * 256 + (tid & 31) * 8, tok0 + (tid >> 5) * 16);
    asm volatile("s_waitcnt vmcnt(0)" ::: "memory"); __syncthreads();
    EpiBf16 E; E.m_Av = Av; E.m_Mt = Mt;
    SchedP3X SX; SX.xc = W2; SX.mx = W1; SX.wq = WqT; SX.wk = WkT; SX.wo = WoT; SX.q = W3; SX.k = W4; SX.og = W5; SX.b_o = p.in[18]; SX.G = G; SX.c = wg;
    gemm_phase<SchedP3X, EpiBf16, false>(lds, 1024, 256, 4, 4, SX, E);
    gates_tile((const bf16_t*)W2, (const bf16_t*)W1, (const bf16_t*)(p.ws + O_WGT), gates, tok0, h, wid, lane);
  }
  }
  if constexpr (MASK == ALLPH) xcd_barrier(xb);

  if constexpr ((MASK >> 3) & 1) {
  int tid = threadIdx.x; asm volatile("" : "+v"(tid)); const int lane = tid & 63, wid = tid >> 6, gw = wg * 8 + wid, gtid = wg * 512 + tid; (void)lane; (void)gw; (void)gtid;
  }


  if constexpr ((MASK >> 4) & 1) {
  int tid = threadIdx.x; asm volatile("" : "+v"(tid)); const int lane = tid & 63, wid = tid >> 6, gw = wg * 8 + wid, gtid = wg * 512 + tid; (void)lane; (void)gw; (void)gtid;
  if (wg < 8) {
    const int b = wg >> 2, h = wg & 3;
    const size_t t0 = (size_t)b * SEQ + (size_t)tid * 16;
    float c[16], ig[16];
    float run = 0.f;
    { const float bi = p.in[20][h], bf = p.in[20][4 + h];
      const float* gi = gates + (size_t)h * T + t0; const float* gf = gates + (size_t)(4 + h) * T + t0;
#pragma unroll
      for (int k4 = 0; k4 < 4; ++k4) {
        f32x4 a = *(const f32x4*)(gi + 4 * k4), f = *(const f32x4*)(gf + 4 * k4);
#pragma unroll
        for (int hh = 1; hh < 4; ++hh) { a = a + *(const f32x4*)(gi + (size_t)hh * 8 * T + 4 * k4); f = f + *(const f32x4*)(gf + (size_t)hh * 8 * T + 4 * k4); }
#pragma unroll
        for (int e = 0; e < 4; ++e) { ig[4 * k4 + e] = a[e] + bi; run += logsigm(f[e] + bf); c[4 * k4 + e] = run; } } }
    const float off = block_excl_scan<false>(run, xT);
    float pmx = -3.0e38f;
#pragma unroll
    for (int k = 0; k < 16; ++k) { c[k] += off; ig[k] = ig[k] - c[k]; pmx = fmaxf(pmx, ig[k]); }
    const float offm = block_excl_scan<true>(pmx, xT);
    float rm = offm;
#pragma unroll
    for (int k = 0; k < 16; ++k) { rm = fmaxf(rm, ig[k]); const float mtv = fmaxf(rm, 0.f); Bc[(t0 + k) * 4 + h] = c[k] + mtv;   Av[(t0 + k) * 4 + h] = ig[k]; Mt[(t0 + k) * 4 + h] = mtv; }
  } else if (wg < 24) {
    const int idx = wg - 8; SchedOne S; S.has = true;
    if (idx < 8) { const int pm = idx >> 2, pn = idx & 3;
      S.u.A0 = S.u.A1 = memN + (size_t)pm * 256 * 1024 * 2; S.u.B0 = S.u.B1 = WkvT + (size_t)pn * 256 * 1024 * 2; S.u.out = Kmem + ((size_t)pm * 256 * 1024 + pn * 256) * 2; S.u.ldc = 1024; }
    else { const int pm = (idx - 8) >> 1, b = (idx - 8) & 1;
      S.u.A0 = S.u.A1 = WkvT + (size_t)(1024 + pm * 256) * 1024 * 2; S.u.B0 = S.u.B1 = memN + (size_t)b * 256 * 1024 * 2; S.u.out = VmemT + (size_t)(b * 1024 + pm * 256) * 256 * 2; S.u.ldc = 256; }
    S.u.bias = nullptr; S.u.sub = 0; S.u.row0 = 0; S.u.col0 = 0; S.u.aux0 = 0; S.u.aux1 = 0;
    EpiBf16 E; E.m_Av = Av; E.m_Mt = Mt;
    gemm_phase<SchedOne, EpiBf16, false>(lds, 1024, 1024, 16, 16, S, E);
  } else {
    for (int l = wg - 24; l < 800; l += G - 24) {
      int it;
      if (l < 512) { const int j = l & 31; it = (l >> 5) * 36 + (j < 8 ? j : j + 4); }
      else if (l < 704) it = 576 + (l - 512); else if (l < 768) it = 768 + (l - 704); else it = 1024 + (l - 768);
      transpose_item(p, it, ldsf);
    }
    EpiBf16 E; E.m_Av = Av; E.m_Mt = Mt;
    SchedP3Y SY; SY.xc = W2; SY.mx = W1; SY.wk = WkT; SY.wv = WvT; SY.vt = D0; SY.ktw = D1; SY.G = G - 24; SY.c = wg - 24; SY.base = 0; SY.count = 256;
    gemm_phase<SchedP3Y, EpiBf16, false>(lds, 256, 1024, 4, 4, SY, E);
  }
  }
  if constexpr (MASK == ALLPH) xcd_barrier(xb);

  if constexpr ((MASK >> 5) & 1) {
  int tid = threadIdx.x; asm volatile("" : "+v"(tid)); const int lane = tid & 63, wid = tid >> 6, gw = wg * 8 + wid, gtid = wg * 512 + tid; (void)lane; (void)gw; (void)gtid;
  { EpiBf16 E; E.m_Av = Av; E.m_Mt = Mt;
    SchedP3Y SY; SY.xc = W2; SY.mx = W1; SY.wk = WkT; SY.wv = WvT; SY.vt = D0; SY.ktw = D1; SY.G = G; SY.c = wg; SY.base = 256; SY.count = 256;
    gemm_phase<SchedP3Y, EpiBf16, false>(lds, 256, 1024, 4, 4, SY, E);
    asm volatile("s_waitcnt vmcnt(0)" ::: "memory"); __syncthreads(); }
  if (wg < 256) { const int unit = wg;
    const int bh = unit >> 5, ci = unit & 31, b = bh >> 2, h = bh & 3, tok0 = b * SEQ + ci * 256;
    { SchedOne S; S.has = true; S.u.A0 = S.u.A1 = D0 + (size_t)unit * 131072; S.u.B0 = S.u.B1 = D1 + (size_t)unit * 131072; S.u.out = W1 + (size_t)unit * 131072; S.u.bias = nullptr; S.u.ldc = 256; S.u.sub = 0;
      S.u.row0 = tok0; S.u.col0 = 0; S.u.aux0 = h; S.u.aux1 = unit;
      EpiBf16 E; E.m_Av = Av; E.m_Mt = Mt;
      gemm_phase<SchedOne, EpiBf16, false>(lds, 256, 256, 4, 4, S, E); }
    { SchedOne S; S.has = true; const size_t to = ((size_t)tok0 * 1024 + h * 256) * 2;
      S.u.A0 = S.u.A1 = W3 + to; S.u.B0 = S.u.B1 = W4 + to; S.u.out = W0 + to; S.u.bias = nullptr; S.u.ldc = 1024; S.u.sub = 0; S.u.row0 = tok0; S.u.col0 = 0; S.u.aux0 = h; S.u.aux1 = unit;
      EpiU1 E; E.m_Av = Av; E.m_Mt = Mt; E.m_denp = denp;
      gemm_phase<SchedOne, EpiU1, false>(lds, 1024, 1024, 4, 4, S, E); }
    { const float mprev = ci == 0 ? 0.f : Mt[(size_t)(tok0 - 1) * 4 + h];
      const int r = tid >> 1, hf = tid & 1;
      const float sc = __expf(mprev - Mt[(size_t)(tok0 + r) * 4 + h]);
      u32x4* qp = (u32x4*)((bf16_t*)W3 + (size_t)(tok0 + r) * 1024 + h * 256 + hf * 128);
      u32x4 v[16];
#pragma unroll
      for (int i = 0; i < 16; ++i) v[i] = qp[i];
#pragma unroll
      for (int i = 0; i < 16; ++i) { u32x4 o;
        o.x = pk2(bf_lo(v[i].x) * sc, bf_hi(v[i].x) * sc); o.y = pk2(bf_lo(v[i].y) * sc, bf_hi(v[i].y) * sc); o.z = pk2(bf_lo(v[i].z) * sc, bf_hi(v[i].z) * sc); o.w = pk2(bf_lo(v[i].w) * sc, bf_hi(v[i].w) * sc); qp[i] = o; } }
    { const float me = Mt[(size_t)(tok0 + 255) * 4 + h];
      if (tid < 256) xW[tid] = __expf(Av[(size_t)(tok0 + tid) * 4 + h] - me);
      __syncthreads();
      const int cg8 = tid & 31, sg = tid >> 5;
      const bf16_t* kp = (const bf16_t*)W4 + (size_t)(tok0 + sg * 16) * 1024 + h * 256 + cg8 * 8;
      u32x4 v[16];
#pragma unroll
      for (int i = 0; i < 16; ++i) v[i] = *(const u32x4*)(kp + (size_t)i * 1024);
      float a[8];
#pragma unroll
      for (int j = 0; j < 8; ++j) a[j] = 0.f;
#pragma unroll
      for (int i = 0; i < 16; ++i) { const float w = xW[sg * 16 + i];
        a[0] += w * bf_lo(v[i].x); a[1] += w * bf_hi(v[i].x); a[2] += w * bf_lo(v[i].y); a[3] += w * bf_hi(v[i].y); a[4] += w * bf_lo(v[i].z); a[5] += w * bf_hi(v[i].z); a[6] += w * bf_lo(v[i].w); a[7] += w * bf_hi(v[i].w); }
#pragma unroll
      for (int j = 0; j < 8; ++j) ldsf[sg * 256 + cg8 * 8 + j] = a[j];
      __syncthreads();
      if (tid < 256) { float s = 0.f;
#pragma unroll
        for (int g2 = 0; g2 < 16; ++g2) s += ldsf[g2 * 256 + tid];
        nkloc[(size_t)unit * 256 + tid] = s; }
      __syncthreads(); }
  }
  }
  if constexpr (MASK == ALLPH) xcd_barrier(xb);

  if constexpr ((MASK >> 6) & 1) {
  int tid = threadIdx.x; asm volatile("" : "+v"(tid)); const int lane = tid & 63, wid = tid >> 6, gw = wg * 8 + wid, gtid = wg * 512 + tid; (void)lane; (void)gw; (void)gtid;
  {
    for (int g = gtid; g < 131072; g += GT) {
      const int bh = (int)(g >> 14), e4 = (int)(g & 16383), b = bh >> 2, h = bh & 3;
      u32x2* base = (u32x2*)((bf16_t*)W1 + (size_t)bh * 32 * 65536 + (size_t)e4 * 4);
      u32x2 kv[32]; float me[32];
#pragma unroll
      for (int c = 0; c < 32; ++c) { kv[c] = base[(size_t)c * 16384]; me[c] = Mt[(size_t)(b * SEQ + c * 256 + 255) * 4 + h]; }
      float C0 = 0.f, C1 = 0.f, C2 = 0.f, C3 = 0.f; float mprev = 0.f;
#pragma unroll
      for (int c = 0; c < 32; ++c) {
        const float dec = __expf(mprev - me[c]); mprev = me[c];
        u32x2 w; w.x = pk2(C0, C1); w.y = pk2(C2, C3); base[(size_t)c * 16384] = w;
        C0 = dec * C0 + bf_lo(kv[c].x); C1 = dec * C1 + bf_hi(kv[c].x); C2 = dec * C2 + bf_lo(kv[c].y); C3 = dec * C3 + bf_hi(kv[c].y);
      }
    }
    for (int g = gtid; g < 2048; g += GT) {
      const int bh = (int)(g >> 8), col = (int)(g & 255), b = bh >> 2, h = bh & 3;
      float nk[32], me[32];
#pragma unroll
      for (int c = 0; c < 32; ++c) { nk[c] = nkloc[(size_t)(bh * 32 + c) * 256 + col]; me[c] = Mt[(size_t)(b * SEQ + c * 256 + 255) * 4 + h]; }
      float n = 0.f, mprev = 0.f;
#pragma unroll
      for (int c = 0; c < 32; ++c) { const float dec = __expf(mprev - me[c]); mprev = me[c]; nprev[(size_t)(bh * 32 + c) * 256 + col] = n; n = dec * n + nk[c]; }
    }
    for (int row = gw * 4; row < T; row += NW * 4) rmsnorm_rows_bf16<4>(x + (size_t)row * 1024, p.in[2], (bf16_t*)W4 + (size_t)row * 1024, lane);
  }
  }
  if constexpr (MASK == ALLPH) xcd_barrier(xb);

  if constexpr ((MASK >> 7) & 1) {
  int tid = threadIdx.x; asm volatile("" : "+v"(tid)); const int lane = tid & 63, wid = tid >> 6, gw = wg * 8 + wid, gtid = wg * 512 + tid; (void)lane; (void)gw; (void)gtid;
  if (wg < 256) { const int unit = wg;
    const int bh = unit >> 5, ci = unit & 31, b = bh >> 2, h = bh & 3, tok0 = b * SEQ + ci * 256;
    { if (tid < 256) xW[tid] = nprev[(size_t)unit * 256 + tid];
      __syncthreads();
      const int r = tid >> 1, hf = tid & 1;
      const u32x4* qp = (const u32x4*)((const bf16_t*)W3 + (size_t)(tok0 + r) * 1024 + h * 256 + hf * 128);
      u32x4 v[16];
#pragma unroll
      for (int i = 0; i < 16; ++i) v[i] = qp[i];
      float s = 0.f;
#pragma unroll
      for (int i = 0; i < 16; ++i) { const LAS float* nv = xW + hf * 128 + i * 8;
        const f32x4 n0 = *(const LAS f32x4*)nv, n1 = *(const LAS f32x4*)(nv + 4);
        s += bf_lo(v[i].x) * n0.x + bf_hi(v[i].x) * n0.y + bf_lo(v[i].y) * n0.z + bf_hi(v[i].y) * n0.w + bf_lo(v[i].z) * n1.x + bf_hi(v[i].z) * n1.y + bf_lo(v[i].w) * n1.z + bf_hi(v[i].w) * n1.w; }
      s += __shfl_xor(s, 1);
      if (hf == 0) xD[r] = s;
      __syncthreads(); }
    SchedOne S; S.has = true; const size_t to = ((size_t)tok0 * 1024 + h * 256) * 2;
    S.u.A0 = W0 + to; S.u.A1 = W3 + to; S.u.B0 = D0 + (size_t)unit * 131072; S.u.B1 = W1 + (size_t)unit * 131072;
    S.u.out = nullptr; S.u.bias = nullptr; S.u.ldc = 1024; S.u.sub = 0; S.u.row0 = tok0; S.u.col0 = 0; S.u.aux0 = h; S.u.aux1 = unit;
    EpiU2 E; E.P = xP; E.deni = xD; E.m_denp = denp; E.m_Bc = Bc; E.m_Mt = Mt; E.og = (const bf16_t*)W5; E.norm_g = p.in[21]; E.skip = p.in[22]; E.xc = (bf16_t*)W2;
    gemm_phase<SchedOne, EpiU2, true>(lds, 1024, 256, 8, 4, S, E);
    __syncthreads();
  }
  }
  if constexpr (MASK == ALLPH) xcd_barrier(xb);

  if constexpr ((MASK >> 8) & 1) {
  int tid = threadIdx.x; asm volatile("" : "+v"(tid)); const int lane = tid & 63, wid = tid >> 6, gw = wg * 8 + wid, gtid = wg * 512 + tid; (void)lane; (void)gw; (void)gtid;
  {
    SchedTiles S; S.A = W4; S.Bt = WinT + (size_t)1024 * 1024 * 2; S.out0 = W0; S.out1 = W1; S.bias = binR + 1024; S.nN = 8; S.G = G; S.c = wg;
    EpiBf16 E; E.m_Av = Av; E.m_Mt = Mt;
    gemm_phase<SchedTiles, EpiBf16, false>(lds, 1024, 1024, 16, 16, S, E);
  }
  }
  if constexpr (MASK == ALLPH) xcd_barrier(xb);

  if constexpr ((MASK >> 9) & 1) {
  int tid = threadIdx.x; asm volatile("" : "+v"(tid)); const int lane = tid & 63, wid = tid >> 6, gw = wg * 8 + wid, gtid = wg * 512 + tid; (void)lane; (void)gw; (void)gtid;
  {
    conv_stream<false>((const bf16_t*)W0, (bf16_t*)W3, p.in[5], p.in[6], gtid, GT);
    if (wg < 256) { const int L = wg;
      const int pm = L >> 2, h = L & 3, b = pm >> 5;
      { SchedOne S; S.has = true;
        S.u.A0 = S.u.A1 = W1 + ((size_t)pm * 256 * 1024 + h * 256) * 2; S.u.B0 = S.u.B1 = Kmem + ((size_t)b * 256 * 1024 + h * 256) * 2; S.u.out = W5 + (size_t)L * 131072; S.u.bias = nullptr; S.u.ldc = 256; S.u.sub = 0;
        S.u.row0 = 0; S.u.col0 = 0; S.u.aux0 = 0; S.u.aux1 = 0;
        EpiSoftmax E; E.P = xP;
        gemm_phase<SchedOne, EpiSoftmax, true>(lds, 1024, 1024, 4, 4, S, E); }
      asm volatile("s_waitcnt vmcnt(0)" ::: "memory"); __syncthreads();
      { SchedOne S; S.has = true;
        S.u.A0 = S.u.A1 = W5 + (size_t)L * 131072; S.u.B0 = S.u.B1 = VmemT + (size_t)(b * 1024 + h * 256) * 256 * 2; S.u.out = D0 + ((size_t)pm * 256 * 1024 + h * 256) * 2; S.u.bias = nullptr; S.u.ldc = 1024; S.u.sub = 0;
        S.u.row0 = 0; S.u.col0 = 0; S.u.aux0 = 0; S.u.aux1 = 0;
        EpiBf16 E; E.m_Av = Av; E.m_Mt = Mt;
        gemm_phase<SchedOne, EpiBf16, false>(lds, 256, 256, 4, 4, S, E); }
      __syncthreads();
    }
  }
  }
  if constexpr (MASK == ALLPH) xcd_barrier(xb);

  if constexpr ((MASK >> 10) & 1) {
  int tid = threadIdx.x; asm volatile("" : "+v"(tid)); const int lane = tid & 63, wid = tid >> 6, gw = wg * 8 + wid, gtid = wg * 512 + tid; (void)lane; (void)gw; (void)gtid;
  {
    SchedLru S; S.u_ = W3; S.wl = WlruT; S.G = G; S.c = wg;
    EpiLru E; E.b_a = p.in[8]; E.b_x = p.in[10]; E.lam = p.in[11]; E.u = (const bf16_t*)W3; E.loga = (bf16_t*)W0; E.bb = (bf16_t*)W1;
    gemm_phase<SchedLru, EpiLru, false>(lds, 1024, 256, 4, 4, S, E);
    asm volatile("s_waitcnt vmcnt(0)" ::: "memory"); __syncthreads();
#pragma unroll 1
    for (int i = 0; i < 2; ++i) { const int L = i * G + wg; if (L < 512) {
      const int pm = (L & 7) * 8 + (L >> 6), pn = (L >> 3) & 7;
      const int ch = (pn >> 1) * 256 + (pn & 1) * 128 + (tid & 127), j = pm * 4 + (tid >> 7);
      const bf16_t* la = (const bf16_t*)W0 + (size_t)j * 64 * 1024 + ch; const bf16_t* bp = (const bf16_t*)W1 + (size_t)j * 64 * 1024 + ch;
      float h = 0.f, s = 0.f;
#pragma unroll 16
      for (int t = 0; t < 64; ++t) { const float l = bf2f(la[(size_t)t * 1024]); h = __expf(l) * h + bf2f(bp[(size_t)t * 1024]); s += l; }
      hend[(size_t)j * 1024 + ch] = h; slog[(size_t)j * 1024 + ch] = s; } }
  }
  }
  if constexpr (MASK == ALLPH) xcd_barrier(xb);

  if constexpr ((MASK >> 11) & 1) {
  int tid = threadIdx.x; asm volatile("" : "+v"(tid)); const int lane = tid & 63, wid = tid >> 6, gw = wg * 8 + wid, gtid = wg * 512 + tid; (void)lane; (void)gw; (void)gtid;
  }

  if constexpr ((MASK >> 12) & 1) {
  int tid = threadIdx.x; asm volatile("" : "+v"(tid)); const int lane = tid & 63, wid = tid >> 6, gw = wg * 8 + wid, gtid = wg * 512 + tid; (void)lane; (void)gw; (void)gtid;
  }

  if constexpr ((MASK >> 13) & 1) {
  int tid = threadIdx.x; asm volatile("" : "+v"(tid)); const int lane = tid & 63, wid = tid >> 6, gw = wg * 8 + wid, gtid = wg * 512 + tid; (void)lane; (void)gw; (void)gtid;
  for (int g = gtid; g < 131072; g += GT) {
    const int cp = (int)(g & 511), j = (int)(g >> 9);
    const unsigned* la = (const unsigned*)((const bf16_t*)W0 + (size_t)j * 64 * 1024 + cp * 2);
    const unsigned* bp = (const unsigned*)((const bf16_t*)W1 + (size_t)j * 64 * 1024 + cp * 2);
    unsigned* yo = (unsigned*)((bf16_t*)W3 + (size_t)j * 64 * 1024 + cp * 2);
    float h0 = 0.f, h1 = 0.f;
    { const int jb = (j >> 7) * 128, jl = j & 127;
#pragma unroll 8
      for (int jj = 0; jj < jl; ++jj) { const size_t o = (size_t)(jb + jj) * 1024 + cp * 2;
        const float sx = slog[o], sy = slog[o + 1], ex = hend[o], ey = hend[o + 1];
        h0 = __expf(sx) * h0 + ex; h1 = __expf(sy) * h1 + ey; } }
#pragma unroll 1
    for (int tb = 0; tb < 64; tb += 16) {
      unsigned av[16], bw[16];
#pragma unroll
      for (int t = 0; t < 16; ++t) { av[t] = la[(size_t)(tb + t) * 512]; bw[t] = bp[(size_t)(tb + t) * 512]; }
#pragma unroll
      for (int t = 0; t < 16; ++t) { h0 = __expf(bf_lo(av[t])) * h0 + bf_lo(bw[t]); h1 = __expf(bf_hi(av[t])) * h1 + bf_hi(bw[t]); yo[(size_t)(tb + t) * 512] = pk2(h0, h1); }
    }
  }
  }
  if constexpr (MASK == ALLPH) xcd_barrier(xb);

  if constexpr ((MASK >> 14) & 1) {
  int tid = threadIdx.x; asm volatile("" : "+v"(tid)); const int lane = tid & 63, wid = tid >> 6, gw = wg * 8 + wid, gtid = wg * 512 + tid; (void)lane; (void)gw; (void)gtid;
  {
    SchedZ S; S.hn = W4; S.wint = WinT; S.y0 = W3; S.y1 = W2; S.y2 = D0; S.binr = binR; S.G = G; S.c = wg;
    EpiZ E;
    gemm_phase<SchedZ, EpiZ, false>(lds, 1024, 1024, 16, 16, S, E);
  }
  }
  if constexpr (MASK == ALLPH) xcd_barrier(xb);

  if constexpr ((MASK >> 15) & 1) {
  int tid = threadIdx.x; asm volatile("" : "+v"(tid)); const int lane = tid & 63, wid = tid >> 6, gw = wg * 8 + wid, gtid = wg * 512 + tid; (void)lane; (void)gw; (void)gtid;
  {
    SchedMerge S; S.hn = W4; S.wint = WinT; S.wbt = WbT; S.y0 = W3; S.y1 = W2; S.y2 = D0; S.binr = binR; S.G = G; S.c = wg;
    EpiMerge E; E.gsc = (bf16_t*)D1; E.macc = (float*)W0; E.merged = (bf16_t*)W5;
    gemm_phase<SchedMerge, EpiMerge, false>(lds, 1024, 1024, 16, 16, S, E);
  }
  }
  if constexpr (MASK == ALLPH) xcd_barrier(xb);

  if constexpr ((MASK >> 16) & 1) {
  int tid = threadIdx.x; asm volatile("" : "+v"(tid)); const int lane = tid & 63, wid = tid >> 6, gw = wg * 8 + wid, gtid = wg * 512 + tid; (void)lane; (void)gw; (void)gtid;
  {
    int pm, pn; SchedOne S; S.has = static_tile((long)wg, 64, 4, pm, pn);
    S.u.A0 = S.u.A1 = W5 + (size_t)pm * 256 * 1024 * 2; S.u.B0 = S.u.B1 = WoutT + (size_t)pn * 256 * 1024 * 2; S.u.out = nullptr; S.u.bias = nullptr; S.u.ldc = 1024; S.u.sub = 0;
    S.u.row0 = pm * 256; S.u.col0 = pn * 256; S.u.aux0 = pm; S.u.aux1 = pn;
    EpiOutNorm E; E.x = x; E.out = p.out; E.g = p.in[27]; E.P = xP; E.xch = (float*)(p.ws + O_XCH); E.cnt = (unsigned*)(p.ws + O_CNT);
    gemm_phase<SchedOne, EpiOutNorm, true>(lds, 1024, 1024, 16, 16, S, E);
  }
  }


  if constexpr ((MASK >> 17) & 1) {
  int tid = threadIdx.x; asm volatile("" : "+v"(tid)); const int lane = tid & 63, wid = tid >> 6, gw = wg * 8 + wid, gtid = wg * 512 + tid; (void)lane; (void)gw; (void)gtid;
  }
}

#ifndef MK_SINGLE
#define MK_SINGLE 1
#endif
template <unsigned MASK>
static void launch_phase(const Params& p, int grid, size_t lds, hipStream_t stream) {
  static bool attr = false;
  if (!attr) { (void)hipFuncSetAttribute((const void*)mk_fwd<MASK>, hipFuncAttributeMaxDynamicSharedMemorySize, (int)lds); attr = true; }
  hipLaunchKernelGGL(mk_fwd<MASK>, dim3(grid), dim3(512), lds, stream, p);
}
extern "C" void kernel_launch(void* const* d_in, const int* in_sizes, int n_in, void* d_out, int out_size, void* d_ws, size_t ws_size, hipStream_t stream) {
  constexpr size_t kDynLds = STAGE_BYTES + 16384;
  static int grid_blocks = 0;
  if (!grid_blocks) {
    int dev = 0, cus = 0, per_cu = 0;
    (void)hipGetDevice(&dev);
    (void)hipDeviceGetAttribute(&cus, hipDeviceAttributeMultiprocessorCount, dev);
#if MK_SINGLE
    (void)hipFuncSetAttribute((const void*)mk_fwd<ALLPH>, hipFuncAttributeMaxDynamicSharedMemorySize, (int)kDynLds);
    (void)hipOccupancyMaxActiveBlocksPerMultiprocessor(&per_cu, (const void*)mk_fwd<ALLPH>, 512, kDynLds);
    if (per_cu < 1) fprintf(stderr, "occupancy query says %d blocks/CU\n", per_cu);
#endif
    if (ws_size < WS_NEED) fprintf(stderr, "workspace too small: %zu < %zu\n", ws_size, (size_t)WS_NEED);
    grid_blocks = 256; if (cus < 256) fprintf(stderr, "this kernel needs 256 CUs, device has %d\n", cus);
  }
  Params p{};
  for (int i = 0; i < 28; ++i) p.in[i] = (const float*)d_in[i];
  p.out = (float*)d_out; p.ws = (unsigned char*)d_ws;
#if MK_SINGLE
  (void)hipMemsetAsync((unsigned char*)d_ws + O_BAR, 0, 32768, stream);
  void* args[] = {&p};
  hipError_t e = hipLaunchCooperativeKernel((void*)mk_fwd<ALLPH>, dim3(grid_blocks), dim3(512), args, kDynLds, stream);
  if (e != hipSuccess) fprintf(stderr, "cooperative launch failed: %s (grid %d)\n", hipGetErrorString(e), grid_blocks);
#else
  const int g = grid_blocks;
  launch_phase<1u << 0>(p, g, kDynLds, stream); launch_phase<1u << 1>(p, g, kDynLds, stream); launch_phase<1u << 2>(p, g, kDynLds, stream); launch_phase<1u << 3>(p, g, kDynLds, stream);
  launch_phase<1u << 4>(p, g, kDynLds, stream); launch_phase<1u << 5>(p, g, kDynLds, stream); launch_phase<1u << 6>(p, g, kDynLds, stream); launch_phase<1u << 7>(p, g, kDynLds, stream);
  launch_phase<1u << 8>(p, g, kDynLds, stream); launch_phase<1u << 9>(p, g, kDynLds, stream); launch_phase<1u << 10>(p, g, kDynLds, stream); launch_phase<1u << 11>(p, g, kDynLds, stream);
  launch_phase<1u << 12>(p, g, kDynLds, stream); launch_phase<1u << 13>(p, g, kDynLds, stream); launch_phase<1u << 14>(p, g, kDynLds, stream); launch_phase<1u << 15>(p, g, kDynLds, stream);
  launch_phase<1u << 16>(p, g, kDynLds, stream); launch_phase<1u << 17>(p, g, kDynLds, stream);
#endif
}
```
